# Optimizing an MI355X kernel written in HIP

```python
import jax
import jax.numpy as jnp
from jax import lax
import numpy as np

D_MODEL = 1024
BATCH = 2
SEQ = 16384
DEPTH = 2

N_MEM = 256
D_BR = 512
N_BRANCH = 4
RW_HEADS = 8
RW_HD = D_BR // RW_HEADS
RW_RANK_W = 64
RW_RANK_A = 64
RW_LN_EPS = 64e-5
RW_SHIFT = 3 * D_BR + RW_RANK_W + RW_RANK_A
GLA_HEADS = 4
GLA_DK = D_BR // 2
GLA_RANK = 16
GLA_TAU = 16.0
GLA_CHUNK = 64
RET_HEADS = 4
RET_DK = D_BR // 2
RET_CHUNK = 64
ROPE_BASE = 10000.0
LRU_BLOCKS = 8
LRU_BW = D_BR // LRU_BLOCKS
LRU_CONV = 4
LRU_C = 8.0
XA_HEADS = 4
XA_HD = D_MODEL // XA_HEADS
NORM_EPS = 1e-6

IN_SPLITS = (
    ('rw_r', D_BR), ('rw_k', D_BR), ('rw_v', D_BR), ('rw_wlo', RW_RANK_W), ('rw_alo', RW_RANK_A), ('rw_g', D_BR),
    ('gla_q', GLA_DK), ('gla_k', GLA_DK), ('gla_v', D_BR), ('gla_flo', GLA_RANK), ('gla_g', D_BR),
    ('ret_q', RET_DK), ('ret_k', RET_DK), ('ret_v', D_BR), ('ret_g', D_BR),
    ('lru_x', D_BR), ('lru_g', D_BR),
    ('merge', N_BRANCH * D_MODEL),
)
N_IN = (RW_SHIFT + D_BR) + (2 * GLA_DK + 2 * D_BR + GLA_RANK) + (2 * RET_DK + 2 * D_BR) + 2 * D_BR + N_BRANCH * D_MODEL

kernel_name = 'hybrid_rwkv7_gla_retnet_rglru_gated_block'


def _rmsnorm(x, g):
    x32 = x.astype(jnp.float32)
    y = x32 * lax.rsqrt(jnp.mean(x32 * x32, -1, keepdims=True) + NORM_EPS)
    return (y * g.astype(jnp.float32)).astype(x.dtype)


def _split_last(z, sizes):
    return jnp.split(z, np.cumsum(sizes)[:-1].tolist(), axis=-1)


def _token_shift(z, mu):
    prev = jnp.pad(z[:, :-1], ((0, 0), (1, 0), (0, 0)))
    return z + (prev - z) * mu


def _rope(t, positions):
    half = t.shape[-1] // 2
    inv = ROPE_BASE ** (-jnp.arange(half, dtype=jnp.float32) / half)
    ang = positions.astype(jnp.float32)[..., None] * inv
    cos, sin = jnp.cos(ang)[:, :, None, :], jnp.sin(ang)[:, :, None, :]
    t1, t2 = t[..., :half], t[..., half:]
    return jnp.concatenate([t1 * cos - t2 * sin, t1 * sin + t2 * cos], -1)


def _rwkv7(r, k, v, w_lo, a_lo, w0, w2, a0, a2, k_k, k_a, r_k, ln_g, ln_b):
    B, S, _ = r.shape
    f32 = jnp.float32
    H, N = RW_HEADS, RW_HD
    log_w = -jax.nn.softplus(-(w0 + jnp.tanh(w_lo) @ w2).astype(f32)) - 0.5
    decay = jnp.exp(-jnp.exp(log_w))
    a = jax.nn.sigmoid((a0 + a_lo @ a2).astype(f32))
    k32 = k.astype(f32)
    kk = (k32 * k_k.astype(f32)).reshape(B, S, H, N)
    kk = kk / jnp.maximum(jnp.sqrt(jnp.sum(kk * kk, -1, keepdims=True)), 1e-12)
    k_mod = k32 * (1.0 + (a - 1.0) * k_a.astype(f32))
    heads = lambda t: t.astype(f32).reshape(B, S, H, N)
    rh, wh, kh, vh, ah = heads(r), heads(decay), heads(k_mod), heads(v), heads(a)
    bh = kk * ah

    def step(state, inp):
        r_t, w_t, k_t, v_t, kk_t, b_t = inp
        sa = jnp.einsum('bhvk,bhk->bhv', state, -kk_t)
        state = state * w_t[:, :, None, :] + sa[..., None] * b_t[:, :, None, :] + v_t[..., None] * k_t[:, :, None, :]
        return state, jnp.einsum('bhvk,bhk->bhv', state, r_t)

    xs = tuple(jnp.moveaxis(t, 1, 0) for t in (rh, wh, kh, vh, kk, bh))
    _, y = lax.scan(step, jnp.zeros((B, H, N, N), f32), xs)
    y = jnp.moveaxis(y, 0, 1)
    mean = jnp.mean(y, -1, keepdims=True)
    var = jnp.mean(jnp.square(y - mean), -1, keepdims=True)
    y = ((y - mean) * lax.rsqrt(var + RW_LN_EPS)).reshape(B, S, D_BR) * ln_g.astype(f32) + ln_b.astype(f32)
    bonus = jnp.sum(rh * kh * r_k.astype(f32), -1, keepdims=True) * vh
    return y + bonus.reshape(B, S, D_BR)


def _gla(q, k, v, f_lo, f_up, f_b, norm_g):
    B, S, _ = q.shape
    f32 = jnp.float32
    C, H = GLA_CHUNK, GLA_HEADS
    nC = S // C
    dk, dv = GLA_DK // H, D_BR // H
    log_f = jax.nn.log_sigmoid((f_lo @ f_up + f_b).astype(f32)) / GLA_TAU
    ch = lambda t, d: t.astype(f32).reshape(B, nC, C, H, d)
    q = ch(q, dk) * dk ** -0.5
    k = ch(k, dk)
    v = ch(v, dv)
    b = jnp.cumsum(ch(log_f, dk), axis=2)
    b_last = b[:, :, -1:]
    q_d = q * jnp.exp(b)
    k_d = k * jnp.exp(-b)
    k_end = k * jnp.exp(b_last - b)
    causal = jnp.tril(jnp.ones((C, C), dtype=bool))
    att = jnp.where(causal, jnp.einsum('bnthd,bnshd->bnhts', q_d, k_d), 0.0)
    o = jnp.einsum('bnhts,bnshv->bnthv', att, v)
    ds = jnp.einsum('bnshd,bnshv->bnhdv', k_end, v)
    dec = jnp.exp(b_last[:, :, 0])

    def step(state, inp):
        dec_n, ds_n = inp
        return state * dec_n[..., None] + ds_n, state

    _, s_prev = lax.scan(step, jnp.zeros((B, H, dk, dv), f32), (jnp.moveaxis(dec, 1, 0), jnp.moveaxis(ds, 1, 0)))
    s_prev = jnp.moveaxis(s_prev, 0, 1)
    o = o + jnp.einsum('bnthd,bnhdv->bnthv', q_d, s_prev)
    o = o * lax.rsqrt(jnp.mean(o * o, -1, keepdims=True) + NORM_EPS)
    return o.reshape(B, S, D_BR) * norm_g.astype(f32)


def _retention(q, k, v, positions, gn_g):
    B, S, _ = q.shape
    f32 = jnp.float32
    C, H = RET_CHUNK, RET_HEADS
    nC = S // C
    dk, dv = RET_DK // H, D_BR // H
    q = _rope(q.astype(f32).reshape(B, S, H, dk), positions)
    k = _rope(k.astype(f32).reshape(B, S, H, dk), positions) * dk ** -0.5
    q = q.reshape(B, nC, C, H, dk)
    k = k.reshape(B, nC, C, H, dk)
    v = v.astype(f32).reshape(B, nC, C, H, dv)
    log_g = jnp.log(1.0 - jnp.exp2(-5.0 - jnp.arange(H, dtype=f32)))
    idx = jnp.arange(C, dtype=f32)
    diff = idx[:, None] - idx[None, :]
    dmat = jnp.where(diff >= 0, jnp.exp(jnp.maximum(diff, 0.0)[None] * log_g[:, None, None]), 0.0)
    att = jnp.einsum('bnthd,bnshd->bnhts', q, k) * dmat
    o = jnp.einsum('bnhts,bnshv->bnthv', att, v)
    k_w = jnp.exp((C - 1.0 - idx)[:, None] * log_g)
    q_w = jnp.exp((idx + 1.0)[:, None] * log_g)
    ds = jnp.einsum('bnshd,sh,bnshv->bnhdv', k, k_w, v)
    chunk_dec = jnp.exp(C * log_g)[None, :, None, None]

    def step(state, ds_n):
        return state * chunk_dec + ds_n, state

    _, s_prev = lax.scan(step, jnp.zeros((B, H, dk, dv), f32), jnp.moveaxis(ds, 1, 0))
    s_prev = jnp.moveaxis(s_prev, 0, 1)
    o = o + jnp.einsum('bnthd,bnhdv->bnthv', q, s_prev) * q_w[:, :, None]
    mean = jnp.mean(o, -1, keepdims=True)
    var = jnp.mean(jnp.square(o - mean), -1, keepdims=True)
    o = (o - mean) * lax.rsqrt(var + NORM_EPS)
    return o.reshape(B, S, D_BR) * gn_g.astype(f32)


def _rglru(xb, conv_w, conv_b, wa, ba, wx, bx, lam):
    B, S, _ = xb.shape
    f32 = jnp.float32
    xc = lax.conv_general_dilated(xb, conv_w[:, None, :], window_strides=(1,), padding=[(LRU_CONV - 1, 0)],
                                  dimension_numbers=('NWC', 'WIO', 'NWC'), feature_group_count=D_BR) + conv_b
    xh = xc.reshape(B, S, LRU_BLOCKS, LRU_BW)
    r = jax.nn.sigmoid((jnp.einsum('bsnc,ncd->bsnd', xh, wa).reshape(B, S, D_BR) + ba).astype(f32))
    i = jax.nn.sigmoid((jnp.einsum('bsnc,ncd->bsnd', xh, wx).reshape(B, S, D_BR) + bx).astype(f32))
    log_a = -LRU_C * r * jax.nn.softplus(-lam.astype(f32))
    a = jnp.exp(log_a)
    u = jnp.sqrt(-jnp.expm1(2.0 * log_a)) * (i * xc.astype(f32))

    def combine(left, right):
        a1, b1 = left
        a2, b2 = right
        return a1 * a2, a2 * b1 + b2

    _, h = lax.associative_scan(combine, (a, u), axis=1)
    return h


def _mixer_sublayer(un, positions, w_in, rw_mu, rw_w0, rw_w2, rw_a0, rw_a2, rw_k_k, rw_k_a, rw_r_k,
                    rw_ln_g, rw_ln_b, gla_f_up, gla_f_b, gla_norm_g, ret_gn_g, lru_conv_w, lru_conv_b,
                    lru_wa, lru_ba, lru_wx, lru_bx, lru_lambda, w_branch, w_out):
    B, S, _ = un.shape
    f32 = jnp.float32
    z = un @ w_in
    p = dict(zip([n for n, _ in IN_SPLITS], _split_last(z, [w for _, w in IN_SPLITS])))
    mu_r, mu_k, mu_v, mu_w, mu_a = _split_last(rw_mu, [D_BR, D_BR, D_BR, RW_RANK_W, RW_RANK_A])

    y_rw = _rwkv7(_token_shift(p['rw_r'], mu_r), _token_shift(p['rw_k'], mu_k), _token_shift(p['rw_v'], mu_v),
                  _token_shift(p['rw_wlo'], mu_w), _token_shift(p['rw_alo'], mu_a),
                  rw_w0, rw_w2, rw_a0, rw_a2, rw_k_k, rw_k_a, rw_r_k, rw_ln_g, rw_ln_b)
    y_rw = y_rw * jax.nn.silu(p['rw_g'].astype(f32))
    y_gla = _gla(p['gla_q'], p['gla_k'], p['gla_v'], p['gla_flo'], gla_f_up, gla_f_b, gla_norm_g)
    y_gla = y_gla * jax.nn.silu(p['gla_g'].astype(f32))
    y_ret = _retention(p['ret_q'], p['ret_k'], p['ret_v'], positions, ret_gn_g)
    y_ret = y_ret * jax.nn.silu(p['ret_g'].astype(f32))
    y_lru = _rglru(p['lru_x'], lru_conv_w, lru_conv_b, lru_wa, lru_ba, lru_wx, lru_bx, lru_lambda)
    y_lru = y_lru * jax.nn.silu(p['lru_g'].astype(f32))

    gates = p['merge'].reshape(B, S, N_BRANCH, D_MODEL)
    branches = (y_rw, y_gla, y_ret, y_lru)
    merged = jnp.zeros_like(un)
    for n in range(N_BRANCH):
        merged = merged + jax.nn.sigmoid(gates[:, :, n]) * (branches[n].astype(un.dtype) @ w_branch[n])
    return merged @ w_out


def _cross_attn(xn, mn, wq, wkv, wo):
    B, S, _ = xn.shape
    M = mn.shape[1]
    q = (xn @ wq).reshape(B, S, XA_HEADS, XA_HD)
    k, v = jnp.split(mn @ wkv, 2, axis=-1)
    k = k.reshape(B, M, XA_HEADS, XA_HD)
    v = v.reshape(B, M, XA_HEADS, XA_HD)
    s = jnp.einsum('bshd,bmhd->bhsm', q, k).astype(jnp.float32) * XA_HD ** -0.5
    pr = jax.nn.softmax(s, axis=-1).astype(xn.dtype)
    o = jnp.einsum('bhsm,bmhd->bshd', pr, v).reshape(B, S, D_MODEL)
    return o @ wo


def setup_inputs(seed: int = 0) -> dict:
    key = jax.random.key(seed)
    k = jax.random.split(key, 40)
    f32 = jnp.float32
    nrm = lambda kk, shape, scale: scale * jax.random.normal(kk, shape, f32)
    gain = lambda kk, shape: 1.0 + 0.02 * jax.random.normal(kk, shape, f32)
    L = DEPTH
    x = jax.random.normal(k[0], (BATCH, SEQ, D_MODEL), f32)
    mem = jax.random.normal(k[1], (BATCH, N_MEM, D_MODEL), f32)
    positions = (jnp.arange(SEQ, dtype=jnp.int32)[None, :]
                 + jax.random.randint(k[2], (BATCH, 1), 0, 1024, dtype=jnp.int32))
    a_init = jax.random.uniform(k[3], (L, D_BR), f32, 0.9, 0.999)
    s_init = a_init ** (1.0 / LRU_C)
    lru_lambda = jnp.log(s_init) - jnp.log1p(-s_init)
    return {
        'x': x,
        'mem': mem,
        'positions': positions,
        'mix_norm_g': gain(k[4], (L, D_MODEL)),
        'w_in': nrm(k[5], (L, D_MODEL, N_IN), D_MODEL ** -0.5),
        'rw_mu': jax.random.uniform(k[6], (L, RW_SHIFT), f32),
        'rw_w0': nrm(k[7], (L, D_BR), 0.5),
        'rw_w2': nrm(k[8], (L, RW_RANK_W, D_BR), RW_RANK_W ** -0.5),
        'rw_a0': nrm(k[9], (L, D_BR), 0.5),
        'rw_a2': nrm(k[10], (L, RW_RANK_A, D_BR), RW_RANK_A ** -0.5),
        'rw_k_k': 1.0 + nrm(k[11], (L, D_BR), 0.1),
        'rw_k_a': 1.0 + nrm(k[12], (L, D_BR), 0.1),
        'rw_r_k': nrm(k[13], (L, RW_HEADS, RW_HD), 0.1),
        'rw_ln_g': gain(k[14], (L, D_BR)),
        'rw_ln_b': nrm(k[15], (L, D_BR), 0.01),
        'gla_f_up': nrm(k[16], (L, GLA_RANK, GLA_DK), GLA_RANK ** -0.5),
        'gla_f_b': nrm(k[17], (L, GLA_DK), 0.1),
        'gla_norm_g': gain(k[18], (L, D_BR)),
        'ret_gn_g': gain(k[19], (L, D_BR)),
        'lru_conv_w': nrm(k[20], (L, LRU_CONV, D_BR), LRU_CONV ** -0.5),
        'lru_conv_b': nrm(k[21], (L, D_BR), 0.01),
        'lru_wa': nrm(k[22], (L, LRU_BLOCKS, LRU_BW, LRU_BW), LRU_BW ** -0.5),
        'lru_ba': nrm(k[23], (L, D_BR), 0.01),
        'lru_wx': nrm(k[24], (L, LRU_BLOCKS, LRU_BW, LRU_BW), LRU_BW ** -0.5),
        'lru_bx': nrm(k[25], (L, D_BR), 0.01),
        'lru_lambda': lru_lambda,
        'w_branch': nrm(k[26], (L, N_BRANCH, D_BR, D_MODEL), D_BR ** -0.5),
        'w_out': nrm(k[27], (L, D_MODEL, D_MODEL), D_MODEL ** -0.5),
        'xa_norm_g': gain(k[28], (L, D_MODEL)),
        'xa_mem_norm_g': gain(k[29], (L, D_MODEL)),
        'xa_wq': nrm(k[30], (L, D_MODEL, D_MODEL), D_MODEL ** -0.5),
        'xa_wkv': nrm(k[31], (L, D_MODEL, 2 * D_MODEL), D_MODEL ** -0.5),
        'xa_wo': nrm(k[32], (L, D_MODEL, D_MODEL), D_MODEL ** -0.5),
        'final_norm_g': gain(k[33], (D_MODEL,)),
    }


def reference(x, mem, positions, mix_norm_g, w_in, rw_mu, rw_w0, rw_w2, rw_a0, rw_a2, rw_k_k, rw_k_a,
              rw_r_k, rw_ln_g, rw_ln_b, gla_f_up, gla_f_b, gla_norm_g, ret_gn_g, lru_conv_w, lru_conv_b,
              lru_wa, lru_ba, lru_wx, lru_bx, lru_lambda, w_branch, w_out, xa_norm_g, xa_mem_norm_g,
              xa_wq, xa_wkv, xa_wo, final_norm_g):
    h = x
    for l in range(DEPTH):
        un = _rmsnorm(h, mix_norm_g[l])
        h = h + _mixer_sublayer(un, positions, w_in[l], rw_mu[l], rw_w0[l], rw_w2[l], rw_a0[l], rw_a2[l],
                                rw_k_k[l], rw_k_a[l], rw_r_k[l], rw_ln_g[l], rw_ln_b[l], gla_f_up[l],
                                gla_f_b[l], gla_norm_g[l], ret_gn_g[l], lru_conv_w[l], lru_conv_b[l],
                                lru_wa[l], lru_ba[l], lru_wx[l], lru_bx[l], lru_lambda[l], w_branch[l], w_out[l])
        xn = _rmsnorm(h, xa_norm_g[l])
        mn = _rmsnorm(mem, xa_mem_norm_g[l])
        h = h + _cross_attn(xn, mn, xa_wq[l], xa_wkv[l], xa_wo[l])
    return _rmsnorm(h, final_norm_g)
```

```cpp
#include <hip/hip_runtime.h>
#include <hip/hip_cooperative_groups.h>
#include <cstdio>
namespace cg = cooperative_groups;

typedef unsigned short bf16_t;
typedef short bf16x8 __attribute__((ext_vector_type(8)));
typedef float f32x4 __attribute__((ext_vector_type(4)));
typedef unsigned u32x4 __attribute__((ext_vector_type(4)));
typedef unsigned u32x2 __attribute__((ext_vector_type(2)));
#define LAS __attribute__((address_space(3)))

constexpr int TB = 16384;
constexpr int DM = 1024;
constexpr int NIN = 10384;
constexpr int NCH = 128, LCH = 128;

constexpr size_t SZ_WIN = (size_t)10752 * 1024 * 2;
constexpr size_t OFF_WIN = 0;
constexpr size_t OFF_WB = OFF_WIN + SZ_WIN;
constexpr size_t OFF_WOUT = OFF_WB + (size_t)4 * 1024 * 512 * 2;
constexpr size_t OFF_WQ = OFF_WOUT + (size_t)1024 * 1024 * 2;
constexpr size_t OFF_WKV = OFF_WQ + (size_t)1024 * 1024 * 2;
constexpr size_t OFF_WO = OFF_WKV + (size_t)2048 * 1024 * 2;
constexpr size_t OFF_UN = OFF_WO + (size_t)1024 * 1024 * 2;
constexpr size_t OFF_MN = OFF_UN + (size_t)TB * 1024 * 2;
constexpr size_t OFF_KM = OFF_MN + (size_t)512 * 1024 * 2;
constexpr size_t OFF_VT = OFF_KM + (size_t)512 * 1024 * 2;
constexpr size_t OFF_ZRW = OFF_VT + (size_t)512 * 1024 * 2;
constexpr size_t OFF_ZGLA = OFF_ZRW + (size_t)TB * 1792 * 2;
constexpr size_t OFF_ZRET = OFF_ZGLA + (size_t)TB * 1280 * 2;
constexpr size_t OFF_ZLRU = OFF_ZRET + (size_t)TB * 1024 * 2;
constexpr size_t OFF_ZG = OFF_ZLRU + (size_t)TB * 512 * 2;
constexpr size_t OFF_MRG = OFF_ZG + (size_t)TB * 2048 * 2;
constexpr size_t OFF_PREP = OFF_MRG + (size_t)TB * 1024 * 2;
constexpr size_t SZ_F = (size_t)TB * 512 * 4;
constexpr size_t OFF_PW = OFF_PREP, OFF_PKK = OFF_PW + SZ_F, OFF_PB = OFF_PKK + SZ_F, OFF_PKM = OFF_PB + SZ_F, OFF_PR = OFF_PKM + SZ_F;
constexpr size_t OFF_PV = OFF_PR + SZ_F;
constexpr size_t OFF_BON = OFF_PV + (size_t)TB * 512 * 2;
constexpr size_t OFF_END = OFF_BON + (size_t)TB * 8 * 4;
constexpr size_t OFF_G = OFF_ZRW;
constexpr size_t OFF_Q = OFF_ZRW;
constexpr size_t OFF_P = OFF_Q + (size_t)TB * 1024 * 2;
constexpr size_t OFF_O = OFF_P + (size_t)TB * 1024 * 2;
constexpr size_t OFF_PP = OFF_MRG;
constexpr size_t OFF_PL = OFF_MRG + (size_t)8 * NCH * 4096 * 4;
constexpr size_t OFF_DSG = OFF_PREP;
constexpr size_t OFF_DEC = OFF_DSG + (size_t)2 * 256 * 4 * 64 * 128 * 4;
constexpr size_t OFF_HL = OFF_DEC + (size_t)256 * 4 * 64 * 4;
constexpr size_t OFF_CA = OFF_HL + SZ_F;
constexpr size_t OFF_AC = OFF_CA + SZ_F;
constexpr size_t OFF_HC = OFF_AC + (size_t)256 * 512 * 4;
constexpr size_t OFF_HIN = OFF_HC + (size_t)256 * 512 * 4;
static_assert(OFF_HIN + 256 * 512 * 4 <= OFF_END, "overlay");
static_assert(OFF_END <= (size_t)512 * 1024 * 1024, "ws");

struct Params { const void* in[34]; float* out; unsigned char* ws; };
typedef const Params __attribute__((address_space(4)))* KP;
__device__ __forceinline__ KP kparams() { KP p = (KP)__builtin_amdgcn_kernarg_segment_ptr(); asm volatile("" : "+s"(p)); return p; }

__device__ __forceinline__ float bf2f(bf16_t v) { return __uint_as_float(((unsigned)v) << 16); }
__device__ __forceinline__ bf16_t f2bf(float f) { unsigned u = __float_as_uint(f); u += 0x7fffu + ((u >> 16) & 1u); return (bf16_t)(u >> 16); }
__device__ __forceinline__ unsigned cvt_pk_bf16(float lo, float hi) { unsigned r; asm("v_cvt_pk_bf16_f32 %0, %1, %2" : "=v"(r) : "v"(lo), "v"(hi)); return r; }
__device__ __forceinline__ float shx(float v, int lane, int o) { return __int_as_float(__builtin_amdgcn_ds_bpermute((lane ^ o) << 2, __float_as_int(v))); }
__device__ __forceinline__ float wave_sum(float v, int lane) {
#pragma unroll
    for (int o = 32; o >= 1; o >>= 1) v += shx(v, lane, o);
    return v; }
__device__ __forceinline__ float rlane(float v, int k) { return __int_as_float(__builtin_amdgcn_readlane(__float_as_int(v), k)); }
__device__ __forceinline__ float sigmoidf_(float x) { return 1.0f / (1.0f + __expf(-x)); }
__device__ __forceinline__ float siluf_(float x) { return x / (1.0f + __expf(-x)); }
__device__ __forceinline__ float softplusf_(float y) { return fmaxf(y, 0.f) + __logf(1.0f + __expf(-fabsf(y))); }
__device__ __forceinline__ float tanhf_(float x) { float e = __expf(2.0f * x); return 1.0f - 2.0f / (e + 1.0f); }

__device__ __forceinline__ int otid() { int t = threadIdx.x; asm volatile("" : "+v"(t)); return t; }
__device__ __forceinline__ int obid() { int t = blockIdx.x; asm volatile("" : "+s"(t)); return t; }

namespace pg8 {
constexpr int BM = 256, BK = 64, HALF = 128, HTB = HALF * BK * 2, STAGE_BYTES = 8 * HTB, NXCD = 8, WGM = 8;
__device__ __forceinline__ int lds_byte(int r, int c) { const int st = (r >> 4) * 2 + (c >> 5), rr = r & 15, cc = c & 31, ob = rr * 64 + cc * 2; return st * 1024 + (ob ^ (((ob >> 9) & 1) << 5)); }
__device__ __forceinline__ void stage_rc(int b, int& R, int& C) { const int st = b / 1024, sb = b % 1024, swz = sb ^ (((sb >> 9) & 1) << 5); R = (st >> 1) * 16 + swz / 64; C = (st & 1) * 32 + (swz % 64) / 2; }
__device__ __forceinline__ int perm32(int rho) { const int n = rho >> 4, i = rho & 15; return 8 * (i >> 2) + 4 * n + (i & 3); }

struct Unit { int pm, pn, aux; const char* pa; const char* pb; };
struct Gemm { int lda, ldb, K; };

struct Order {
    int nM, nN, nwg, G, c, rep;
    const char* A; const char* B;
    long tA, tB, aPn, aRep, bRep;
    __device__ void init(int nM_, int nN_, int rep_, const void* A_, const void* B_, long tA_, long tB_, long aPn_, long aRep_, long bRep_) {
        nM = nM_; nN = nN_; nwg = nM * nN; G = gridDim.x; c = obid(); rep = rep_; A = (const char*)A_; B = (const char*)B_; tA = tA_; tB = tB_; aPn = aPn_; aRep = aRep_; bRep = bRep_; }
    __device__ bool next(int i, Unit& u) const {
        const int ti = i / rep, r = i - ti * rep;
        const long L = (long)ti * G + c; if (L >= nwg) return false;
        int wgid = (int)L; { const int q = nwg / NXCD, rr = nwg % NXCD, xcd = wgid % NXCD, off = wgid / NXCD; wgid = (xcd < rr ? xcd * (q + 1) : rr * (q + 1) + (xcd - rr) * q) + off; }
        const int nig = WGM * nN, gid = wgid / nig, fm = gid * WGM, gsz = (nM - fm) < WGM ? (nM - fm) : WGM;
        u.pm = fm + ((wgid % nig) % gsz); u.pn = (wgid % nig) / gsz; u.aux = r;
        u.pa = A + (long)u.pm * tA + (long)u.pn * aPn + (long)r * aRep;
        u.pb = B + (long)u.pn * tB + (long)r * bRep;
        return true; }
};

template <class Epi>
__device__ __forceinline__ void gemm_phase(LAS unsigned char* lds, const Gemm g, const Order& S, const Epi& E) {
    const int tid = otid(), wid = __builtin_amdgcn_readfirstlane(tid >> 6), lane = tid & 63, wr = wid >> 2, wc = wid & 3, fr = lane & 15, fq = lane >> 4;
    const int K = g.K, nt = K / BK;
    unsigned voffA[2], voffB[2];
#pragma unroll
    for (int i = 0; i < 2; ++i) { int R, C; stage_rc(tid * 16 + i * 8192, R, C); const int Rb = Epi::PERM ? ((R & ~31) + perm32(R & 31)) : R;
        voffA[i] = (unsigned)(R * g.lda + C) * 2u; voffB[i] = (unsigned)(Rb * g.ldb + C) * 2u; }
    const size_t kstep = (size_t)(BK * 2);
    const size_t hstepA = (size_t)HALF * g.lda * 2, hstepB = (size_t)HALF * g.ldb * 2;
    const unsigned ldsw = (unsigned)wid * 1024u;
    const int aoff = lds_byte(wr * 64 + fr, fq * 8), boff = lds_byte(wc * 32 + fr, fq * 8);
#define PG8_SA(b, h) (((b) * 2 + (h)) * HTB)
#define PG8_SB(b, h) ((4 + (b) * 2 + (h)) * HTB)
#define PG8_STAGE(bufoff, gbase, voff) do { _Pragma("unroll") for (int _i = 0; _i < 2; ++_i) \
        __builtin_amdgcn_global_load_lds((const unsigned*)((const char*)(gbase) + (voff)[_i]), (LAS unsigned*)(lds + (bufoff) + ldsw + _i * 8192), 16, 0, 0); } while (0)
#define PG8_LDA(dst, b, h) do { _Pragma("unroll") for (int m = 0; m < 4; ++m) _Pragma("unroll") for (int k = 0; k < 2; ++k) dst[m][k] = *(const LAS bf16x8*)(lds + PG8_SA(b, h) + aoff + m * 2048 + k * 1024); } while (0)
#define PG8_LDB(dst, b, h) do { _Pragma("unroll") for (int n = 0; n < 2; ++n) _Pragma("unroll") for (int k = 0; k < 2; ++k) dst[n][k] = *(const LAS bf16x8*)(lds + PG8_SB(b, h) + boff + n * 2048 + k * 1024); } while (0)
#define PG8_MMA(ai, bj, At, Bt) do { __builtin_amdgcn_s_setprio(1); _Pragma("unroll") for (int m = 0; m < 4; ++m) _Pragma("unroll") for (int n = 0; n < 2; ++n) _Pragma("unroll") for (int k = 0; k < 2; ++k) \
        acc[ai][bj][m][n] = __builtin_amdgcn_mfma_f32_16x16x32_bf16(Bt[n][k], At[m][k], acc[ai][bj][m][n], 0, 0, 0); __builtin_amdgcn_s_setprio(0); } while (0)
#define PG8_WAIT_V(n) asm volatile("s_waitcnt vmcnt(" #n ")" ::: "memory")
#define PG8_WAIT_L(n) asm volatile("s_waitcnt lgkmcnt(" #n ")" ::: "memory")
#define PG8_BAR __builtin_amdgcn_s_barrier()
#define PG8_SCHED __builtin_amdgcn_sched_barrier(0)
    Unit cur, nxt; int ui = 0;
    if (!S.next(0, cur)) return;
    f32x4 acc[2][2][4][2];
#pragma unroll
    for (int a = 0; a < 2; ++a)
#pragma unroll
        for (int b = 0; b < 2; ++b)
#pragma unroll
            for (int m = 0; m < 4; ++m)
#pragma unroll
                for (int n = 0; n < 2; ++n) acc[a][b][m][n] = (f32x4){0.f, 0.f, 0.f, 0.f};
    bf16x8 At[4][2], B0[2][2], B1[2][2];
    const char* cA = cur.pa; const char* cB = cur.pb;
    PG8_STAGE(PG8_SB(0, 0), cB, voffB); PG8_STAGE(PG8_SA(0, 0), cA, voffA); PG8_STAGE(PG8_SB(0, 1), cB + hstepB, voffB); PG8_STAGE(PG8_SA(0, 1), cA + hstepA, voffA);
    if (wr == 1) PG8_BAR;
    PG8_WAIT_V(4); PG8_BAR;
    PG8_STAGE(PG8_SB(1, 0), cB + kstep, voffB); PG8_STAGE(PG8_SA(1, 0), cA + kstep, voffA); PG8_STAGE(PG8_SB(1, 1), cB + hstepB + kstep, voffB);
    PG8_WAIT_V(6); PG8_BAR;
    for (;;) {
        const bool has_next = S.next(ui + 1, nxt);
        const char* nA = has_next ? nxt.pa : cA; const char* nB = has_next ? nxt.pb : cB;
        for (int t = 0; t < nt; t += 2) {
            const bool last = (t == nt - 2);
            const char* a1 = cA + (size_t)(t + 1) * kstep;
            const char* a2 = last ? nA : cA + (size_t)(t + 2) * kstep; const char* b2 = last ? nB : cB + (size_t)(t + 2) * kstep;
            const char* a3 = a2 + kstep; const char* b3 = b2 + kstep;
            PG8_LDB(B0, 0, 0); PG8_SCHED; PG8_LDA(At, 0, 0); PG8_STAGE(PG8_SA(1, 1), a1 + hstepA, voffA);
            PG8_WAIT_L(8); PG8_BAR; PG8_WAIT_L(0); PG8_MMA(0, 0, At, B0); PG8_BAR; PG8_SCHED;
            PG8_LDB(B1, 0, 1); PG8_STAGE(PG8_SB(0, 0), b2, voffB);
            PG8_BAR; PG8_WAIT_L(0); PG8_MMA(0, 1, At, B1); PG8_BAR;
            PG8_LDA(At, 0, 1); PG8_STAGE(PG8_SA(0, 0), a2, voffA);
            PG8_BAR; PG8_WAIT_L(0); PG8_MMA(1, 0, At, B0); PG8_BAR; PG8_SCHED;
            PG8_STAGE(PG8_SB(0, 1), b2 + hstepB, voffB);
            PG8_WAIT_V(6); PG8_BAR; PG8_MMA(1, 1, At, B1); PG8_BAR;
            PG8_LDB(B0, 1, 0); PG8_SCHED; PG8_LDA(At, 1, 0); PG8_STAGE(PG8_SA(0, 1), a2 + hstepA, voffA);
            PG8_WAIT_L(8); PG8_BAR; PG8_WAIT_L(0); PG8_MMA(0, 0, At, B0); PG8_BAR; PG8_SCHED;
            PG8_LDB(B1, 1, 1); PG8_STAGE(PG8_SB(1, 0), b3, voffB);
            PG8_BAR; PG8_WAIT_L(0); PG8_MMA(0, 1, At, B1); PG8_BAR;
            PG8_LDA(At, 1, 1); PG8_STAGE(PG8_SA(1, 0), a3, voffA);
            PG8_BAR; PG8_WAIT_L(0); PG8_MMA(1, 0, At, B0); PG8_BAR; PG8_SCHED;
            PG8_STAGE(PG8_SB(1, 1), b3 + hstepB, voffB);
            PG8_WAIT_V(6); PG8_BAR; PG8_MMA(1, 1, At, B1); PG8_BAR;
        }
        E(acc, cur, wr, wc, fr, fq);
        if (!has_next) break;
#pragma unroll
        for (int a = 0; a < 2; ++a)
#pragma unroll
            for (int b = 0; b < 2; ++b)
#pragma unroll
                for (int m = 0; m < 4; ++m)
#pragma unroll
                    for (int n = 0; n < 2; ++n) acc[a][b][m][n] = (f32x4){0.f, 0.f, 0.f, 0.f};
        cur = nxt; cA = nA; cB = nB; ++ui;
    }
    PG8_WAIT_V(0);
    if (wr == 0) PG8_BAR;
    PG8_BAR;
#undef PG8_SA
#undef PG8_SB
#undef PG8_STAGE
#undef PG8_LDA
#undef PG8_LDB
#undef PG8_MMA
#undef PG8_WAIT_V
#undef PG8_WAIT_L
#undef PG8_BAR
#undef PG8_SCHED
}

typedef f32x4 Acc[2][2][4][2];

struct EpiInproj {
    static constexpr bool PERM = true;
    unsigned char* ws;
    __device__ __forceinline__ void operator()(Acc& acc, const Unit& u, int wr, int wc, int fr, int fq) const {
        int pn = u.pn, ld, colt; size_t off;
        if (pn < 7) { off = OFF_ZRW; ld = 1792; colt = pn * 256; }
        else if (pn < 12) { off = OFF_ZGLA; ld = 1280; colt = (pn - 7) * 256; }
        else if (pn < 16) { off = OFF_ZRET; ld = 1024; colt = (pn - 12) * 256; }
        else if (pn < 18) { off = OFF_ZLRU; ld = 512; colt = (pn - 16) * 256; }
        else { off = OFF_ZG; ld = 2048; colt = (pn - 18) * 256; }
        bf16_t* base = (bf16_t*)(ws + off);
        const int row0 = u.pm * BM + wr * 64 + fr, col0 = colt + wc * 32 + 8 * fq;
#pragma unroll
        for (int ai = 0; ai < 2; ++ai)
#pragma unroll
            for (int m = 0; m < 4; ++m) { bf16_t* rowp = base + (size_t)(row0 + ai * HALF + m * 16) * ld + col0;
#pragma unroll
                for (int bj = 0; bj < 2; ++bj) { const f32x4 v0 = acc[ai][bj][m][0], v1 = acc[ai][bj][m][1];
                    u32x4 w; w.x = cvt_pk_bf16(v0[0], v0[1]); w.y = cvt_pk_bf16(v0[2], v0[3]); w.z = cvt_pk_bf16(v1[0], v1[1]); w.w = cvt_pk_bf16(v1[2], v1[3]);
                    *(u32x4*)(rowp + bj * HALF) = w; } }
    }
};
template <int ACT> struct EpiBf16 {
    static constexpr bool PERM = true;
    bf16_t* O; int ldc; float scale;
    __device__ __forceinline__ void operator()(Acc& acc, const Unit& u, int wr, int wc, int fr, int fq) const {
        const int row0 = u.pm * BM + wr * 64 + fr, col0 = u.pn * BM + wc * 32 + 8 * fq;
#pragma unroll
        for (int ai = 0; ai < 2; ++ai)
#pragma unroll
            for (int m = 0; m < 4; ++m) { bf16_t* rowp = O + (size_t)(row0 + ai * HALF + m * 16) * ldc + col0;
#pragma unroll
                for (int bj = 0; bj < 2; ++bj) { f32x4 v0 = acc[ai][bj][m][0], v1 = acc[ai][bj][m][1];
                    if (ACT == 1) {
#pragma unroll
                        for (int j = 0; j < 4; ++j) { v0[j] = sigmoidf_(v0[j]); v1[j] = sigmoidf_(v1[j]); } }
                    else { v0 = v0 * scale; v1 = v1 * scale; }
                    u32x4 w; w.x = cvt_pk_bf16(v0[0], v0[1]); w.y = cvt_pk_bf16(v0[2], v0[3]); w.z = cvt_pk_bf16(v1[0], v1[1]); w.w = cvt_pk_bf16(v1[2], v1[3]);
                    *(u32x4*)(rowp + bj * HALF) = w; } }
    }
};
struct EpiKV {
    static constexpr bool PERM = true;
    bf16_t* KM; bf16_t* VT;
    __device__ __forceinline__ void operator()(Acc& acc, const Unit& u, int wr, int wc, int fr, int fq) const {
        const int row0 = u.pm * BM + wr * 64 + fr, col0 = u.pn * BM + wc * 32 + 8 * fq;
#pragma unroll
        for (int ai = 0; ai < 2; ++ai)
#pragma unroll
            for (int m = 0; m < 4; ++m) { const int row = row0 + ai * HALF + m * 16;
#pragma unroll
                for (int bj = 0; bj < 2; ++bj)
#pragma unroll
                    for (int n = 0; n < 2; ++n)
#pragma unroll
                        for (int j = 0; j < 4; ++j) { const int col = col0 + bj * HALF + 4 * n + j; const bf16_t v = f2bf(acc[ai][bj][m][n][j]);
                            if (col < 1024) KM[(size_t)row * 1024 + col] = v;
                            else VT[((size_t)(row >> 8) * 1024 + (col - 1024)) * 256 + (row & 255)] = v; } }
    }
};
struct EpiMerge {
    static constexpr bool PERM = true;
    const bf16_t* G; bf16_t* MRG;
    __device__ __forceinline__ void operator()(Acc& acc, const Unit& u, int wr, int wc, int fr, int fq) const {
        const int row0 = u.pm * BM + wr * 64 + fr, col0 = u.pn * BM + wc * 32 + 8 * fq;
#pragma unroll
        for (int ai = 0; ai < 2; ++ai)
#pragma unroll
            for (int m = 0; m < 4; ++m) { const size_t row = (size_t)(row0 + ai * HALF + m * 16);
#pragma unroll
                for (int bj = 0; bj < 2; ++bj) { const f32x4 v0 = acc[ai][bj][m][0], v1 = acc[ai][bj][m][1];
                    const u32x4 gq = *(const u32x4*)(G + row * 4096 + u.aux * 1024 + col0 + bj * HALF);
                    bf16_t* mp = MRG + row * 1024 + col0 + bj * HALF;
                    float o[8] = {0.f, 0.f, 0.f, 0.f, 0.f, 0.f, 0.f, 0.f};
                    if (u.aux > 0) { const u32x4 mq = *(const u32x4*)mp;
#pragma unroll
                        for (int e = 0; e < 4; ++e) { o[2 * e] = __uint_as_float(mq[e] << 16); o[2 * e + 1] = __uint_as_float(mq[e] & 0xffff0000u); } }
#pragma unroll
                    for (int e = 0; e < 4; ++e) { const float g0 = __uint_as_float(gq[e] << 16), g1 = __uint_as_float(gq[e] & 0xffff0000u);
                        const float a0 = e < 2 ? v0[2 * e] : v1[2 * e - 4], a1 = e < 2 ? v0[2 * e + 1] : v1[2 * e - 3];
                        o[2 * e] += g0 * a0; o[2 * e + 1] += g1 * a1; }
                    u32x4 w; w.x = cvt_pk_bf16(o[0], o[1]); w.y = cvt_pk_bf16(o[2], o[3]); w.z = cvt_pk_bf16(o[4], o[5]); w.w = cvt_pk_bf16(o[6], o[7]);
                    *(u32x4*)mp = w; } }
    }
};
struct EpiResid {
    static constexpr bool PERM = false;
    const float* hin; float* hout;
    __device__ __forceinline__ void operator()(Acc& acc, const Unit& u, int wr, int wc, int fr, int fq) const {
        const int row0 = u.pm * BM + wr * 64 + fr, col0 = u.pn * BM + wc * 32 + 4 * fq;
#pragma unroll
        for (int ai = 0; ai < 2; ++ai)
#pragma unroll
            for (int m = 0; m < 4; ++m) { const size_t ro = (size_t)(row0 + ai * HALF + m * 16) * 1024 + col0;
#pragma unroll
                for (int bj = 0; bj < 2; ++bj)
#pragma unroll
                    for (int n = 0; n < 2; ++n) { const f32x4 r = *(const f32x4*)(hin + ro + bj * HALF + n * 16);
                        *(f32x4*)(hout + ro + bj * HALF + n * 16) = r + acc[ai][bj][m][n]; } }
    }
};
struct EpiSoftmax {
    static constexpr bool PERM = true;
    bf16_t* P; LAS float* xs;
    __device__ __forceinline__ void operator()(Acc& acc, const Unit& u, int wr_, int wc_, int fr_, int fq_) const {
        const int tid2 = otid(), wid2 = tid2 >> 6, wr = wid2 >> 2, wc = wid2 & 3, fr = tid2 & 15, fq = (tid2 >> 4) & 3;
#pragma unroll
        for (int ai = 0; ai < 2; ++ai)
#pragma unroll
            for (int m = 0; m < 4; ++m) { float v = -3.0e38f;
#pragma unroll
                for (int bj = 0; bj < 2; ++bj)
#pragma unroll
                    for (int n = 0; n < 2; ++n)
#pragma unroll
                        for (int j = 0; j < 4; ++j) v = fmaxf(v, acc[ai][bj][m][n][j]);
                xs[(ai * HALF + wr * 64 + m * 16 + fr) * 16 + wc * 4 + fq] = v; }
        asm volatile("s_waitcnt lgkmcnt(0)\n\ts_barrier" ::: "memory");
        float sums[2][4];
#pragma unroll
        for (int ai = 0; ai < 2; ++ai)
#pragma unroll
            for (int m = 0; m < 4; ++m) { const int rl = ai * HALF + wr * 64 + m * 16 + fr;
                f32x4 q = *(const LAS f32x4*)(xs + rl * 16);
#pragma unroll
                for (int e = 1; e < 4; ++e) { const f32x4 q2 = *(const LAS f32x4*)(xs + rl * 16 + 4 * e); q[0] = fmaxf(q[0], q2[0]); q[1] = fmaxf(q[1], q2[1]); q[2] = fmaxf(q[2], q2[2]); q[3] = fmaxf(q[3], q2[3]); }
                const float M = fmaxf(fmaxf(q[0], q[1]), fmaxf(q[2], q[3]));
                float sv = 0.f;
#pragma unroll
                for (int bj = 0; bj < 2; ++bj)
#pragma unroll
                    for (int n = 0; n < 2; ++n)
#pragma unroll
                        for (int j = 0; j < 4; ++j) { const float e = __expf(acc[ai][bj][m][n][j] - M); acc[ai][bj][m][n][j] = e; sv += e; }
                sums[ai][m] = sv; }
        asm volatile("s_waitcnt lgkmcnt(0)\n\ts_barrier" ::: "memory");
#pragma unroll
        for (int ai = 0; ai < 2; ++ai)
#pragma unroll
            for (int m = 0; m < 4; ++m) xs[(ai * HALF + wr * 64 + m * 16 + fr) * 16 + wc * 4 + fq] = sums[ai][m];
        asm volatile("s_waitcnt lgkmcnt(0)\n\ts_barrier" ::: "memory");
        const int row0 = u.pm * BM + wr * 64 + fr, col0 = u.pn * BM + wc * 32 + 8 * fq;
#pragma unroll
        for (int ai = 0; ai < 2; ++ai)
#pragma unroll
            for (int m = 0; m < 4; ++m) { const int rl = ai * HALF + wr * 64 + m * 16 + fr;
                f32x4 q = *(const LAS f32x4*)(xs + rl * 16);
#pragma unroll
                for (int e = 1; e < 4; ++e) q += *(const LAS f32x4*)(xs + rl * 16 + 4 * e);
                const float inv = 1.0f / (q[0] + q[1] + q[2] + q[3]);
                bf16_t* rowp = P + (size_t)(row0 + ai * HALF + m * 16) * 1024 + col0;
#pragma unroll
                for (int bj = 0; bj < 2; ++bj) { const f32x4 v0 = acc[ai][bj][m][0] * inv, v1 = acc[ai][bj][m][1] * inv;
                    u32x4 w; w.x = cvt_pk_bf16(v0[0], v0[1]); w.y = cvt_pk_bf16(v0[2], v0[3]); w.z = cvt_pk_bf16(v1[0], v1[1]); w.w = cvt_pk_bf16(v1[2], v1[3]);
                    *(u32x4*)(rowp + bj * HALF) = w; } }
    }
};
}

__device__ __forceinline__ int win_map(int n) {
    if (n < 1792) return n < 1664 ? n : -1;
    n -= 1792; if (n < 1280) return n < 1040 ? 2176 + n : -1;
    n -= 1280; if (n < 1024) return 3728 + n;
    n -= 1024; if (n < 512) return 5264 + n;
    n -= 512;
    if (n < 512) return 1664 + n;
    if (n < 1024) return 3216 + (n - 512);
    if (n < 1536) return 4752 + (n - 1024);
    if (n < 2048) return 5776 + (n - 1536);
    n -= 2048; return 6288 + n;
}
template <bool WIN>
__device__ void conv_t(bf16_t* dst, const float* src, int ND, int K, int NS) {
    const size_t total = (size_t)ND * (K / 8);
    for (size_t i = (size_t)obid() * 512 + otid(); i < total; i += (size_t)gridDim.x * 512) {
        const int n = (int)(i % ND), ko = (int)(i / ND);
        const int ms = WIN ? win_map(n) : n;
        float v[8];
#pragma unroll
        for (int j = 0; j < 8; ++j) v[j] = ms >= 0 ? src[(size_t)(ko * 8 + j) * NS + ms] : 0.f;
        u32x4 w; w.x = cvt_pk_bf16(v[0], v[1]); w.y = cvt_pk_bf16(v[2], v[3]); w.z = cvt_pk_bf16(v[4], v[5]); w.w = cvt_pk_bf16(v[6], v[7]);
        *(u32x4*)(dst + (size_t)n * K + ko * 8) = w;
    }
}
__device__ void rmsnorm_bf16(const float* src, const float* g, bf16_t* dst, int rows) {
    const int lane = otid() & 63, gw = obid() * 8 + (otid() >> 6), nw = gridDim.x * 8;
    for (int r = gw; r < rows; r += nw) {
        const float* p = src + (size_t)r * 1024; f32x4 v[4]; float ss = 0.f;
#pragma unroll
        for (int i = 0; i < 4; ++i) { v[i] = *(const f32x4*)(p + i * 256 + lane * 4); ss += v[i][0] * v[i][0] + v[i][1] * v[i][1] + v[i][2] * v[i][2] + v[i][3] * v[i][3]; }
        ss = wave_sum(ss, lane); const float rs = rsqrtf(ss * (1.0f / 1024.0f) + 1e-6f);
#pragma unroll
        for (int i = 0; i < 4; ++i) { const f32x4 gg = *(const f32x4*)(g + i * 256 + lane * 4);
            u32x2 w; w.x = cvt_pk_bf16(v[i][0] * rs * gg[0], v[i][1] * rs * gg[1]); w.y = cvt_pk_bf16(v[i][2] * rs * gg[2], v[i][3] * rs * gg[3]);
            *(u32x2*)(dst + (size_t)r * 1024 + i * 256 + lane * 4) = w; }
    }
}
__device__ void rmsnorm_f32_inplace(float* buf, const float* g, int rows) {
    const int lane = otid() & 63, gw = obid() * 8 + (otid() >> 6), nw = gridDim.x * 8;
    for (int r = gw; r < rows; r += nw) {
        float* p = buf + (size_t)r * 1024; f32x4 v[4]; float ss = 0.f;
#pragma unroll
        for (int i = 0; i < 4; ++i) { v[i] = *(const f32x4*)(p + i * 256 + lane * 4); ss += v[i][0] * v[i][0] + v[i][1] * v[i][1] + v[i][2] * v[i][2] + v[i][3] * v[i][3]; }
        ss = wave_sum(ss, lane); const float rs = rsqrtf(ss * (1.0f / 1024.0f) + 1e-6f);
#pragma unroll
        for (int i = 0; i < 4; ++i) { const f32x4 gg = *(const f32x4*)(g + i * 256 + lane * 4); *(f32x4*)(p + i * 256 + lane * 4) = v[i] * rs * gg; }
    }
}

__device__ void rwkv_prep(KP P, int l) {
    unsigned char* ws = P->ws;
    const int c = otid(), lane = c & 63, h = c >> 6;
    const float* w2 = (const float*)P->in[7] + (size_t)l * 64 * 512; const float* a2 = (const float*)P->in[9] + (size_t)l * 64 * 512;
    const float* mu = (const float*)P->in[5] + (size_t)l * 1664;
    float w2c[64], a2c[64];
#pragma unroll
    for (int j = 0; j < 64; ++j) { w2c[j] = w2[j * 512 + c]; a2c[j] = a2[j * 512 + c]; }
    const float mu_r = mu[c], mu_k = mu[512 + c], mu_v = mu[1024 + c], mu_w = mu[1536 + lane], mu_a = mu[1600 + lane];
    const float w0c = ((const float*)P->in[6])[l * 512 + c], a0c = ((const float*)P->in[8])[l * 512 + c];
    const float kkc = ((const float*)P->in[10])[l * 512 + c], kac = ((const float*)P->in[11])[l * 512 + c], rkc = ((const float*)P->in[12])[l * 512 + c];
    const bf16_t* Z = (const bf16_t*)(ws + OFF_ZRW);
    float* PW = (float*)(ws + OFF_PW); float* PKK = (float*)(ws + OFF_PKK); float* PB = (float*)(ws + OFF_PB); float* PKM = (float*)(ws + OFF_PKM); float* PR = (float*)(ws + OFF_PR);
    bf16_t* PV = (bf16_t*)(ws + OFF_PV); float* BON = (float*)(ws + OFF_BON);
    for (int rng = obid(); rng < TB / 64; rng += gridDim.x) {
        const int t0 = rng * 64;
        float pr = 0.f, pk = 0.f, pv = 0.f, pwl = 0.f, pal = 0.f;
        if (t0 > 0) { const bf16_t* z = Z + (size_t)(t0 - 1) * 1792; pr = bf2f(z[c]); pk = bf2f(z[512 + c]); pv = bf2f(z[1024 + c]); pwl = bf2f(z[1536 + lane]); pal = bf2f(z[1600 + lane]); }
        for (int t = t0; t < t0 + 64; ++t) {
            const bf16_t* z = Z + (size_t)t * 1792;
            const float cr = bf2f(z[c]), ck = bf2f(z[512 + c]), cv = bf2f(z[1024 + c]), cwl = bf2f(z[1536 + lane]), cal = bf2f(z[1600 + lane]);
            const float rs = cr + (pr - cr) * mu_r, ks = ck + (pk - ck) * mu_k, vs = cv + (pv - cv) * mu_v;
            const float wl = tanhf_(cwl + (pwl - cwl) * mu_w), al = cal + (pal - cal) * mu_a;
            float accw = w0c, acca = a0c;
#pragma unroll
            for (int j = 0; j < 64; ++j) { accw += rlane(wl, j) * w2c[j]; acca += rlane(al, j) * a2c[j]; }
            const float logw = -softplusf_(-accw) - 0.5f;
            const float wdec = __expf(-__expf(logw));
            const float a = sigmoidf_(acca);
            const float kraw = ks * kkc;
            const float ss = wave_sum(kraw * kraw, lane);
            const float kk = kraw / fmaxf(sqrtf(ss), 1e-12f);
            const float km = ks * (1.0f + (a - 1.0f) * kac);
            const float bb = kk * a;
            const float bon = wave_sum(rs * km * rkc, lane);
            const size_t o = (size_t)t * 512 + c;
            PW[o] = wdec; PKK[o] = kk; PB[o] = bb; PKM[o] = km; PR[o] = rs; PV[o] = f2bf(vs);
            if (lane == 0) BON[(size_t)t * 8 + h] = bon;
            pr = cr; pk = ck; pv = cv; pwl = cwl; pal = cal;
        }
    }
}
__device__ void rwkv_pass1(KP P) {
    unsigned char* ws = P->ws;
    const int wave = otid() >> 6, lane = otid() & 63;
    if (wave >= 4) return;
    const float* PW = (const float*)(ws + OFF_PW); const float* PKK = (const float*)(ws + OFF_PKK); const float* PB = (const float*)(ws + OFF_PB); const float* PKM = (const float*)(ws + OFF_PKM);
    const bf16_t* PV = (const bf16_t*)(ws + OFF_PV);
    float* PP = (float*)(ws + OFF_PP); float* PL = (float*)(ws + OFF_PL);
    for (int u = obid() * 4 + wave; u < 8 * NCH; u += gridDim.x * 4) {
        const int c = u >> 3, h = u & 7, col = h * 64 + lane;
        float sp[64], sl[64];
#pragma unroll
        for (int k = 0; k < 64; ++k) { sp[k] = (k == lane) ? 1.f : 0.f; sl[k] = 0.f; }
        size_t o = (size_t)c * LCH * 512 + col;
        float wv = PW[o], kkv = PKK[o], bv = PB[o], kmv = PKM[o], vv = bf2f(PV[o]);
        for (int i = 0; i < LCH; ++i) {
            const size_t on = (i + 1 < LCH) ? o + 512 : o;
            const float nwv = PW[on], nkkv = PKK[on], nbv = PB[on], nkmv = PKM[on], nvv = bf2f(PV[on]);
            float sap = 0.f, sal = 0.f;
#pragma unroll
            for (int k = 0; k < 64; ++k) { const float q = rlane(kkv, k); sap += sp[k] * q; sal += sl[k] * q; }
            sap = -sap; sal = -sal;
#pragma unroll
            for (int k = 0; k < 64; ++k) { const float wk = rlane(wv, k), bk = rlane(bv, k), kmk = rlane(kmv, k);
                sp[k] = sp[k] * wk + sap * bk;
                sl[k] = sl[k] * wk + (sal * bk + vv * kmk); }
            o = on; wv = nwv; kkv = nkkv; bv = nbv; kmv = nkmv; vv = nvv;
        }
        float* pp = PP + ((size_t)(h * NCH + c) * 64 + lane) * 64; float* pl = PL + ((size_t)(h * NCH + c) * 64 + lane) * 64;
#pragma unroll
        for (int k = 0; k < 64; k += 4) { *(f32x4*)(pp + k) = (f32x4){sp[k], sp[k + 1], sp[k + 2], sp[k + 3]}; *(f32x4*)(pl + k) = (f32x4){sl[k], sl[k + 1], sl[k + 2], sl[k + 3]}; }
    }
}
__device__ void rwkv_cscan(KP P, float* xs  ) {
    unsigned char* ws = P->ws;
    const int jg = otid() >> 6, lane = otid() & 63;
    const float* PP = (const float*)(ws + OFF_PP); float* PL = (float*)(ws + OFF_PL);
    for (int h = obid(); h < 8; h += gridDim.x) {
        float s[64], mine[8];
#pragma unroll
        for (int k = 0; k < 64; ++k) s[k] = 0.f;
#pragma unroll
        for (int r = 0; r < 8; ++r) mine[r] = 0.f;
        for (int c = 0; c < NCH; ++c) {
            const size_t base = (size_t)(h * NCH + c) * 4096 + (size_t)lane * 64 + 8 * jg;
            const f32x4 p0 = *(const f32x4*)(PP + base), p1 = *(const f32x4*)(PP + base + 4);
            const f32x4 l0 = *(const f32x4*)(PL + base), l1 = *(const f32x4*)(PL + base + 4);
            float nw[8] = {l0[0], l0[1], l0[2], l0[3], l1[0], l1[1], l1[2], l1[3]};
            *(f32x4*)(PL + base) = (f32x4){mine[0], mine[1], mine[2], mine[3]}; *(f32x4*)(PL + base + 4) = (f32x4){mine[4], mine[5], mine[6], mine[7]};
#pragma unroll
            for (int i = 0; i < 64; ++i) { const float si = s[i];
                nw[0] += si * rlane(p0[0], i); nw[1] += si * rlane(p0[1], i); nw[2] += si * rlane(p0[2], i); nw[3] += si * rlane(p0[3], i);
                nw[4] += si * rlane(p1[0], i); nw[5] += si * rlane(p1[1], i); nw[6] += si * rlane(p1[2], i); nw[7] += si * rlane(p1[3], i); }
#pragma unroll
            for (int r = 0; r < 8; ++r) { mine[r] = nw[r]; xs[lane * 65 + 8 * jg + r] = nw[r]; }
            __syncthreads();
#pragma unroll
            for (int k = 0; k < 64; ++k) s[k] = xs[lane * 65 + k];
            __syncthreads();
        }
    }
}
__device__ void rwkv_pass2(KP P, int l) {
    unsigned char* ws = P->ws;
    const int wave = otid() >> 6, lane = otid() & 63;
    if (wave >= 4) return;
    const float* PW = (const float*)(ws + OFF_PW); const float* PKK = (const float*)(ws + OFF_PKK); const float* PB = (const float*)(ws + OFF_PB); const float* PKM = (const float*)(ws + OFF_PKM); const float* PR = (const float*)(ws + OFF_PR);
    const bf16_t* PV = (const bf16_t*)(ws + OFF_PV); const float* BON = (const float*)(ws + OFF_BON);
    const float* PL = (const float*)(ws + OFF_PL); bf16_t* ZG = (bf16_t*)(ws + OFF_ZG);
    for (int u = obid() * 4 + wave; u < 8 * NCH; u += gridDim.x * 4) {
        const int c = u >> 3, h = u & 7, col = h * 64 + lane;
        const float lng = ((const float*)P->in[13])[l * 512 + col], lnb = ((const float*)P->in[14])[l * 512 + col];
        float s[64];
        const float* s0 = PL + ((size_t)(h * NCH + c) * 64 + lane) * 64;
#pragma unroll
        for (int k = 0; k < 64; k += 4) { const f32x4 q = *(const f32x4*)(s0 + k); s[k] = q[0]; s[k + 1] = q[1]; s[k + 2] = q[2]; s[k + 3] = q[3]; }
        int t = c * LCH;
        size_t o = (size_t)t * 512 + col;
        float wv = PW[o], kkv = PKK[o], bv = PB[o], kmv = PKM[o], rv = PR[o], vv = bf2f(PV[o]);
        for (int i = 0; i < LCH; ++i, ++t) {
            const size_t on = (i + 1 < LCH) ? o + 512 : o;
            const float nwv = PW[on], nkkv = PKK[on], nbv = PB[on], nkmv = PKM[on], nrv = PR[on], nvv = bf2f(PV[on]);
            const float gg = bf2f(ZG[(size_t)t * 2048 + col]); const float bon = BON[(size_t)t * 8 + h];
            float sa = 0.f;
#pragma unroll
            for (int k = 0; k < 64; ++k) sa += s[k] * rlane(kkv, k);
            sa = -sa;
            float y = 0.f;
#pragma unroll
            for (int k = 0; k < 64; ++k) { const float wk = rlane(wv, k), bk = rlane(bv, k), kmk = rlane(kmv, k), rk = rlane(rv, k);
                s[k] = s[k] * wk + (sa * bk + vv * kmk);
                y += s[k] * rk; }
            const float mean = wave_sum(y, lane) * (1.0f / 64.0f); const float d = y - mean;
            const float var = wave_sum(d * d, lane) * (1.0f / 64.0f);
            const float yn = d * rsqrtf(var + 64e-5f) * lng + lnb + bon * vv;
            ZG[(size_t)t * 2048 + col] = f2bf(yn * siluf_(gg));
            o = on; wv = nwv; kkv = nkkv; bv = nbv; kmv = nkmv; rv = nrv; vv = nvv;
        }
    }
}

__device__ __forceinline__ void rope_cs(int i, float posf, float& cs, float& sn) {
    const float inv = (float)exp2(-(double)i * (13.287712379549449 / 32.0));
    const float ang = posf * inv;
    const double a = (double)ang; const double kq = rint(a * 0.15915494309189535); const float r = (float)(a - kq * 6.283185307179586);
    cs = __cosf(r); sn = __sinf(r);
}
__device__ __forceinline__ void gr_stage_b(KP P, int l, int kind, int n, int h, float* Bm) {
    const int tid = otid(), t = tid >> 3, dg = tid & 7;
    if (kind == 0) {
        const bf16_t* zr = (const bf16_t*)(P->ws + OFF_ZGLA) + (size_t)(n * 64 + t) * 1280 + 1024;
        float fl[16];
        const u32x4 q0 = *(const u32x4*)zr, q1 = *(const u32x4*)(zr + 8);
#pragma unroll
        for (int e = 0; e < 4; ++e) { fl[2 * e] = __uint_as_float(q0[e] << 16); fl[2 * e + 1] = __uint_as_float(q0[e] & 0xffff0000u); fl[8 + 2 * e] = __uint_as_float(q1[e] << 16); fl[8 + 2 * e + 1] = __uint_as_float(q1[e] & 0xffff0000u); }
        const float* fup = (const float*)P->in[15] + (size_t)l * 16 * 256; const float* fb = (const float*)P->in[16] + (size_t)l * 256;
#pragma unroll
        for (int dd = 0; dd < 8; ++dd) { const int d = dg * 8 + dd; float x = fb[h * 64 + d];
#pragma unroll
            for (int j = 0; j < 16; ++j) x += fl[j] * fup[j * 256 + h * 64 + d];
            Bm[t * 64 + d] = -softplusf_(-x) * (1.0f / 16.0f); }
    } else {
        const float lg = __logf(1.0f - exp2f(-5.0f - (float)h));
#pragma unroll
        for (int dd = 0; dd < 8; ++dd) Bm[t * 64 + dg * 8 + dd] = lg;
    }
    __syncthreads();
    if (tid < 64) { float run = 0.f; for (int tt = 0; tt < 64; ++tt) { run += Bm[tt * 64 + tid]; Bm[tt * 64 + tid] = run; } }
    __syncthreads();
}
__device__ __forceinline__ float gr_qk(KP P, int b, int kind, int which, int tg, int h, int d) {
    if (kind == 0) { const bf16_t* z = (const bf16_t*)(P->ws + OFF_ZGLA) + (size_t)tg * 1280 + which * 256 + h * 64; return bf2f(z[d]); }
    const bf16_t* z = (const bf16_t*)(P->ws + OFF_ZRET) + (size_t)tg * 1024 + which * 256 + h * 64;
    const int i = d & 31; const float x1 = bf2f(z[i]), x2 = bf2f(z[i + 32]);
    const float posf = (float)((const int*)P->in[2])[(size_t)b * TB + tg];
    float cs, sn; rope_cs(i, posf, cs, sn);
    return d < 32 ? x1 * cs - x2 * sn : x1 * sn + x2 * cs;
}
__device__ __forceinline__ const bf16_t* gr_vptr(KP P, int kind, int tg, int h) {
    return kind == 0 ? (const bf16_t*)(P->ws + OFF_ZGLA) + (size_t)tg * 1280 + 512 + h * 128 : (const bf16_t*)(P->ws + OFF_ZRET) + (size_t)tg * 1024 + 512 + h * 128;
}
__device__ void gr_ds(KP P, int l, int b, unsigned char* sm) {
    float* Bm = (float*)sm; bf16_t* KET = (bf16_t*)(sm + 16384); bf16_t* VT = (bf16_t*)(sm + 25600);
    const int tid = otid(), t = tid >> 3, dg = tid & 7, wave = tid >> 6, lane = tid & 63;
    float* DS = (float*)(P->ws + OFF_DSG); float* DEC = (float*)(P->ws + OFF_DEC);
    for (int idx = obid(); idx < 2048; idx += gridDim.x) {
        const int kind = idx >> 10, n = (idx >> 2) & 255, h = idx & 3, tg = n * 64 + t;
        gr_stage_b(P, l, kind, n, h, Bm);
#pragma unroll
        for (int dd = 0; dd < 8; ++dd) { const int d = dg * 8 + dd; const float bl = Bm[63 * 64 + d], bt = Bm[t * 64 + d];
            float kv = gr_qk(P, b, kind, 1, tg, h, d); if (kind == 1) kv *= 0.125f;
            KET[d * 72 + t] = f2bf(kv * __expf(bl - bt));
            if (t == 63 && kind == 0) DEC[(size_t)(n * 4 + h) * 64 + d] = __expf(bl); }
        { const bf16_t* vp = gr_vptr(P, kind, tg, h) + dg * 16;
#pragma unroll
            for (int e = 0; e < 16; ++e) VT[(dg * 16 + e) * 72 + t] = vp[e]; }
        __syncthreads();
        f32x4 acc[4];
#pragma unroll
        for (int mt = 0; mt < 4; ++mt) acc[mt] = (f32x4){0.f, 0.f, 0.f, 0.f};
#pragma unroll
        for (int ks = 0; ks < 2; ++ks) { const bf16x8 bf = *(const bf16x8*)(VT + (wave * 16 + (lane & 15)) * 72 + ks * 32 + (lane >> 4) * 8);
#pragma unroll
            for (int mt = 0; mt < 4; ++mt) { const bf16x8 af = *(const bf16x8*)(KET + (mt * 16 + (lane & 15)) * 72 + ks * 32 + (lane >> 4) * 8);
                acc[mt] = __builtin_amdgcn_mfma_f32_16x16x32_bf16(af, bf, acc[mt], 0, 0, 0); } }
        float* dsp = DS + ((size_t)(kind * 256 + n) * 4 + h) * 64 * 128;
#pragma unroll
        for (int mt = 0; mt < 4; ++mt)
#pragma unroll
            for (int j = 0; j < 4; ++j) dsp[(size_t)(mt * 16 + (lane >> 4) * 4 + j) * 128 + wave * 16 + (lane & 15)] = acc[mt][j];
        __syncthreads();
    }
}
__device__ void gr_scan(KP P) {
    float* DS = (float*)(P->ws + OFF_DSG); const float* DEC = (const float*)(P->ws + OFF_DEC);
    for (int blk = obid(); blk < 129; blk += gridDim.x) {
        if (blk < 128) {
            const int gid = blk * 512 + otid(), kind = gid >> 15, e = gid & 32767, h = e >> 13, d = (e >> 7) & 63, vch = e & 127;
            const float rdec = __expf(64.0f * __logf(1.0f - exp2f(-5.0f - (float)h)));
            float st = 0.f;
            for (int n0 = 0; n0 < 256; n0 += 8) {
                float dsv[8], dc[8];
#pragma unroll
                for (int q = 0; q < 8; ++q) { const int n = n0 + q; dsv[q] = DS[(((size_t)(kind * 256 + n) * 4 + h) * 64 + d) * 128 + vch]; dc[q] = kind == 0 ? DEC[(size_t)(n * 4 + h) * 64 + d] : rdec; }
#pragma unroll
                for (int q = 0; q < 8; ++q) { const int n = n0 + q; DS[(((size_t)(kind * 256 + n) * 4 + h) * 64 + d) * 128 + vch] = st; st = st * dc[q] + dsv[q]; }
            }
        } else {
            const float* AC = (const float*)(P->ws + OFF_AC); const float* HC = (const float*)(P->ws + OFF_HC); float* HIN = (float*)(P->ws + OFF_HIN);
            const int d = otid(); float hin = 0.f;
            for (int n = 0; n < 256; ++n) { HIN[n * 512 + d] = hin; hin = AC[n * 512 + d] * hin + HC[n * 512 + d]; }
        }
    }
}
__device__ void gr_out(KP P, int l, int b, unsigned char* sm) {
    float* Bm = (float*)sm; bf16_t* QD = (bf16_t*)(sm + 16384); bf16_t* KD = (bf16_t*)(sm + 25600); bf16_t* ATT = (bf16_t*)(sm + 34816);
    bf16_t* VT = (bf16_t*)(sm + 44032); bf16_t* ST = (bf16_t*)(sm + 62464); float* O = (float*)(sm + 80896);
    const int tid = otid(), t = tid >> 3, dg = tid & 7, wave = tid >> 6, lane = tid & 63;
    const float* DS = (const float*)(P->ws + OFF_DSG); bf16_t* ZG = (bf16_t*)(P->ws + OFF_ZG);
    for (int idx = obid(); idx < 2048; idx += gridDim.x) {
        const int kind = idx >> 10, n = (idx >> 2) & 255, h = idx & 3, tg = n * 64 + t;
        gr_stage_b(P, l, kind, n, h, Bm);
#pragma unroll
        for (int dd = 0; dd < 8; ++dd) { const int d = dg * 8 + dd; const float bt = Bm[t * 64 + d];
            float qv = gr_qk(P, b, kind, 0, tg, h, d), kv = gr_qk(P, b, kind, 1, tg, h, d);
            if (kind == 0) qv *= 0.125f; else kv *= 0.125f;
            QD[t * 72 + d] = f2bf(qv * __expf(bt)); KD[t * 72 + d] = f2bf(kv * __expf(-bt)); }
        { const bf16_t* vp = gr_vptr(P, kind, tg, h) + dg * 16;
#pragma unroll
            for (int e = 0; e < 16; ++e) VT[(dg * 16 + e) * 72 + t] = vp[e]; }
        { const float* dsp = DS + ((size_t)(kind * 256 + n) * 4 + h) * 64 * 128;
#pragma unroll
            for (int i = 0; i < 16; ++i) { const int e = tid + i * 512, d = e >> 7, vch = e & 127; ST[vch * 72 + d] = f2bf(dsp[e]); } }
        __syncthreads();
        {
            const int nt = wave & 3, mt0 = (wave >> 2) * 2;
            f32x4 a2[2] = {(f32x4){0.f, 0.f, 0.f, 0.f}, (f32x4){0.f, 0.f, 0.f, 0.f}};
#pragma unroll
            for (int ks = 0; ks < 2; ++ks) { const bf16x8 bf = *(const bf16x8*)(KD + (nt * 16 + (lane & 15)) * 72 + ks * 32 + (lane >> 4) * 8);
#pragma unroll
                for (int i = 0; i < 2; ++i) { const bf16x8 af = *(const bf16x8*)(QD + ((mt0 + i) * 16 + (lane & 15)) * 72 + ks * 32 + (lane >> 4) * 8);
                    a2[i] = __builtin_amdgcn_mfma_f32_16x16x32_bf16(af, bf, a2[i], 0, 0, 0); } }
#pragma unroll
            for (int i = 0; i < 2; ++i)
#pragma unroll
                for (int j = 0; j < 4; ++j) { const int tt = (mt0 + i) * 16 + (lane >> 4) * 4 + j, ss = nt * 16 + (lane & 15);
                    ATT[tt * 72 + ss] = f2bf(ss <= tt ? a2[i][j] : 0.f); }
        }
        __syncthreads();
        {
            f32x4 acc[4];
#pragma unroll
            for (int mt = 0; mt < 4; ++mt) acc[mt] = (f32x4){0.f, 0.f, 0.f, 0.f};
#pragma unroll
            for (int ks = 0; ks < 2; ++ks) {
                const bf16x8 b1 = *(const bf16x8*)(VT + (wave * 16 + (lane & 15)) * 72 + ks * 32 + (lane >> 4) * 8);
                const bf16x8 b2 = *(const bf16x8*)(ST + (wave * 16 + (lane & 15)) * 72 + ks * 32 + (lane >> 4) * 8);
#pragma unroll
                for (int mt = 0; mt < 4; ++mt) {
                    const bf16x8 a1 = *(const bf16x8*)(ATT + (mt * 16 + (lane & 15)) * 72 + ks * 32 + (lane >> 4) * 8);
                    const bf16x8 aq = *(const bf16x8*)(QD + (mt * 16 + (lane & 15)) * 72 + ks * 32 + (lane >> 4) * 8);
                    acc[mt] = __builtin_amdgcn_mfma_f32_16x16x32_bf16(a1, b1, acc[mt], 0, 0, 0);
                    acc[mt] = __builtin_amdgcn_mfma_f32_16x16x32_bf16(aq, b2, acc[mt], 0, 0, 0); } }
#pragma unroll
            for (int mt = 0; mt < 4; ++mt)
#pragma unroll
                for (int j = 0; j < 4; ++j) O[(mt * 16 + (lane >> 4) * 4 + j) * 132 + wave * 16 + (lane & 15)] = acc[mt][j];
        }
        __syncthreads();
        {
            float v[16]; float s1 = 0.f, s2 = 0.f;
#pragma unroll
            for (int e = 0; e < 16; ++e) { v[e] = O[t * 132 + dg * 16 + e]; s1 += v[e]; s2 += v[e] * v[e]; }
#pragma unroll
            for (int o = 1; o <= 4; o <<= 1) { s1 += shx(s1, lane, o); s2 += shx(s2, lane, o); }
            float mean = 0.f, rs;
            if (kind == 0) rs = rsqrtf(s2 * (1.0f / 128.0f) + 1e-6f);
            else { mean = s1 * (1.0f / 128.0f); const float var = fmaxf(s2 * (1.0f / 128.0f) - mean * mean, 0.f); rs = rsqrtf(var + 1e-6f); }
            const float* gn = (kind == 0 ? (const float*)P->in[17] : (const float*)P->in[18]) + (size_t)l * 512 + h * 128 + dg * 16;
            bf16_t* gp = ZG + (size_t)tg * 2048 + (kind == 0 ? 512 : 1024) + h * 128 + dg * 16;
            const u32x4 g0 = *(const u32x4*)gp, g1 = *(const u32x4*)(gp + 8);
            float gv[16];
#pragma unroll
            for (int e = 0; e < 4; ++e) { gv[2 * e] = __uint_as_float(g0[e] << 16); gv[2 * e + 1] = __uint_as_float(g0[e] & 0xffff0000u); gv[8 + 2 * e] = __uint_as_float(g1[e] << 16); gv[8 + 2 * e + 1] = __uint_as_float(g1[e] & 0xffff0000u); }
            float r[16];
#pragma unroll
            for (int e = 0; e < 16; ++e) r[e] = (v[e] - mean) * rs * gn[e] * siluf_(gv[e]);
            u32x4 w0, w1;
            w0.x = cvt_pk_bf16(r[0], r[1]); w0.y = cvt_pk_bf16(r[2], r[3]); w0.z = cvt_pk_bf16(r[4], r[5]); w0.w = cvt_pk_bf16(r[6], r[7]);
            w1.x = cvt_pk_bf16(r[8], r[9]); w1.y = cvt_pk_bf16(r[10], r[11]); w1.z = cvt_pk_bf16(r[12], r[13]); w1.w = cvt_pk_bf16(r[14], r[15]);
            *(u32x4*)gp = w0; *(u32x4*)(gp + 8) = w1;
        }
        __syncthreads();
    }
}

__device__ void lru_p1(KP P, int l) {
    unsigned char* ws = P->ws;
    const int d = otid(), lane = d & 63, blk = d >> 6;
    const float* wa = (const float*)P->in[21] + ((size_t)l * 8 + blk) * 4096; const float* wx = (const float*)P->in[23] + ((size_t)l * 8 + blk) * 4096;
    float wac[64], wxc[64];
#pragma unroll
    for (int c = 0; c < 64; ++c) { wac[c] = wa[c * 64 + lane]; wxc[c] = wx[c * 64 + lane]; }
    const float* cwp = (const float*)P->in[19] + (size_t)l * 4 * 512;
    const float cw0 = cwp[d], cw1 = cwp[512 + d], cw2 = cwp[1024 + d], cw3 = cwp[1536 + d], cb = ((const float*)P->in[20])[l * 512 + d];
    const float ba = ((const float*)P->in[22])[l * 512 + d], bx = ((const float*)P->in[24])[l * 512 + d];
    const float sp = softplusf_(-((const float*)P->in[25])[l * 512 + d]);
    const bf16_t* X = (const bf16_t*)(ws + OFF_ZLRU);
    float* HL = (float*)(ws + OFF_HL); float* CA = (float*)(ws + OFF_CA); float* AC = (float*)(ws + OFF_AC); float* HC = (float*)(ws + OFF_HC);
    for (int n = obid(); n < 256; n += gridDim.x) {
        const int t0 = n * 64;
        float x1 = 0.f, x2 = 0.f, x3 = 0.f;
        if (t0 > 0) { x1 = bf2f(X[(size_t)(t0 - 1) * 512 + d]); x2 = bf2f(X[(size_t)(t0 - 2) * 512 + d]); x3 = bf2f(X[(size_t)(t0 - 3) * 512 + d]); }
        float hloc = 0.f, cum = 1.f;
        for (int t = t0; t < t0 + 64; ++t) {
            const float x0 = bf2f(X[(size_t)t * 512 + d]);
            const float xc = x3 * cw0 + x2 * cw1 + x1 * cw2 + x0 * cw3 + cb;
            float ra = ba, ri = bx;
#pragma unroll
            for (int c = 0; c < 64; ++c) { const float xv = rlane(xc, c); ra += xv * wac[c]; ri += xv * wxc[c]; }
            const float r = sigmoidf_(ra), ig = sigmoidf_(ri);
            const float la = -8.0f * r * sp; const float a = __expf(la);
            const float x2l = 2.0f * la;
            const float om = x2l > -0.02f ? -(x2l * (1.0f + x2l * (0.5f + x2l * (1.0f / 6.0f)))) : 1.0f - __expf(x2l);
            const float uu = sqrtf(fmaxf(om, 0.f)) * (ig * xc);
            hloc = a * hloc + uu; cum *= a;
            HL[(size_t)t * 512 + d] = hloc; CA[(size_t)t * 512 + d] = cum;
            x3 = x2; x2 = x1; x1 = x0;
        }
        AC[n * 512 + d] = cum; HC[n * 512 + d] = hloc;
    }
}
__device__ void lru_p3(KP P) {
    unsigned char* ws = P->ws;
    const float* HL = (const float*)(ws + OFF_HL); const float* CA = (const float*)(ws + OFF_CA); const float* HIN = (const float*)(ws + OFF_HIN);
    bf16_t* ZG = (bf16_t*)(ws + OFF_ZG);
    const size_t total = (size_t)TB * 128;
    for (size_t i = (size_t)obid() * 512 + otid(); i < total; i += (size_t)gridDim.x * 512) {
        const int t = (int)(i >> 7), d4 = (int)(i & 127) * 4;
        const f32x4 hl = *(const f32x4*)(HL + (size_t)t * 512 + d4), ca = *(const f32x4*)(CA + (size_t)t * 512 + d4), hi = *(const f32x4*)(HIN + (size_t)(t >> 6) * 512 + d4);
        bf16_t* gp = ZG + (size_t)t * 2048 + 1536 + d4;
        const u32x2 gq = *(const u32x2*)gp;
        const float g0 = __uint_as_float(gq.x << 16), g1 = __uint_as_float(gq.x & 0xffff0000u), g2 = __uint_as_float(gq.y << 16), g3 = __uint_as_float(gq.y & 0xffff0000u);
        u32x2 w; w.x = cvt_pk_bf16((hl[0] + ca[0] * hi[0]) * siluf_(g0), (hl[1] + ca[1] * hi[1]) * siluf_(g1));
        w.y = cvt_pk_bf16((hl[2] + ca[2] * hi[2]) * siluf_(g2), (hl[3] + ca[3] * hi[3]) * siluf_(g3));
        *(u32x2*)gp = w;
    }
}

__global__ void __launch_bounds__(512) fwd_megakernel(Params Parg) {
    extern __shared__ __attribute__((aligned(16))) unsigned char shm[];
    cg::grid_group grid = cg::this_grid();
    LAS unsigned char* lds = (LAS unsigned char*)shm;
    using namespace pg8;
    for (int l = 0; l < 2; ++l) {
        { KP P = kparams(); unsigned char* ws = P->ws;
          conv_t<true>((bf16_t*)(ws + OFF_WIN), (const float*)P->in[4] + (size_t)l * 1024 * NIN, 10752, 1024, NIN); }
        for (int n = 0; n < 4; ++n) { KP P = kparams(); unsigned char* ws = P->ws;
          conv_t<false>((bf16_t*)(ws + OFF_WB) + (size_t)n * 1024 * 512, (const float*)P->in[26] + ((size_t)l * 4 + n) * 512 * 1024, 1024, 512, 1024); }
        { KP P = kparams(); unsigned char* ws = P->ws; conv_t<false>((bf16_t*)(ws + OFF_WOUT), (const float*)P->in[27] + (size_t)l * 1024 * 1024, 1024, 1024, 1024); }
        { KP P = kparams(); unsigned char* ws = P->ws; conv_t<false>((bf16_t*)(ws + OFF_WQ), (const float*)P->in[30] + (size_t)l * 1024 * 1024, 1024, 1024, 1024); }
        { KP P = kparams(); unsigned char* ws = P->ws; conv_t<false>((bf16_t*)(ws + OFF_WKV), (const float*)P->in[31] + (size_t)l * 1024 * 2048, 2048, 1024, 2048); }
        { KP P = kparams(); unsigned char* ws = P->ws; conv_t<false>((bf16_t*)(ws + OFF_WO), (const float*)P->in[32] + (size_t)l * 1024 * 1024, 1024, 1024, 1024); }
        { KP P = kparams(); unsigned char* ws = P->ws; rmsnorm_bf16((const float*)P->in[1], (const float*)P->in[29] + l * 1024, (bf16_t*)(ws + OFF_MN), 512); }
        for (int b = 0; b < 2; ++b) {
            { KP P = kparams(); unsigned char* ws = P->ws;
              const float* hin = (l == 0 ? (const float*)P->in[0] : (const float*)P->out) + (size_t)b * TB * DM;
              rmsnorm_bf16(hin, (const float*)P->in[3] + l * 1024, (bf16_t*)(ws + OFF_UN), TB); }
            grid.sync();
            if (b == 0) { KP P = kparams(); unsigned char* ws = P->ws;
                Order S; S.init(2, 8, 1, ws + OFF_MN, ws + OFF_WKV, 256L * 1024 * 2, 256L * 1024 * 2, 0, 0, 0);
                EpiKV E{(bf16_t*)(ws + OFF_KM), (bf16_t*)(ws + OFF_VT)}; gemm_phase(lds, Gemm{1024, 1024, 1024}, S, E); }
            { KP P = kparams(); unsigned char* ws = P->ws;
                Order S; S.init(64, 26, 1, ws + OFF_UN, ws + OFF_WIN, 256L * 1024 * 2, 256L * 1024 * 2, 0, 0, 0);
                EpiInproj E{ws}; gemm_phase(lds, Gemm{1024, 1024, 1024}, S, E); }
            grid.sync();
            rwkv_prep(kparams(), l);
            grid.sync();
            rwkv_pass1(kparams());
            grid.sync();
            rwkv_cscan(kparams(), (float*)shm);
            grid.sync();
            rwkv_pass2(kparams(), l);
            grid.sync();
            gr_ds(kparams(), l, b, shm);
            lru_p1(kparams(), l);
            grid.sync();
            gr_scan(kparams());
            grid.sync();
            gr_out(kparams(), l, b, shm);
            lru_p3(kparams());
            grid.sync();
            { KP P = kparams(); unsigned char* ws = P->ws;
                Order S; S.init(64, 16, 1, ws + OFF_UN, ws + OFF_WIN + (size_t)6656 * 1024 * 2, 256L * 1024 * 2, 256L * 1024 * 2, 0, 0, 0);
                EpiBf16<1> E{(bf16_t*)(ws + OFF_G), 4096, 1.0f}; gemm_phase(lds, Gemm{1024, 1024, 1024}, S, E); }
            grid.sync();
            { KP P = kparams(); unsigned char* ws = P->ws;
                Order S; S.init(64, 4, 4, ws + OFF_ZG, ws + OFF_WB, 256L * 2048 * 2, 256L * 512 * 2, 0, 512L * 2, 1024L * 512 * 2);
                EpiMerge E{(const bf16_t*)(ws + OFF_G), (bf16_t*)(ws + OFF_MRG)}; gemm_phase(lds, Gemm{2048, 512, 512}, S, E); }
            grid.sync();
            { KP P = kparams(); unsigned char* ws = P->ws;
                const float* hin = (l == 0 ? (const float*)P->in[0] : (const float*)P->out) + (size_t)b * TB * DM; float* hout = P->out + (size_t)b * TB * DM;
                Order S; S.init(64, 4, 1, ws + OFF_MRG, ws + OFF_WOUT, 256L * 1024 * 2, 256L * 1024 * 2, 0, 0, 0);
                EpiResid E{hin, hout}; gemm_phase(lds, Gemm{1024, 1024, 1024}, S, E); }
            grid.sync();
            { KP P = kparams(); unsigned char* ws = P->ws; const float* hout = P->out + (size_t)b * TB * DM;
              rmsnorm_bf16(hout, (const float*)P->in[28] + l * 1024, (bf16_t*)(ws + OFF_UN), TB); }
            grid.sync();
            { KP P = kparams(); unsigned char* ws = P->ws;
                Order S; S.init(64, 4, 1, ws + OFF_UN, ws + OFF_WQ, 256L * 1024 * 2, 256L * 1024 * 2, 0, 0, 0);
                EpiBf16<0> E{(bf16_t*)(ws + OFF_Q), 1024, 0.0625f}; gemm_phase(lds, Gemm{1024, 1024, 1024}, S, E); }
            grid.sync();
            { KP P = kparams(); unsigned char* ws = P->ws;
                Order S; S.init(64, 4, 1, ws + OFF_Q, ws + OFF_KM + (size_t)b * 256 * 1024 * 2, 256L * 1024 * 2, 256L * 2, 256L * 2, 0, 0);
                EpiSoftmax E{(bf16_t*)(ws + OFF_P), (LAS float*)(lds + STAGE_BYTES)}; gemm_phase(lds, Gemm{1024, 1024, 256}, S, E); }
            grid.sync();
            { KP P = kparams(); unsigned char* ws = P->ws;
                Order S; S.init(64, 4, 1, ws + OFF_P, ws + OFF_VT + (size_t)b * 1024 * 256 * 2, 256L * 1024 * 2, 256L * 256 * 2, 256L * 2, 0, 0);
                EpiBf16<0> E{(bf16_t*)(ws + OFF_O), 1024, 1.0f}; gemm_phase(lds, Gemm{1024, 256, 256}, S, E); }
            grid.sync();
            { KP P = kparams(); unsigned char* ws = P->ws; float* hout = P->out + (size_t)b * TB * DM;
                Order S; S.init(64, 4, 1, ws + OFF_O, ws + OFF_WO, 256L * 1024 * 2, 256L * 1024 * 2, 0, 0, 0);
                EpiResid E{hout, hout}; gemm_phase(lds, Gemm{1024, 1024, 1024}, S, E); }
            grid.sync();
        }
    }
    { KP P = kparams(); rmsnorm_f32_inplace(P->out, (const float*)P->in[33], 2 * TB); }
}

extern "C" void kernel_launch(void* const* d_in, const int* in_sizes, int n_in, void* d_out, int out_size, void* d_ws, size_t ws_size, hipStream_t stream) {
    constexpr size_t kDynLds = pg8::STAGE_BYTES + 16384;
    static int grid_blocks = 0;
    if (!grid_blocks) {
        int dev = 0, cus = 0, per_cu = 0;
        hipGetDevice(&dev);
        hipDeviceGetAttribute(&cus, hipDeviceAttributeMultiprocessorCount, dev);
        hipFuncSetAttribute((const void*)fwd_megakernel, hipFuncAttributeMaxDynamicSharedMemorySize, (int)kDynLds);
        hipOccupancyMaxActiveBlocksPerMultiprocessor(&per_cu, (const void*)fwd_megakernel, 512, kDynLds);
        if (per_cu < 1) { fprintf(stderr, "occupancy query returned %d\n", per_cu); per_cu = 1; }
        grid_blocks = cus * per_cu;
        if (ws_size < OFF_END) fprintf(stderr, "workspace too small: %zu < %zu\n", ws_size, (size_t)OFF_END);
    }
    Params p{};
    for (int i = 0; i < 34; ++i) p.in[i] = d_in[i];
    p.out = (float*)d_out; p.ws = (unsigned char*)d_ws;
    void* args[] = {&p};
    hipError_t e = hipLaunchCooperativeKernel((const void*)fwd_megakernel, dim3(grid_blocks), dim3(512), args, kDynLds, stream);
    if (e != hipSuccess) fprintf(stderr, "cooperative launch failed: %s (grid %d)\n", hipGetErrorString(e), grid_blocks);
}
```

```cpp
#include <hip/hip_runtime.h>
#include <hip/hip_cooperative_groups.h>
#include <cstdio>
namespace cg = cooperative_groups;

typedef unsigned short bf16_t;
typedef short bf16x8 __attribute__((ext_vector_type(8)));
typedef float f32x4 __attribute__((ext_vector_type(4)));
typedef unsigned u32x4 __attribute__((ext_vector_type(4)));
typedef unsigned u32x2 __attribute__((ext_vector_type(2)));
#define LAS __attribute__((address_space(3)))

constexpr int TB = 16384;
constexpr int DM = 1024;
constexpr int NIN = 10384;
constexpr int NCH = 128, LCH = 128;

constexpr size_t SZ_WIN = (size_t)10752 * 1024 * 2;
constexpr size_t OFF_WIN = 0;
constexpr size_t OFF_WB = OFF_WIN + SZ_WIN;
constexpr size_t OFF_WOUT = OFF_WB + (size_t)4 * 1024 * 512 * 2;
constexpr size_t OFF_WQ = OFF_WOUT + (size_t)1024 * 1024 * 2;
constexpr size_t OFF_WKV = OFF_WQ + (size_t)1024 * 1024 * 2;
constexpr size_t OFF_WO = OFF_WKV + (size_t)2048 * 1024 * 2;
constexpr size_t OFF_UN = OFF_WO + (size_t)1024 * 1024 * 2;
constexpr size_t OFF_MN = OFF_UN + (size_t)TB * 1024 * 2;
constexpr size_t OFF_KM = OFF_MN + (size_t)512 * 1024 * 2;
constexpr size_t OFF_VT = OFF_KM + (size_t)512 * 1024 * 2;
constexpr size_t OFF_ZRW = OFF_VT + (size_t)512 * 1024 * 2;
constexpr size_t OFF_ZGLA = OFF_ZRW + (size_t)TB * 1792 * 2;
constexpr size_t OFF_ZRET = OFF_ZGLA + (size_t)TB * 1280 * 2;
constexpr size_t OFF_ZLRU = OFF_ZRET + (size_t)TB * 1024 * 2;
constexpr size_t OFF_ZG = OFF_ZLRU + (size_t)TB * 512 * 2;
constexpr size_t OFF_MRG = OFF_ZG + (size_t)TB * 2048 * 2;
constexpr size_t OFF_PREP = OFF_MRG + (size_t)TB * 1024 * 2;
constexpr size_t SZ_F = (size_t)TB * 512 * 4;
constexpr size_t OFF_PW = OFF_PREP, OFF_PKK = OFF_PW + SZ_F, OFF_PB = OFF_PKK + SZ_F, OFF_PKM = OFF_PB + SZ_F, OFF_PR = OFF_PKM + SZ_F;
constexpr size_t OFF_PV = OFF_PR + SZ_F;
constexpr size_t OFF_BON = OFF_PV + (size_t)TB * 512 * 2;
constexpr size_t OFF_BAR = OFF_BON + (size_t)TB * 8 * 4;
constexpr size_t OFF_END = OFF_BAR + 16384;
constexpr size_t OFF_G = OFF_ZRW;
constexpr size_t OFF_Q = OFF_ZRW;
constexpr size_t OFF_P = OFF_Q + (size_t)TB * 1024 * 2;
constexpr size_t OFF_O = OFF_P + (size_t)TB * 1024 * 2;
constexpr size_t OFF_PP = OFF_MRG;
constexpr size_t OFF_PL = OFF_MRG + (size_t)8 * NCH * 4096 * 4;
constexpr size_t OFF_DSG = OFF_PREP;
constexpr size_t OFF_DEC = OFF_DSG + (size_t)2 * 256 * 4 * 64 * 128 * 4;
constexpr size_t OFF_HL = OFF_DEC + (size_t)256 * 4 * 64 * 4;
constexpr size_t OFF_CA = OFF_HL + SZ_F;
constexpr size_t OFF_AC = OFF_CA + SZ_F;
constexpr size_t OFF_HC = OFF_AC + (size_t)256 * 512 * 4;
constexpr size_t OFF_HIN = OFF_HC + (size_t)256 * 512 * 4;
static_assert(OFF_HIN + 256 * 512 * 4 <= OFF_END, "overlay");
static_assert(OFF_END <= (size_t)512 * 1024 * 1024, "ws");

struct Params { const void* in[34]; float* out; unsigned char* ws; };
typedef const Params __attribute__((address_space(4)))* KP;
__device__ __forceinline__ KP kparams() { KP p = (KP)__builtin_amdgcn_kernarg_segment_ptr(); asm volatile("" : "+s"(p)); return p; }

__device__ __forceinline__ float bf2f(bf16_t v) { return __uint_as_float(((unsigned)v) << 16); }
__device__ __forceinline__ bf16_t f2bf(float f) { unsigned u = __float_as_uint(f); u += 0x7fffu + ((u >> 16) & 1u); return (bf16_t)(u >> 16); }
__device__ __forceinline__ unsigned cvt_pk_bf16(float lo, float hi) { unsigned r; asm("v_cvt_pk_bf16_f32 %0, %1, %2" : "=v"(r) : "v"(lo), "v"(hi)); return r; }
__device__ __forceinline__ float shx(float v, int lane, int o) { return __int_as_float(__builtin_amdgcn_ds_bpermute((lane ^ o) << 2, __float_as_int(v))); }
__device__ __forceinline__ float wave_sum(float v, int lane) {
#pragma unroll
    for (int o = 32; o >= 1; o >>= 1) v += shx(v, lane, o);
    return v; }
__device__ __forceinline__ float rlane(float v, int k) { return __int_as_float(__builtin_amdgcn_readlane(__float_as_int(v), k)); }
__device__ __forceinline__ float sigmoidf_(float x) { return 1.0f / (1.0f + __expf(-x)); }
__device__ __forceinline__ float siluf_(float x) { return x / (1.0f + __expf(-x)); }
__device__ __forceinline__ float softplusf_(float y) { return fmaxf(y, 0.f) + __logf(1.0f + __expf(-fabsf(y))); }
__device__ __forceinline__ float tanhf_(float x) { float e = __expf(2.0f * x); return 1.0f - 2.0f / (e + 1.0f); }

__device__ __forceinline__ int otid() { int t = threadIdx.x; asm volatile("" : "+v"(t)); return t; }
__device__ __forceinline__ int obid() { int t = blockIdx.x; asm volatile("" : "+s"(t)); return t; }

namespace pg8 {
constexpr int BM = 256, BK = 64, HALF = 128, HTB = HALF * BK * 2, STAGE_BYTES = 8 * HTB, NXCD = 8, WGM = 8;
__device__ __forceinline__ int lds_byte(int r, int c) { const int st = (r >> 4) * 2 + (c >> 5), rr = r & 15, cc = c & 31, ob = rr * 64 + cc * 2; return st * 1024 + (ob ^ (((ob >> 9) & 1) << 5)); }
__device__ __forceinline__ void stage_rc(int b, int& R, int& C) { const int st = b / 1024, sb = b % 1024, swz = sb ^ (((sb >> 9) & 1) << 5); R = (st >> 1) * 16 + swz / 64; C = (st & 1) * 32 + (swz % 64) / 2; }
__device__ __forceinline__ int perm32(int rho) { const int n = rho >> 4, i = rho & 15; return 8 * (i >> 2) + 4 * n + (i & 3); }

struct Unit { int pm, pn, aux; const char* pa; const char* pb; };
struct Gemm { int lda, ldb, K; };

struct Order {
    int nM, nN, nwg, G, c, rep;
    const char* A; const char* B;
    long tA, tB, aPn, aRep, bRep;
    __device__ void init(int nM_, int nN_, int rep_, const void* A_, const void* B_, long tA_, long tB_, long aPn_, long aRep_, long bRep_) {
        nM = nM_; nN = nN_; nwg = nM * nN; G = gridDim.x; c = obid(); rep = rep_; A = (const char*)A_; B = (const char*)B_; tA = tA_; tB = tB_; aPn = aPn_; aRep = aRep_; bRep = bRep_; }
    __device__ bool next(int i, Unit& u) const {
        const int ti = i / rep, r = i - ti * rep;
        const long L = (long)ti * G + c; if (L >= nwg) return false;
        int wgid = (int)L; { const int q = nwg / NXCD, rr = nwg % NXCD, xcd = wgid % NXCD, off = wgid / NXCD; wgid = (xcd < rr ? xcd * (q + 1) : rr * (q + 1) + (xcd - rr) * q) + off; }
        const int nig = WGM * nN, gid = wgid / nig, fm = gid * WGM, gsz = (nM - fm) < WGM ? (nM - fm) : WGM;
        u.pm = fm + ((wgid % nig) % gsz); u.pn = (wgid % nig) / gsz; u.aux = r;
        u.pa = A + (long)u.pm * tA + (long)u.pn * aPn + (long)r * aRep;
        u.pb = B + (long)u.pn * tB + (long)r * bRep;
        return true; }
};

template <class Epi>
__device__ __forceinline__ void gemm_phase(LAS unsigned char* lds, const Gemm g, const Order& S, const Epi& E) {
    const int tid = otid(), wid = __builtin_amdgcn_readfirstlane(tid >> 6), lane = tid & 63, wr = wid >> 2, wc = wid & 3, fr = lane & 15, fq = lane >> 4;
    const int K = g.K, nt = K / BK;
    unsigned voffA[2], voffB[2];
#pragma unroll
    for (int i = 0; i < 2; ++i) { int R, C; stage_rc(tid * 16 + i * 8192, R, C); const int Rb = Epi::PERM ? ((R & ~31) + perm32(R & 31)) : R;
        voffA[i] = (unsigned)(R * g.lda + C) * 2u; voffB[i] = (unsigned)(Rb * g.ldb + C) * 2u; }
    const size_t kstep = (size_t)(BK * 2);
    const size_t hstepA = (size_t)HALF * g.lda * 2, hstepB = (size_t)HALF * g.ldb * 2;
    const unsigned ldsw = (unsigned)wid * 1024u;
    const int aoff = lds_byte(wr * 64 + fr, fq * 8), boff = lds_byte(wc * 32 + fr, fq * 8);
#define PG8_SA(b, h) (((b) * 2 + (h)) * HTB)
#define PG8_SB(b, h) ((4 + (b) * 2 + (h)) * HTB)
#define PG8_STAGE(bufoff, gbase, voff) do { _Pragma("unroll") for (int _i = 0; _i < 2; ++_i) \
        __builtin_amdgcn_global_load_lds((const unsigned*)((const char*)(gbase) + (voff)[_i]), (LAS unsigned*)(lds + (bufoff) + ldsw + _i * 8192), 16, 0, 0); } while (0)
#define PG8_LDA(dst, b, h) do { _Pragma("unroll") for (int m = 0; m < 4; ++m) _Pragma("unroll") for (int k = 0; k < 2; ++k) dst[m][k] = *(const LAS bf16x8*)(lds + PG8_SA(b, h) + aoff + m * 2048 + k * 1024); } while (0)
#define PG8_LDB(dst, b, h) do { _Pragma("unroll") for (int n = 0; n < 2; ++n) _Pragma("unroll") for (int k = 0; k < 2; ++k) dst[n][k] = *(const LAS bf16x8*)(lds + PG8_SB(b, h) + boff + n * 2048 + k * 1024); } while (0)
#define PG8_MMA(ai, bj, At, Bt) do { __builtin_amdgcn_s_setprio(1); _Pragma("unroll") for (int m = 0; m < 4; ++m) _Pragma("unroll") for (int n = 0; n < 2; ++n) _Pragma("unroll") for (int k = 0; k < 2; ++k) \
        acc[ai][bj][m][n] = __builtin_amdgcn_mfma_f32_16x16x32_bf16(Bt[n][k], At[m][k], acc[ai][bj][m][n], 0, 0, 0); __builtin_amdgcn_s_setprio(0); } while (0)
#define PG8_WAIT_V(n) asm volatile("s_waitcnt vmcnt(" #n ")" ::: "memory")
#define PG8_WAIT_L(n) asm volatile("s_waitcnt lgkmcnt(" #n ")" ::: "memory")
#define PG8_BAR __builtin_amdgcn_s_barrier()
#define PG8_SCHED __builtin_amdgcn_sched_barrier(0)
    Unit cur, nxt; int ui = 0;
    if (!S.next(0, cur)) return;
    f32x4 acc[2][2][4][2];
#pragma unroll
    for (int a = 0; a < 2; ++a)
#pragma unroll
        for (int b = 0; b < 2; ++b)
#pragma unroll
            for (int m = 0; m < 4; ++m)
#pragma unroll
                for (int n = 0; n < 2; ++n) acc[a][b][m][n] = (f32x4){0.f, 0.f, 0.f, 0.f};
    bf16x8 At[4][2], B0[2][2], B1[2][2];
    const char* cA = cur.pa; const char* cB = cur.pb;
    PG8_STAGE(PG8_SB(0, 0), cB, voffB); PG8_STAGE(PG8_SA(0, 0), cA, voffA); PG8_STAGE(PG8_SB(0, 1), cB + hstepB, voffB); PG8_STAGE(PG8_SA(0, 1), cA + hstepA, voffA);
    if (wr == 1) PG8_BAR;
    PG8_WAIT_V(4); PG8_BAR;
    PG8_STAGE(PG8_SB(1, 0), cB + kstep, voffB); PG8_STAGE(PG8_SA(1, 0), cA + kstep, voffA); PG8_STAGE(PG8_SB(1, 1), cB + hstepB + kstep, voffB);
    PG8_WAIT_V(6); PG8_BAR;
    for (;;) {
        const bool has_next = S.next(ui + 1, nxt);
        const char* nA = has_next ? nxt.pa : cA; const char* nB = has_next ? nxt.pb : cB;
        for (int t = 0; t < nt; t += 2) {
            const bool last = (t == nt - 2);
            const char* a1 = cA + (size_t)(t + 1) * kstep;
            const char* a2 = last ? nA : cA + (size_t)(t + 2) * kstep; const char* b2 = last ? nB : cB + (size_t)(t + 2) * kstep;
            const char* a3 = a2 + kstep; const char* b3 = b2 + kstep;
            PG8_LDB(B0, 0, 0); PG8_SCHED; PG8_LDA(At, 0, 0); PG8_STAGE(PG8_SA(1, 1), a1 + hstepA, voffA);
            PG8_WAIT_L(8); PG8_BAR; PG8_WAIT_L(0); PG8_MMA(0, 0, At, B0); PG8_BAR; PG8_SCHED;
            PG8_LDB(B1, 0, 1); PG8_STAGE(PG8_SB(0, 0), b2, voffB);
            PG8_BAR; PG8_WAIT_L(0); PG8_MMA(0, 1, At, B1); PG8_BAR;
            PG8_LDA(At, 0, 1); PG8_STAGE(PG8_SA(0, 0), a2, voffA);
            PG8_BAR; PG8_WAIT_L(0); PG8_MMA(1, 0, At, B0); PG8_BAR; PG8_SCHED;
            PG8_STAGE(PG8_SB(0, 1), b2 + hstepB, voffB);
            PG8_WAIT_V(6); PG8_BAR; PG8_MMA(1, 1, At, B1); PG8_BAR;
            PG8_LDB(B0, 1, 0); PG8_SCHED; PG8_LDA(At, 1, 0); PG8_STAGE(PG8_SA(0, 1), a2 + hstepA, voffA);
            PG8_WAIT_L(8); PG8_BAR; PG8_WAIT_L(0); PG8_MMA(0, 0, At, B0); PG8_BAR; PG8_SCHED;
            PG8_LDB(B1, 1, 1); PG8_STAGE(PG8_SB(1, 0), b3, voffB);
            PG8_BAR; PG8_WAIT_L(0); PG8_MMA(0, 1, At, B1); PG8_BAR;
            PG8_LDA(At, 1, 1); PG8_STAGE(PG8_SA(1, 0), a3, voffA);
            PG8_BAR; PG8_WAIT_L(0); PG8_MMA(1, 0, At, B0); PG8_BAR; PG8_SCHED;
            PG8_STAGE(PG8_SB(1, 1), b3 + hstepB, voffB);
            PG8_WAIT_V(6); PG8_BAR; PG8_MMA(1, 1, At, B1); PG8_BAR;
        }
        E(acc, cur, wr, wc, fr, fq);
        if (!has_next) break;
#pragma unroll
        for (int a = 0; a < 2; ++a)
#pragma unroll
            for (int b = 0; b < 2; ++b)
#pragma unroll
                for (int m = 0; m < 4; ++m)
#pragma unroll
                    for (int n = 0; n < 2; ++n) acc[a][b][m][n] = (f32x4){0.f, 0.f, 0.f, 0.f};
        cur = nxt; cA = nA; cB = nB; ++ui;
    }
    PG8_WAIT_V(0);
    if (wr == 0) PG8_BAR;
    PG8_BAR;
#undef PG8_SA
#undef PG8_SB
#undef PG8_STAGE
#undef PG8_LDA
#undef PG8_LDB
#undef PG8_MMA
#undef PG8_WAIT_V
#undef PG8_WAIT_L
#undef PG8_BAR
#undef PG8_SCHED
}

typedef f32x4 Acc[2][2][4][2];

struct EpiInproj {
    static constexpr bool PERM = true;
    unsigned char* ws;
    __device__ __forceinline__ void operator()(Acc& acc, const Unit& u, int wr, int wc, int fr, int fq) const {
        int pn = u.pn, ld, colt; size_t off;
        if (pn < 7) { off = OFF_ZRW; ld = 1792; colt = pn * 256; }
        else if (pn < 12) { off = OFF_ZGLA; ld = 1280; colt = (pn - 7) * 256; }
        else if (pn < 16) { off = OFF_ZRET; ld = 1024; colt = (pn - 12) * 256; }
        else if (pn < 18) { off = OFF_ZLRU; ld = 512; colt = (pn - 16) * 256; }
        else { off = OFF_ZG; ld = 2048; colt = (pn - 18) * 256; }
        bf16_t* base = (bf16_t*)(ws + off);
        const int row0 = u.pm * BM + wr * 64 + fr, col0 = colt + wc * 32 + 8 * fq;
#pragma unroll
        for (int ai = 0; ai < 2; ++ai)
#pragma unroll
            for (int m = 0; m < 4; ++m) { bf16_t* rowp = base + (size_t)(row0 + ai * HALF + m * 16) * ld + col0;
#pragma unroll
                for (int bj = 0; bj < 2; ++bj) { const f32x4 v0 = acc[ai][bj][m][0], v1 = acc[ai][bj][m][1];
                    u32x4 w; w.x = cvt_pk_bf16(v0[0], v0[1]); w.y = cvt_pk_bf16(v0[2], v0[3]); w.z = cvt_pk_bf16(v1[0], v1[1]); w.w = cvt_pk_bf16(v1[2], v1[3]);
                    *(u32x4*)(rowp + bj * HALF) = w; } }
    }
};
template <int ACT> struct EpiBf16 {
    static constexpr bool PERM = true;
    bf16_t* O; int ldc; float scale;
    __device__ __forceinline__ void operator()(Acc& acc, const Unit& u, int wr, int wc, int fr, int fq) const {
        const int row0 = u.pm * BM + wr * 64 + fr, col0 = u.pn * BM + wc * 32 + 8 * fq;
#pragma unroll
        for (int ai = 0; ai < 2; ++ai)
#pragma unroll
            for (int m = 0; m < 4; ++m) { bf16_t* rowp = O + (size_t)(row0 + ai * HALF + m * 16) * ldc + col0;
#pragma unroll
                for (int bj = 0; bj < 2; ++bj) { f32x4 v0 = acc[ai][bj][m][0], v1 = acc[ai][bj][m][1];
                    if (ACT == 1) {
#pragma unroll
                        for (int j = 0; j < 4; ++j) { v0[j] = sigmoidf_(v0[j]); v1[j] = sigmoidf_(v1[j]); } }
                    else { v0 = v0 * scale; v1 = v1 * scale; }
                    u32x4 w; w.x = cvt_pk_bf16(v0[0], v0[1]); w.y = cvt_pk_bf16(v0[2], v0[3]); w.z = cvt_pk_bf16(v1[0], v1[1]); w.w = cvt_pk_bf16(v1[2], v1[3]);
                    *(u32x4*)(rowp + bj * HALF) = w; } }
    }
};
struct EpiKV {
    static constexpr bool PERM = true;
    bf16_t* KM; bf16_t* VT;
    __device__ __forceinline__ void operator()(Acc& acc, const Unit& u, int wr, int wc, int fr, int fq) const {
        const int row0 = u.pm * BM + wr * 64 + fr, col0 = u.pn * BM + wc * 32 + 8 * fq;
#pragma unroll
        for (int ai = 0; ai < 2; ++ai)
#pragma unroll
            for (int m = 0; m < 4; ++m) { const int row = row0 + ai * HALF + m * 16;
#pragma unroll
                for (int bj = 0; bj < 2; ++bj)
#pragma unroll
                    for (int n = 0; n < 2; ++n)
#pragma unroll
                        for (int j = 0; j < 4; ++j) { const int col = col0 + bj * HALF + 4 * n + j; const bf16_t v = f2bf(acc[ai][bj][m][n][j]);
                            if (col < 1024) KM[(size_t)row * 1024 + col] = v;
                            else VT[((size_t)(row >> 8) * 1024 + (col - 1024)) * 256 + (row & 255)] = v; } }
    }
};
struct EpiMerge {
    static constexpr bool PERM = true;
    const bf16_t* G; bf16_t* MRG;
    __device__ __forceinline__ void operator()(Acc& acc, const Unit& u, int wr, int wc, int fr, int fq) const {
        const int row0 = u.pm * BM + wr * 64 + fr, col0 = u.pn * BM + wc * 32 + 8 * fq;
#pragma unroll
        for (int ai = 0; ai < 2; ++ai)
#pragma unroll
            for (int m = 0; m < 4; ++m) { const size_t row = (size_t)(row0 + ai * HALF + m * 16);
#pragma unroll
                for (int bj = 0; bj < 2; ++bj) { const f32x4 v0 = acc[ai][bj][m][0], v1 = acc[ai][bj][m][1];
                    const u32x4 gq = *(const u32x4*)(G + row * 4096 + u.aux * 1024 + col0 + bj * HALF);
                    bf16_t* mp = MRG + row * 1024 + col0 + bj * HALF;
                    float o[8] = {0.f, 0.f, 0.f, 0.f, 0.f, 0.f, 0.f, 0.f};
                    if (u.aux > 0) { const u32x4 mq = *(const u32x4*)mp;
#pragma unroll
                        for (int e = 0; e < 4; ++e) { o[2 * e] = __uint_as_float(mq[e] << 16); o[2 * e + 1] = __uint_as_float(mq[e] & 0xffff0000u); } }
#pragma unroll
                    for (int e = 0; e < 4; ++e) { const float g0 = __uint_as_float(gq[e] << 16), g1 = __uint_as_float(gq[e] & 0xffff0000u);
                        const float a0 = e < 2 ? v0[2 * e] : v1[2 * e - 4], a1 = e < 2 ? v0[2 * e + 1] : v1[2 * e - 3];
                        o[2 * e] += g0 * a0; o[2 * e + 1] += g1 * a1; }
                    u32x4 w; w.x = cvt_pk_bf16(o[0], o[1]); w.y = cvt_pk_bf16(o[2], o[3]); w.z = cvt_pk_bf16(o[4], o[5]); w.w = cvt_pk_bf16(o[6], o[7]);
                    *(u32x4*)mp = w; } }
    }
};
struct EpiResid {
    static constexpr bool PERM = false;
    const float* hin; float* hout;
    __device__ __forceinline__ void operator()(Acc& acc, const Unit& u, int wr, int wc, int fr, int fq) const {
        const int row0 = u.pm * BM + wr * 64 + fr, col0 = u.pn * BM + wc * 32 + 4 * fq;
#pragma unroll
        for (int ai = 0; ai < 2; ++ai)
#pragma unroll
            for (int m = 0; m < 4; ++m) { const size_t ro = (size_t)(row0 + ai * HALF + m * 16) * 1024 + col0;
#pragma unroll
                for (int bj = 0; bj < 2; ++bj)
#pragma unroll
                    for (int n = 0; n < 2; ++n) { const f32x4 r = *(const f32x4*)(hin + ro + bj * HALF + n * 16);
                        *(f32x4*)(hout + ro + bj * HALF + n * 16) = r + acc[ai][bj][m][n]; } }
    }
};
struct EpiSoftmax {
    static constexpr bool PERM = true;
    bf16_t* P; LAS float* xs;
    __device__ __forceinline__ void operator()(Acc& acc, const Unit& u, int wr_, int wc_, int fr_, int fq_) const {
        const int tid2 = otid(), wid2 = tid2 >> 6, wr = wid2 >> 2, wc = wid2 & 3, fr = tid2 & 15, fq = (tid2 >> 4) & 3;
#pragma unroll
        for (int ai = 0; ai < 2; ++ai)
#pragma unroll
            for (int m = 0; m < 4; ++m) { float v = -3.0e38f;
#pragma unroll
                for (int bj = 0; bj < 2; ++bj)
#pragma unroll
                    for (int n = 0; n < 2; ++n)
#pragma unroll
                        for (int j = 0; j < 4; ++j) v = fmaxf(v, acc[ai][bj][m][n][j]);
                xs[(ai * HALF + wr * 64 + m * 16 + fr) * 16 + wc * 4 + fq] = v; }
        asm volatile("s_waitcnt lgkmcnt(0)\n\ts_barrier" ::: "memory");
        float sums[2][4];
#pragma unroll
        for (int ai = 0; ai < 2; ++ai)
#pragma unroll
            for (int m = 0; m < 4; ++m) { const int rl = ai * HALF + wr * 64 + m * 16 + fr;
                f32x4 q = *(const LAS f32x4*)(xs + rl * 16);
#pragma unroll
                for (int e = 1; e < 4; ++e) { const f32x4 q2 = *(const LAS f32x4*)(xs + rl * 16 + 4 * e); q[0] = fmaxf(q[0], q2[0]); q[1] = fmaxf(q[1], q2[1]); q[2] = fmaxf(q[2], q2[2]); q[3] = fmaxf(q[3], q2[3]); }
                const float M = fmaxf(fmaxf(q[0], q[1]), fmaxf(q[2], q[3]));
                float sv = 0.f;
#pragma unroll
                for (int bj = 0; bj < 2; ++bj)
#pragma unroll
                    for (int n = 0; n < 2; ++n)
#pragma unroll
                        for (int j = 0; j < 4; ++j) { const float e = __expf(acc[ai][bj][m][n][j] - M); acc[ai][bj][m][n][j] = e; sv += e; }
                sums[ai][m] = sv; }
        asm volatile("s_waitcnt lgkmcnt(0)\n\ts_barrier" ::: "memory");
#pragma unroll
        for (int ai = 0; ai < 2; ++ai)
#pragma unroll
            for (int m = 0; m < 4; ++m) xs[(ai * HALF + wr * 64 + m * 16 + fr) * 16 + wc * 4 + fq] = sums[ai][m];
        asm volatile("s_waitcnt lgkmcnt(0)\n\ts_barrier" ::: "memory");
        const int row0 = u.pm * BM + wr * 64 + fr, col0 = u.pn * BM + wc * 32 + 8 * fq;
#pragma unroll
        for (int ai = 0; ai < 2; ++ai)
#pragma unroll
            for (int m = 0; m < 4; ++m) { const int rl = ai * HALF + wr * 64 + m * 16 + fr;
                f32x4 q = *(const LAS f32x4*)(xs + rl * 16);
#pragma unroll
                for (int e = 1; e < 4; ++e) q += *(const LAS f32x4*)(xs + rl * 16 + 4 * e);
                const float inv = 1.0f / (q[0] + q[1] + q[2] + q[3]);
                bf16_t* rowp = P + (size_t)(row0 + ai * HALF + m * 16) * 1024 + col0;
#pragma unroll
                for (int bj = 0; bj < 2; ++bj) { const f32x4 v0 = acc[ai][bj][m][0] * inv, v1 = acc[ai][bj][m][1] * inv;
                    u32x4 w; w.x = cvt_pk_bf16(v0[0], v0[1]); w.y = cvt_pk_bf16(v0[2], v0[3]); w.z = cvt_pk_bf16(v1[0], v1[1]); w.w = cvt_pk_bf16(v1[2], v1[3]);
                    *(u32x4*)(rowp + bj * HALF) = w; } }
    }
};
}

__device__ __forceinline__ int win_map(int n) {
    if (n < 1792) return n < 1664 ? n : -1;
    n -= 1792; if (n < 1280) return n < 1040 ? 2176 + n : -1;
    n -= 1280; if (n < 1024) return 3728 + n;
    n -= 1024; if (n < 512) return 5264 + n;
    n -= 512;
    if (n < 512) return 1664 + n;
    if (n < 1024) return 3216 + (n - 512);
    if (n < 1536) return 4752 + (n - 1024);
    if (n < 2048) return 5776 + (n - 1536);
    n -= 2048; return 6288 + n;
}
template <bool WIN>
__device__ __forceinline__ void conv_t(bf16_t* dst, const float* src, int ND, int K, int NS) {
    const size_t total = (size_t)ND * (K / 8);
    for (size_t i = (size_t)obid() * 512 + otid(); i < total; i += (size_t)gridDim.x * 512) {
        const int n = (int)(i % ND), ko = (int)(i / ND);
        const int ms = WIN ? win_map(n) : n;
        float v[8];
#pragma unroll
        for (int j = 0; j < 8; ++j) v[j] = ms >= 0 ? src[(size_t)(ko * 8 + j) * NS + ms] : 0.f;
        u32x4 w; w.x = cvt_pk_bf16(v[0], v[1]); w.y = cvt_pk_bf16(v[2], v[3]); w.z = cvt_pk_bf16(v[4], v[5]); w.w = cvt_pk_bf16(v[6], v[7]);
        *(u32x4*)(dst + (size_t)n * K + ko * 8) = w;
    }
}
__device__ __forceinline__ void rmsnorm_bf16(const float* src, const float* g, bf16_t* dst, int rows) {
    const int lane = otid() & 63, gw = obid() * 8 + (otid() >> 6), nw = gridDim.x * 8;
    for (int r = gw; r < rows; r += nw) {
        const float* p = src + (size_t)r * 1024; f32x4 v[4]; float ss = 0.f;
#pragma unroll
        for (int i = 0; i < 4; ++i) { v[i] = *(const f32x4*)(p + i * 256 + lane * 4); ss += v[i][0] * v[i][0] + v[i][1] * v[i][1] + v[i][2] * v[i][2] + v[i][3] * v[i][3]; }
        ss = wave_sum(ss, lane); const float rs = rsqrtf(ss * (1.0f / 1024.0f) + 1e-6f);
#pragma unroll
        for (int i = 0; i < 4; ++i) { const f32x4 gg = *(const f32x4*)(g + i * 256 + lane * 4);
            u32x2 w; w.x = cvt_pk_bf16(v[i][0] * rs * gg[0], v[i][1] * rs * gg[1]); w.y = cvt_pk_bf16(v[i][2] * rs * gg[2], v[i][3] * rs * gg[3]);
            *(u32x2*)(dst + (size_t)r * 1024 + i * 256 + lane * 4) = w; }
    }
}
__device__ __forceinline__ void rmsnorm_f32_inplace(float* buf, const float* g, int rows) {
    const int lane = otid() & 63, gw = obid() * 8 + (otid() >> 6), nw = gridDim.x * 8;
    for (int r = gw; r < rows; r += nw) {
        float* p = buf + (size_t)r * 1024; f32x4 v[4]; float ss = 0.f;
#pragma unroll
        for (int i = 0; i < 4; ++i) { v[i] = *(const f32x4*)(p + i * 256 + lane * 4); ss += v[i][0] * v[i][0] + v[i][1] * v[i][1] + v[i][2] * v[i][2] + v[i][3] * v[i][3]; }
        ss = wave_sum(ss, lane); const float rs = rsqrtf(ss * (1.0f / 1024.0f) + 1e-6f);
#pragma unroll
        for (int i = 0; i < 4; ++i) { const f32x4 gg = *(const f32x4*)(g + i * 256 + lane * 4); *(f32x4*)(p + i * 256 + lane * 4) = v[i] * rs * gg; }
    }
}

__device__ __forceinline__ void rwkv_prep(KP P, int l) {
    unsigned char* ws = P->ws;
    const int c = otid(), lane = c & 63, h = c >> 6;
    const float* w2 = (const float*)P->in[7] + (size_t)l * 64 * 512; const float* a2 = (const float*)P->in[9] + (size_t)l * 64 * 512;
    const float* mu = (const float*)P->in[5] + (size_t)l * 1664;
    float w2c[64], a2c[64];
#pragma unroll
    for (int j = 0; j < 64; ++j) { w2c[j] = w2[j * 512 + c]; a2c[j] = a2[j * 512 + c]; }
    const float mu_r = mu[c], mu_k = mu[512 + c], mu_v = mu[1024 + c], mu_w = mu[1536 + lane], mu_a = mu[1600 + lane];
    const float w0c = ((const float*)P->in[6])[l * 512 + c], a0c = ((const float*)P->in[8])[l * 512 + c];
    const float kkc = ((const float*)P->in[10])[l * 512 + c], kac = ((const float*)P->in[11])[l * 512 + c], rkc = ((const float*)P->in[12])[l * 512 + c];
    const bf16_t* Z = (const bf16_t*)(ws + OFF_ZRW);
    float* PW = (float*)(ws + OFF_PW); float* PKK = (float*)(ws + OFF_PKK); float* PB = (float*)(ws + OFF_PB); float* PKM = (float*)(ws + OFF_PKM); float* PR = (float*)(ws + OFF_PR);
    bf16_t* PV = (bf16_t*)(ws + OFF_PV); float* BON = (float*)(ws + OFF_BON);
    for (int rng = obid(); rng < TB / 64; rng += gridDim.x) {
        const int t0 = rng * 64;
        float pr = 0.f, pk = 0.f, pv = 0.f, pwl = 0.f, pal = 0.f;
        if (t0 > 0) { const bf16_t* z = Z + (size_t)(t0 - 1) * 1792; pr = bf2f(z[c]); pk = bf2f(z[512 + c]); pv = bf2f(z[1024 + c]); pwl = bf2f(z[1536 + lane]); pal = bf2f(z[1600 + lane]); }
        for (int t = t0; t < t0 + 64; ++t) {
            const bf16_t* z = Z + (size_t)t * 1792;
            const float cr = bf2f(z[c]), ck = bf2f(z[512 + c]), cv = bf2f(z[1024 + c]), cwl = bf2f(z[1536 + lane]), cal = bf2f(z[1600 + lane]);
            const float rs = cr + (pr - cr) * mu_r, ks = ck + (pk - ck) * mu_k, vs = cv + (pv - cv) * mu_v;
            const float wl = tanhf_(cwl + (pwl - cwl) * mu_w), al = cal + (pal - cal) * mu_a;
            float accw = w0c, acca = a0c;
#pragma unroll
            for (int j = 0; j < 64; ++j) { accw += rlane(wl, j) * w2c[j]; acca += rlane(al, j) * a2c[j]; }
            const float logw = -softplusf_(-accw) - 0.5f;
            const float wdec = __expf(-__expf(logw));
            const float a = sigmoidf_(acca);
            const float kraw = ks * kkc;
            const float ss = wave_sum(kraw * kraw, lane);
            const float kk = kraw / fmaxf(sqrtf(ss), 1e-12f);
            const float km = ks * (1.0f + (a - 1.0f) * kac);
            const float bb = kk * a;
            const float bon = wave_sum(rs * km * rkc, lane);
            const size_t o = (size_t)t * 512 + c;
            PW[o] = wdec; PKK[o] = kk; PB[o] = bb; PKM[o] = km; PR[o] = rs; PV[o] = f2bf(vs);
            if (lane == 0) BON[(size_t)t * 8 + h] = bon;
            pr = cr; pk = ck; pv = cv; pwl = cwl; pal = cal;
        }
    }
}
__device__ __forceinline__ void rwkv_pass1(KP P) {
    unsigned char* ws = P->ws;
    const int wave = otid() >> 6, lane = otid() & 63;
    if (wave >= 4) return;
    const float* PW = (const float*)(ws + OFF_PW); const float* PKK = (const float*)(ws + OFF_PKK); const float* PB = (const float*)(ws + OFF_PB); const float* PKM = (const float*)(ws + OFF_PKM);
    const bf16_t* PV = (const bf16_t*)(ws + OFF_PV);
    float* PP = (float*)(ws + OFF_PP); float* PL = (float*)(ws + OFF_PL);
    for (int u = obid() * 4 + wave; u < 8 * NCH; u += gridDim.x * 4) {
        const int c = u >> 3, h = u & 7, col = h * 64 + lane;
        float sp[64], sl[64];
#pragma unroll
        for (int k = 0; k < 64; ++k) { sp[k] = (k == lane) ? 1.f : 0.f; sl[k] = 0.f; }
        size_t o = (size_t)c * LCH * 512 + col;
        float wv = PW[o], kkv = PKK[o], bv = PB[o], kmv = PKM[o], vv = bf2f(PV[o]);
        for (int i = 0; i < LCH; ++i) {
            const size_t on = (i + 1 < LCH) ? o + 512 : o;
            const float nwv = PW[on], nkkv = PKK[on], nbv = PB[on], nkmv = PKM[on], nvv = bf2f(PV[on]);
            float sap = 0.f, sal = 0.f;
#pragma unroll
            for (int k = 0; k < 64; ++k) { const float q = rlane(kkv, k); sap += sp[k] * q; sal += sl[k] * q; }
            sap = -sap; sal = -sal;
#pragma unroll
            for (int k = 0; k < 64; ++k) { const float wk = rlane(wv, k), bk = rlane(bv, k), kmk = rlane(kmv, k);
                sp[k] = sp[k] * wk + sap * bk;
                sl[k] = sl[k] * wk + (sal * bk + vv * kmk); }
            o = on; wv = nwv; kkv = nkkv; bv = nbv; kmv = nkmv; vv = nvv;
        }
        float* pp = PP + ((size_t)(h * NCH + c) * 64 + lane) * 64; float* pl = PL + ((size_t)(h * NCH + c) * 64 + lane) * 64;
#pragma unroll
        for (int k = 0; k < 64; k += 4) { *(f32x4*)(pp + k) = (f32x4){sp[k], sp[k + 1], sp[k + 2], sp[k + 3]}; *(f32x4*)(pl + k) = (f32x4){sl[k], sl[k + 1], sl[k + 2], sl[k + 3]}; }
    }
}
__device__ __forceinline__ void rwkv_cscan(KP P, float* xs  ) {
    unsigned char* ws = P->ws;
    const int jg = otid() >> 6, lane = otid() & 63;
    const float* PP = (const float*)(ws + OFF_PP); float* PL = (float*)(ws + OFF_PL);
    for (int h = obid(); h < 8; h += gridDim.x) {
        float s[64], mine[8];
#pragma unroll
        for (int k = 0; k < 64; ++k) s[k] = 0.f;
#pragma unroll
        for (int r = 0; r < 8; ++r) mine[r] = 0.f;
        for (int c = 0; c < NCH; ++c) {
            const size_t base = (size_t)(h * NCH + c) * 4096 + (size_t)lane * 64 + 8 * jg;
            const f32x4 p0 = *(const f32x4*)(PP + base), p1 = *(const f32x4*)(PP + base + 4);
            const f32x4 l0 = *(const f32x4*)(PL + base), l1 = *(const f32x4*)(PL + base + 4);
            float nw[8] = {l0[0], l0[1], l0[2], l0[3], l1[0], l1[1], l1[2], l1[3]};
            *(f32x4*)(PL + base) = (f32x4){mine[0], mine[1], mine[2], mine[3]}; *(f32x4*)(PL + base + 4) = (f32x4){mine[4], mine[5], mine[6], mine[7]};
#pragma unroll
            for (int i = 0; i < 64; ++i) { const float si = s[i];
                nw[0] += si * rlane(p0[0], i); nw[1] += si * rlane(p0[1], i); nw[2] += si * rlane(p0[2], i); nw[3] += si * rlane(p0[3], i);
                nw[4] += si * rlane(p1[0], i); nw[5] += si * rlane(p1[1], i); nw[6] += si * rlane(p1[2], i); nw[7] += si * rlane(p1[3], i); }
#pragma unroll
            for (int r = 0; r < 8; ++r) { mine[r] = nw[r]; xs[lane * 65 + 8 * jg + r] = nw[r]; }
            __syncthreads();
#pragma unroll
            for (int k = 0; k < 64; ++k) s[k] = xs[lane * 65 + k];
            __syncthreads();
        }
    }
}
__device__ __forceinline__ void rwkv_pass2(KP P, int l) {
    unsigned char* ws = P->ws;
    const int wave = otid() >> 6, lane = otid() & 63;
    if (wave >= 4) return;
    const float* PW = (const float*)(ws + OFF_PW); const float* PKK = (const float*)(ws + OFF_PKK); const float* PB = (const float*)(ws + OFF_PB); const float* PKM = (const float*)(ws + OFF_PKM); const float* PR = (const float*)(ws + OFF_PR);
    const bf16_t* PV = (const bf16_t*)(ws + OFF_PV); const float* BON = (const float*)(ws + OFF_BON);
    const float* PL = (const float*)(ws + OFF_PL); bf16_t* ZG = (bf16_t*)(ws + OFF_ZG);
    for (int u = obid() * 4 + wave; u < 8 * NCH; u += gridDim.x * 4) {
        const int c = u >> 3, h = u & 7, col = h * 64 + lane;
        const float lng = ((const float*)P->in[13])[l * 512 + col], lnb = ((const float*)P->in[14])[l * 512 + col];
        float s[64];
        const float* s0 = PL + ((size_t)(h * NCH + c) * 64 + lane) * 64;
#pragma unroll
        for (int k = 0; k < 64; k += 4) { const f32x4 q = *(const f32x4*)(s0 + k); s[k] = q[0]; s[k + 1] = q[1]; s[k + 2] = q[2]; s[k + 3] = q[3]; }
        int t = c * LCH;
        size_t o = (size_t)t * 512 + col;
        float wv = PW[o], kkv = PKK[o], bv = PB[o], kmv = PKM[o], rv = PR[o], vv = bf2f(PV[o]);
        for (int i = 0; i < LCH; ++i, ++t) {
            const size_t on = (i + 1 < LCH) ? o + 512 : o;
            const float nwv = PW[on], nkkv = PKK[on], nbv = PB[on], nkmv = PKM[on], nrv = PR[on], nvv = bf2f(PV[on]);
            const float gg = bf2f(ZG[(size_t)t * 2048 + col]); const float bon = BON[(size_t)t * 8 + h];
            float sa = 0.f;
#pragma unroll
            for (int k = 0; k < 64; ++k) sa += s[k] * rlane(kkv, k);
            sa = -sa;
            float y = 0.f;
#pragma unroll
            for (int k = 0; k < 64; ++k) { const float wk = rlane(wv, k), bk = rlane(bv, k), kmk = rlane(kmv, k), rk = rlane(rv, k);
                s[k] = s[k] * wk + (sa * bk + vv * kmk);
                y += s[k] * rk; }
            const float mean = wave_sum(y, lane) * (1.0f / 64.0f); const float d = y - mean;
            const float var = wave_sum(d * d, lane) * (1.0f / 64.0f);
            const float yn = d * rsqrtf(var + 64e-5f) * lng + lnb + bon * vv;
            ZG[(size_t)t * 2048 + col] = f2bf(yn * siluf_(gg));
            o = on; wv = nwv; kkv = nkkv; bv = nbv; kmv = nkmv; rv = nrv; vv = nvv;
        }
    }
}

__device__ __forceinline__ void rope_cs(int i, float posf, float& cs, float& sn) {
    const float inv = (float)exp2(-(double)i * (13.287712379549449 / 32.0));
    const float ang = posf * inv;
    const double a = (double)ang; const double kq = rint(a * 0.15915494309189535); const float r = (float)(a - kq * 6.283185307179586);
    cs = __cosf(r); sn = __sinf(r);
}
__device__ __forceinline__ void gr_stage_b(KP P, int l, int kind, int n, int h, float* Bm) {
    const int tid = otid(), t = tid >> 3, dg = tid & 7;
    if (kind == 0) {
        const bf16_t* zr = (const bf16_t*)(P->ws + OFF_ZGLA) + (size_t)(n * 64 + t) * 1280 + 1024;
        float fl[16];
        const u32x4 q0 = *(const u32x4*)zr, q1 = *(const u32x4*)(zr + 8);
#pragma unroll
        for (int e = 0; e < 4; ++e) { fl[2 * e] = __uint_as_float(q0[e] << 16); fl[2 * e + 1] = __uint_as_float(q0[e] & 0xffff0000u); fl[8 + 2 * e] = __uint_as_float(q1[e] << 16); fl[8 + 2 * e + 1] = __uint_as_float(q1[e] & 0xffff0000u); }
        const float* fup = (const float*)P->in[15] + (size_t)l * 16 * 256; const float* fb = (const float*)P->in[16] + (size_t)l * 256;
#pragma unroll
        for (int dd = 0; dd < 8; ++dd) { const int d = dg * 8 + dd; float x = fb[h * 64 + d];
#pragma unroll
            for (int j = 0; j < 16; ++j) x += fl[j] * fup[j * 256 + h * 64 + d];
            Bm[t * 64 + d] = -softplusf_(-x) * (1.0f / 16.0f); }
    } else {
        const float lg = __logf(1.0f - exp2f(-5.0f - (float)h));
#pragma unroll
        for (int dd = 0; dd < 8; ++dd) Bm[t * 64 + dg * 8 + dd] = lg;
    }
    __syncthreads();
    if (tid < 64) { float run = 0.f; for (int tt = 0; tt < 64; ++tt) { run += Bm[tt * 64 + tid]; Bm[tt * 64 + tid] = run; } }
    __syncthreads();
}
__device__ __forceinline__ float gr_qk(KP P, int b, int kind, int which, int tg, int h, int d) {
    if (kind == 0) { const bf16_t* z = (const bf16_t*)(P->ws + OFF_ZGLA) + (size_t)tg * 1280 + which * 256 + h * 64; return bf2f(z[d]); }
    const bf16_t* z = (const bf16_t*)(P->ws + OFF_ZRET) + (size_t)tg * 1024 + which * 256 + h * 64;
    const int i = d & 31; const float x1 = bf2f(z[i]), x2 = bf2f(z[i + 32]);
    const float posf = (float)((const int*)P->in[2])[(size_t)b * TB + tg];
    float cs, sn; rope_cs(i, posf, cs, sn);
    return d < 32 ? x1 * cs - x2 * sn : x1 * sn + x2 * cs;
}
__device__ __forceinline__ const bf16_t* gr_vptr(KP P, int kind, int tg, int h) {
    return kind == 0 ? (const bf16_t*)(P->ws + OFF_ZGLA) + (size_t)tg * 1280 + 512 + h * 128 : (const bf16_t*)(P->ws + OFF_ZRET) + (size_t)tg * 1024 + 512 + h * 128;
}
__device__ __forceinline__ void gr_ds(KP P, int l, int b, unsigned char* sm) {
    float* Bm = (float*)sm; bf16_t* KET = (bf16_t*)(sm + 16384); bf16_t* VT = (bf16_t*)(sm + 25600);
    const int tid = otid(), t = tid >> 3, dg = tid & 7, wave = tid >> 6, lane = tid & 63;
    float* DS = (float*)(P->ws + OFF_DSG); float* DEC = (float*)(P->ws + OFF_DEC);
    for (int idx = obid(); idx < 2048; idx += gridDim.x) {
        const int kind = idx >> 10, n = (idx >> 2) & 255, h = idx & 3, tg = n * 64 + t;
        gr_stage_b(P, l, kind, n, h, Bm);
#pragma unroll
        for (int dd = 0; dd < 8; ++dd) { const int d = dg * 8 + dd; const float bl = Bm[63 * 64 + d], bt = Bm[t * 64 + d];
            float kv = gr_qk(P, b, kind, 1, tg, h, d); if (kind == 1) kv *= 0.125f;
            KET[d * 72 + t] = f2bf(kv * __expf(bl - bt));
            if (t == 63 && kind == 0) DEC[(size_t)(n * 4 + h) * 64 + d] = __expf(bl); }
        { const bf16_t* vp = gr_vptr(P, kind, tg, h) + dg * 16;
#pragma unroll
            for (int e = 0; e < 16; ++e) VT[(dg * 16 + e) * 72 + t] = vp[e]; }
        __syncthreads();
        f32x4 acc[4];
#pragma unroll
        for (int mt = 0; mt < 4; ++mt) acc[mt] = (f32x4){0.f, 0.f, 0.f, 0.f};
#pragma unroll
        for (int ks = 0; ks < 2; ++ks) { const bf16x8 bf = *(const bf16x8*)(VT + (wave * 16 + (lane & 15)) * 72 + ks * 32 + (lane >> 4) * 8);
#pragma unroll
            for (int mt = 0; mt < 4; ++mt) { const bf16x8 af = *(const bf16x8*)(KET + (mt * 16 + (lane & 15)) * 72 + ks * 32 + (lane >> 4) * 8);
                acc[mt] = __builtin_amdgcn_mfma_f32_16x16x32_bf16(af, bf, acc[mt], 0, 0, 0); } }
        float* dsp = DS + ((size_t)(kind * 256 + n) * 4 + h) * 64 * 128;
#pragma unroll
        for (int mt = 0; mt < 4; ++mt)
#pragma unroll
            for (int j = 0; j < 4; ++j) dsp[(size_t)(mt * 16 + (lane >> 4) * 4 + j) * 128 + wave * 16 + (lane & 15)] = acc[mt][j];
        __syncthreads();
    }
}
__device__ __forceinline__ void gr_scan(KP P) {
    float* DS = (float*)(P->ws + OFF_DSG); const float* DEC = (const float*)(P->ws + OFF_DEC);
    for (int blk = obid(); blk < 129; blk += gridDim.x) {
        if (blk < 128) {
            const int gid = blk * 512 + otid(), kind = gid >> 15, e = gid & 32767, h = e >> 13, d = (e >> 7) & 63, vch = e & 127;
            const float rdec = __expf(64.0f * __logf(1.0f - exp2f(-5.0f - (float)h)));
            float st = 0.f;
            for (int n0 = 0; n0 < 256; n0 += 8) {
                float dsv[8], dc[8];
#pragma unroll
                for (int q = 0; q < 8; ++q) { const int n = n0 + q; dsv[q] = DS[(((size_t)(kind * 256 + n) * 4 + h) * 64 + d) * 128 + vch]; dc[q] = kind == 0 ? DEC[(size_t)(n * 4 + h) * 64 + d] : rdec; }
#pragma unroll
                for (int q = 0; q < 8; ++q) { const int n = n0 + q; DS[(((size_t)(kind * 256 + n) * 4 + h) * 64 + d) * 128 + vch] = st; st = st * dc[q] + dsv[q]; }
            }
        } else {
            const float* AC = (const float*)(P->ws + OFF_AC); const float* HC = (const float*)(P->ws + OFF_HC); float* HIN = (float*)(P->ws + OFF_HIN);
            const int d = otid(); float hin = 0.f;
            for (int n = 0; n < 256; ++n) { HIN[n * 512 + d] = hin; hin = AC[n * 512 + d] * hin + HC[n * 512 + d]; }
        }
    }
}
__device__ __forceinline__ void gr_out(KP P, int l, int b, unsigned char* sm) {
    float* Bm = (float*)sm; bf16_t* QD = (bf16_t*)(sm + 16384); bf16_t* KD = (bf16_t*)(sm + 25600); bf16_t* ATT = (bf16_t*)(sm + 34816);
    bf16_t* VT = (bf16_t*)(sm + 44032); bf16_t* ST = (bf16_t*)(sm + 62464); float* O = (float*)(sm + 80896);
    const int tid = otid(), t = tid >> 3, dg = tid & 7, wave = tid >> 6, lane = tid & 63;
    const float* DS = (const float*)(P->ws + OFF_DSG); bf16_t* ZG = (bf16_t*)(P->ws + OFF_ZG);
    for (int idx = obid(); idx < 2048; idx += gridDim.x) {
        const int kind = idx >> 10, n = (idx >> 2) & 255, h = idx & 3, tg = n * 64 + t;
        gr_stage_b(P, l, kind, n, h, Bm);
#pragma unroll
        for (int dd = 0; dd < 8; ++dd) { const int d = dg * 8 + dd; const float bt = Bm[t * 64 + d];
            float qv = gr_qk(P, b, kind, 0, tg, h, d), kv = gr_qk(P, b, kind, 1, tg, h, d);
            if (kind == 0) qv *= 0.125f; else kv *= 0.125f;
            QD[t * 72 + d] = f2bf(qv * __expf(bt)); KD[t * 72 + d] = f2bf(kv * __expf(-bt)); }
        { const bf16_t* vp = gr_vptr(P, kind, tg, h) + dg * 16;
#pragma unroll
            for (int e = 0; e < 16; ++e) VT[(dg * 16 + e) * 72 + t] = vp[e]; }
        { const float* dsp = DS + ((size_t)(kind * 256 + n) * 4 + h) * 64 * 128;
#pragma unroll
            for (int i = 0; i < 16; ++i) { const int e = tid + i * 512, d = e >> 7, vch = e & 127; ST[vch * 72 + d] = f2bf(dsp[e]); } }
        __syncthreads();
        {
            const int nt = wave & 3, mt0 = (wave >> 2) * 2;
            f32x4 a2[2] = {(f32x4){0.f, 0.f, 0.f, 0.f}, (f32x4){0.f, 0.f, 0.f, 0.f}};
#pragma unroll
            for (int ks = 0; ks < 2; ++ks) { const bf16x8 bf = *(const bf16x8*)(KD + (nt * 16 + (lane & 15)) * 72 + ks * 32 + (lane >> 4) * 8);
#pragma unroll
                for (int i = 0; i < 2; ++i) { const bf16x8 af = *(const bf16x8*)(QD + ((mt0 + i) * 16 + (lane & 15)) * 72 + ks * 32 + (lane >> 4) * 8);
                    a2[i] = __builtin_amdgcn_mfma_f32_16x16x32_bf16(af, bf, a2[i], 0, 0, 0); } }
#pragma unroll
            for (int i = 0; i < 2; ++i)
#pragma unroll
                for (int j = 0; j < 4; ++j) { const int tt = (mt0 + i) * 16 + (lane >> 4) * 4 + j, ss = nt * 16 + (lane & 15);
                    ATT[tt * 72 + ss] = f2bf(ss <= tt ? a2[i][j] : 0.f); }
        }
        __syncthreads();
        {
            f32x4 acc[4];
#pragma unroll
            for (int mt = 0; mt < 4; ++mt) acc[mt] = (f32x4){0.f, 0.f, 0.f, 0.f};
#pragma unroll
            for (int ks = 0; ks < 2; ++ks) {
                const bf16x8 b1 = *(const bf16x8*)(VT + (wave * 16 + (lane & 15)) * 72 + ks * 32 + (lane >> 4) * 8);
                const bf16x8 b2 = *(const bf16x8*)(ST + (wave * 16 + (lane & 15)) * 72 + ks * 32 + (lane >> 4) * 8);
#pragma unroll
                for (int mt = 0; mt < 4; ++mt) {
                    const bf16x8 a1 = *(const bf16x8*)(ATT + (mt * 16 + (lane & 15)) * 72 + ks * 32 + (lane >> 4) * 8);
                    const bf16x8 aq = *(const bf16x8*)(QD + (mt * 16 + (lane & 15)) * 72 + ks * 32 + (lane >> 4) * 8);
                    acc[mt] = __builtin_amdgcn_mfma_f32_16x16x32_bf16(a1, b1, acc[mt], 0, 0, 0);
                    acc[mt] = __builtin_amdgcn_mfma_f32_16x16x32_bf16(aq, b2, acc[mt], 0, 0, 0); } }
#pragma unroll
            for (int mt = 0; mt < 4; ++mt)
#pragma unroll
                for (int j = 0; j < 4; ++j) O[(mt * 16 + (lane >> 4) * 4 + j) * 132 + wave * 16 + (lane & 15)] = acc[mt][j];
        }
        __syncthreads();
        {
            float v[16]; float s1 = 0.f, s2 = 0.f;
#pragma unroll
            for (int e = 0; e < 16; ++e) { v[e] = O[t * 132 + dg * 16 + e]; s1 += v[e]; s2 += v[e] * v[e]; }
#pragma unroll
            for (int o = 1; o <= 4; o <<= 1) { s1 += shx(s1, lane, o); s2 += shx(s2, lane, o); }
            float mean = 0.f, rs;
            if (kind == 0) rs = rsqrtf(s2 * (1.0f / 128.0f) + 1e-6f);
            else { mean = s1 * (1.0f / 128.0f); const float var = fmaxf(s2 * (1.0f / 128.0f) - mean * mean, 0.f); rs = rsqrtf(var + 1e-6f); }
            const float* gn = (kind == 0 ? (const float*)P->in[17] : (const float*)P->in[18]) + (size_t)l * 512 + h * 128 + dg * 16;
            bf16_t* gp = ZG + (size_t)tg * 2048 + (kind == 0 ? 512 : 1024) + h * 128 + dg * 16;
            const u32x4 g0 = *(const u32x4*)gp, g1 = *(const u32x4*)(gp + 8);
            float gv[16];
#pragma unroll
            for (int e = 0; e < 4; ++e) { gv[2 * e] = __uint_as_float(g0[e] << 16); gv[2 * e + 1] = __uint_as_float(g0[e] & 0xffff0000u); gv[8 + 2 * e] = __uint_as_float(g1[e] << 16); gv[8 + 2 * e + 1] = __uint_as_float(g1[e] & 0xffff0000u); }
            float r[16];
#pragma unroll
            for (int e = 0; e < 16; ++e) r[e] = (v[e] - mean) * rs * gn[e] * siluf_(gv[e]);
            u32x4 w0, w1;
            w0.x = cvt_pk_bf16(r[0], r[1]); w0.y = cvt_pk_bf16(r[2], r[3]); w0.z = cvt_pk_bf16(r[4], r[5]); w0.w = cvt_pk_bf16(r[6], r[7]);
            w1.x = cvt_pk_bf16(r[8], r[9]); w1.y = cvt_pk_bf16(r[10], r[11]); w1.z = cvt_pk_bf16(r[12], r[13]); w1.w = cvt_pk_bf16(r[14], r[15]);
            *(u32x4*)gp = w0; *(u32x4*)(gp + 8) = w1;
        }
        __syncthreads();
    }
}

__device__ __forceinline__ void lru_p1(KP P, int l) {
    unsigned char* ws = P->ws;
    const int d = otid(), lane = d & 63, blk = d >> 6;
    const float* wa = (const float*)P->in[21] + ((size_t)l * 8 + blk) * 4096; const float* wx = (const float*)P->in[23] + ((size_t)l * 8 + blk) * 4096;
    float wac[64], wxc[64];
#pragma unroll
    for (int c = 0; c < 64; ++c) { wac[c] = wa[c * 64 + lane]; wxc[c] = wx[c * 64 + lane]; }
    const float* cwp = (const float*)P->in[19] + (size_t)l * 4 * 512;
    const float cw0 = cwp[d], cw1 = cwp[512 + d], cw2 = cwp[1024 + d], cw3 = cwp[1536 + d], cb = ((const float*)P->in[20])[l * 512 + d];
    const float ba = ((const float*)P->in[22])[l * 512 + d], bx = ((const float*)P->in[24])[l * 512 + d];
    const float sp = softplusf_(-((const float*)P->in[25])[l * 512 + d]);
    const bf16_t* X = (const bf16_t*)(ws + OFF_ZLRU);
    float* HL = (float*)(ws + OFF_HL); float* CA = (float*)(ws + OFF_CA); float* AC = (float*)(ws + OFF_AC); float* HC = (float*)(ws + OFF_HC);
    for (int n = obid(); n < 256; n += gridDim.x) {
        const int t0 = n * 64;
        float x1 = 0.f, x2 = 0.f, x3 = 0.f;
        if (t0 > 0) { x1 = bf2f(X[(size_t)(t0 - 1) * 512 + d]); x2 = bf2f(X[(size_t)(t0 - 2) * 512 + d]); x3 = bf2f(X[(size_t)(t0 - 3) * 512 + d]); }
        float hloc = 0.f, cum = 1.f;
        for (int t = t0; t < t0 + 64; ++t) {
            const float x0 = bf2f(X[(size_t)t * 512 + d]);
            const float xc = x3 * cw0 + x2 * cw1 + x1 * cw2 + x0 * cw3 + cb;
            float ra = ba, ri = bx;
#pragma unroll
            for (int c = 0; c < 64; ++c) { const float xv = rlane(xc, c); ra += xv * wac[c]; ri += xv * wxc[c]; }
            const float r = sigmoidf_(ra), ig = sigmoidf_(ri);
            const float la = -8.0f * r * sp; const float a = __expf(la);
            const float x2l = 2.0f * la;
            const float om = x2l > -0.02f ? -(x2l * (1.0f + x2l * (0.5f + x2l * (1.0f / 6.0f)))) : 1.0f - __expf(x2l);
            const float uu = sqrtf(fmaxf(om, 0.f)) * (ig * xc);
            hloc = a * hloc + uu; cum *= a;
            HL[(size_t)t * 512 + d] = hloc; CA[(size_t)t * 512 + d] = cum;
            x3 = x2; x2 = x1; x1 = x0;
        }
        AC[n * 512 + d] = cum; HC[n * 512 + d] = hloc;
    }
}
__device__ __forceinline__ void lru_p3(KP P) {
    unsigned char* ws = P->ws;
    const float* HL = (const float*)(ws + OFF_HL); const float* CA = (const float*)(ws + OFF_CA); const float* HIN = (const float*)(ws + OFF_HIN);
    bf16_t* ZG = (bf16_t*)(ws + OFF_ZG);
    const size_t total = (size_t)TB * 128;
    for (size_t i = (size_t)obid() * 512 + otid(); i < total; i += (size_t)gridDim.x * 512) {
        const int t = (int)(i >> 7), d4 = (int)(i & 127) * 4;
        const f32x4 hl = *(const f32x4*)(HL + (size_t)t * 512 + d4), ca = *(const f32x4*)(CA + (size_t)t * 512 + d4), hi = *(const f32x4*)(HIN + (size_t)(t >> 6) * 512 + d4);
        bf16_t* gp = ZG + (size_t)t * 2048 + 1536 + d4;
        const u32x2 gq = *(const u32x2*)gp;
        const float g0 = __uint_as_float(gq.x << 16), g1 = __uint_as_float(gq.x & 0xffff0000u), g2 = __uint_as_float(gq.y << 16), g3 = __uint_as_float(gq.y & 0xffff0000u);
        u32x2 w; w.x = cvt_pk_bf16((hl[0] + ca[0] * hi[0]) * siluf_(g0), (hl[1] + ca[1] * hi[1]) * siluf_(g1));
        w.y = cvt_pk_bf16((hl[2] + ca[2] * hi[2]) * siluf_(g2), (hl[3] + ca[3] * hi[3]) * siluf_(g3));
        *(u32x2*)gp = w;
    }
}

#define XB_TMO      128
#define XB_XCNT(j)  (256  + 64 * (j))
#define XB_XSUB(j)  (1280 + 64 * (j))
#define XB_XGEN(j)  (2304 + 64 * (j))
#define XB_TOP      3328
#define XB_TOPGEN   3392
#define XCD_BAR_WORDS 3456
#define XB_SPIN_CAP (1u << 22)
__device__ __forceinline__ unsigned xb_ld(unsigned* p)              { return __hip_atomic_load(p, __ATOMIC_RELAXED, __HIP_MEMORY_SCOPE_AGENT); }
__device__ __forceinline__ unsigned xb_add(unsigned* p, unsigned v) { return __hip_atomic_fetch_add(p, v, __ATOMIC_RELAXED, __HIP_MEMORY_SCOPE_AGENT); }
__device__ __forceinline__ unsigned xb_xcc_id() { return (unsigned)__builtin_amdgcn_s_getreg((3 << 11) | 20) & 0xFu; }
#define XB_SPIN(cond, bar) do { unsigned _sp = 0; while (cond) { __builtin_amdgcn_s_sleep(1); \
    if ((++_sp & 255u) == 0u) { if (xb_ld(&(bar)[XB_TMO])) break; if (_sp > XB_SPIN_CAP) { atomicAdd(&(bar)[XB_TMO], 1u); break; } } } } while (0)
struct XcdBarrier { unsigned* bar; unsigned x; volatile LAS unsigned* st; };
__device__ __forceinline__ XcdBarrier xcd_barrier_post(unsigned* bar, volatile LAS unsigned* st) {
    XcdBarrier b; b.bar = bar; b.x = xb_xcc_id(); b.st = st;
    if (threadIdx.x == 0) (void)xb_add(&bar[XB_XCNT(b.x)], 1u);
    return b;
}
__device__ __forceinline__ void xcd_barrier_complete(unsigned* bar, unsigned x, unsigned& nloc, unsigned& nx) {
    const unsigned G = gridDim.x * gridDim.y * gridDim.z;
    unsigned sum, cnt, mine, sp = 0u;
    for (;;) {
        sum = 0u; cnt = 0u; mine = 0u;
#pragma unroll
        for (unsigned j = 0; j < 16; ++j) { const unsigned c = xb_ld(&bar[XB_XCNT(j)]); sum += c; cnt += (c > 0u) ? 1u : 0u; mine = (j == x) ? c : mine; }
        if (sum == G) break;
        __builtin_amdgcn_s_sleep(1);
        if ((++sp & 255u) == 0u) { if (xb_ld(&bar[XB_TMO])) break; if (sp > XB_SPIN_CAP) { atomicAdd(&bar[XB_TMO], 1u); break; } }
    }
    nloc = mine > 0u ? mine : 1u; nx = cnt > 0u ? cnt : 1u;
}
__device__ __forceinline__ void xcd_barrier(const XcdBarrier& b) {
    asm volatile("s_waitcnt vmcnt(0)" ::: "memory");
    __syncthreads();
    if (threadIdx.x == 0) {
        unsigned* bar = b.bar;
        __builtin_amdgcn_s_waitcnt(0);
        unsigned nloc = b.st[0], nx = b.st[1];
        if (nloc == 0u) { xcd_barrier_complete(bar, b.x, nloc, nx); b.st[0] = nloc; b.st[1] = nx; }
        const unsigned old = xb_add(&bar[XB_XSUB(b.x)], 1u);
        const unsigned gen = old / nloc;
        if (old + 1u == (gen + 1u) * nloc) {
            __builtin_amdgcn_fence(__ATOMIC_RELEASE, "agent");
            asm volatile("s_waitcnt vmcnt(0)" ::: "memory");
            const unsigned og = xb_add(&bar[XB_TOP], 1u);
            const unsigned tg = og / nx;
            if (og + 1u == (tg + 1u) * nx) xb_add(&bar[XB_TOPGEN], 1u);
            else XB_SPIN(xb_ld(&bar[XB_TOPGEN]) == tg, bar);
            __builtin_amdgcn_fence(__ATOMIC_ACQUIRE, "agent");
            xb_add(&bar[XB_XGEN(b.x)], 1u);
            asm volatile("s_waitcnt vmcnt(0)" ::: "memory");
        } else {
            XB_SPIN(xb_ld(&bar[XB_XGEN(b.x)]) == gen, bar);
            __builtin_amdgcn_fence(__ATOMIC_ACQUIRE, "agent");
            asm volatile("s_waitcnt vmcnt(0)" ::: "memory");
        }
    }
    __syncthreads();
}

__global__ void __launch_bounds__(512) fwd_megakernel(Params Parg) {
    extern __shared__ __attribute__((aligned(16))) unsigned char shm[];
    cg::grid_group grid = cg::this_grid();
    LAS unsigned char* lds = (LAS unsigned char*)shm;
    using namespace pg8;
    if (threadIdx.x < 4) ((volatile LAS unsigned*)(lds + STAGE_BYTES + 16384))[threadIdx.x] = 0u;
    __syncthreads();
    { KP Pb = kparams(); (void)xcd_barrier_post((unsigned*)(Pb->ws + OFF_BAR), (volatile LAS unsigned*)(lds + STAGE_BYTES + 16384)); }
    grid.sync();
#ifndef DUP_GEMM
#define DUP_GEMM 1
#endif
#ifndef DUP_RW
#define DUP_RW 1
#endif
#ifndef DUP_GR
#define DUP_GR 1
#endif
#ifndef DUP_MISC
#define DUP_MISC 1
#endif
#ifndef NSYNC
#define NSYNC 1
#endif
#define REP(n) _Pragma("nounroll") for (int _d = 0; _d < (n); ++_d)
#define GSYNC() do { REP(NSYNC) { KP Pb = kparams(); XcdBarrier xb_; xb_.bar = (unsigned*)(Pb->ws + OFF_BAR); xb_.x = xb_xcc_id(); xb_.st = (volatile LAS unsigned*)(lds + STAGE_BYTES + 16384); xcd_barrier(xb_); } } while (0)
    for (int l = 0; l < 2; ++l) {
        { KP P = kparams(); unsigned char* ws = P->ws;
          conv_t<true>((bf16_t*)(ws + OFF_WIN), (const float*)P->in[4] + (size_t)l * 1024 * NIN, 10752, 1024, NIN); }
        for (int n = 0; n < 4; ++n) { KP P = kparams(); unsigned char* ws = P->ws;
          conv_t<false>((bf16_t*)(ws + OFF_WB) + (size_t)n * 1024 * 512, (const float*)P->in[26] + ((size_t)l * 4 + n) * 512 * 1024, 1024, 512, 1024); }
        { KP P = kparams(); unsigned char* ws = P->ws; conv_t<false>((bf16_t*)(ws + OFF_WOUT), (const float*)P->in[27] + (size_t)l * 1024 * 1024, 1024, 1024, 1024); }
        { KP P = kparams(); unsigned char* ws = P->ws; conv_t<false>((bf16_t*)(ws + OFF_WQ), (const float*)P->in[30] + (size_t)l * 1024 * 1024, 1024, 1024, 1024); }
        { KP P = kparams(); unsigned char* ws = P->ws; conv_t<false>((bf16_t*)(ws + OFF_WKV), (const float*)P->in[31] + (size_t)l * 1024 * 2048, 2048, 1024, 2048); }
        { KP P = kparams(); unsigned char* ws = P->ws; conv_t<false>((bf16_t*)(ws + OFF_WO), (const float*)P->in[32] + (size_t)l * 1024 * 1024, 1024, 1024, 1024); }
        { KP P = kparams(); unsigned char* ws = P->ws; rmsnorm_bf16((const float*)P->in[1], (const float*)P->in[29] + l * 1024, (bf16_t*)(ws + OFF_MN), 512); }
        for (int b = 0; b < 2; ++b) {
            { KP P = kparams(); unsigned char* ws = P->ws;
              const float* hin = (l == 0 ? (const float*)P->in[0] : (const float*)P->out) + (size_t)b * TB * DM;
              rmsnorm_bf16(hin, (const float*)P->in[3] + l * 1024, (bf16_t*)(ws + OFF_UN), TB); }
            GSYNC();
            if (b == 0) { KP P = kparams(); unsigned char* ws = P->ws;
                Order S; S.init(2, 8, 1, ws + OFF_MN, ws + OFF_WKV, 256L * 1024 * 2, 256L * 1024 * 2, 0, 0, 0);
                EpiKV E{(bf16_t*)(ws + OFF_KM), (bf16_t*)(ws + OFF_VT)}; gemm_phase(lds, Gemm{1024, 1024, 1024}, S, E); }
            REP(DUP_GEMM) { KP P = kparams(); unsigned char* ws = P->ws;
                Order S; S.init(64, 26, 1, ws + OFF_UN, ws + OFF_WIN, 256L * 1024 * 2, 256L * 1024 * 2, 0, 0, 0);
                EpiInproj E{ws}; gemm_phase(lds, Gemm{1024, 1024, 1024}, S, E); }
            GSYNC();
            REP(DUP_RW) rwkv_prep(kparams(), l);
            GSYNC();
            REP(DUP_RW) rwkv_pass1(kparams());
            GSYNC();
            rwkv_cscan(kparams(), (float*)shm);
            GSYNC();
            rwkv_pass2(kparams(), l);
            GSYNC();
            REP(DUP_GR) gr_ds(kparams(), l, b, shm);
            REP(DUP_MISC) lru_p1(kparams(), l);
            GSYNC();
            gr_scan(kparams());
            GSYNC();
            gr_out(kparams(), l, b, shm);
            lru_p3(kparams());
            GSYNC();
            REP(DUP_GEMM) { KP P = kparams(); unsigned char* ws = P->ws;
                Order S; S.init(64, 16, 1, ws + OFF_UN, ws + OFF_WIN + (size_t)6656 * 1024 * 2, 256L * 1024 * 2, 256L * 1024 * 2, 0, 0, 0);
                EpiBf16<1> E{(bf16_t*)(ws + OFF_G), 4096, 1.0f}; gemm_phase(lds, Gemm{1024, 1024, 1024}, S, E); }
            GSYNC();
            REP(DUP_GEMM) { KP P = kparams(); unsigned char* ws = P->ws;
                Order S; S.init(64, 4, 4, ws + OFF_ZG, ws + OFF_WB, 256L * 2048 * 2, 256L * 512 * 2, 0, 512L * 2, 1024L * 512 * 2);
                EpiMerge E{(const bf16_t*)(ws + OFF_G), (bf16_t*)(ws + OFF_MRG)}; gemm_phase(lds, Gemm{2048, 512, 512}, S, E); }
            GSYNC();
            { KP P = kparams(); unsigned char* ws = P->ws;
                const float* hin = (l == 0 ? (const float*)P->in[0] : (const float*)P->out) + (size_t)b * TB * DM; float* hout = P->out + (size_t)b * TB * DM;
                Order S; S.init(64, 4, 1, ws + OFF_MRG, ws + OFF_WOUT, 256L * 1024 * 2, 256L * 1024 * 2, 0, 0, 0);
                EpiResid E{hin, hout}; gemm_phase(lds, Gemm{1024, 1024, 1024}, S, E); }
            GSYNC();
            { KP P = kparams(); unsigned char* ws = P->ws; const float* hout = P->out + (size_t)b * TB * DM;
              rmsnorm_bf16(hout, (const float*)P->in[28] + l * 1024, (bf16_t*)(ws + OFF_UN), TB); }
            GSYNC();
            REP(DUP_GEMM) { KP P = kparams(); unsigned char* ws = P->ws;
                Order S; S.init(64, 4, 1, ws + OFF_UN, ws + OFF_WQ, 256L * 1024 * 2, 256L * 1024 * 2, 0, 0, 0);
                EpiBf16<0> E{(bf16_t*)(ws + OFF_Q), 1024, 0.0625f}; gemm_phase(lds, Gemm{1024, 1024, 1024}, S, E); }
            GSYNC();
            REP(DUP_GEMM) { KP P = kparams(); unsigned char* ws = P->ws;
                Order S; S.init(64, 4, 1, ws + OFF_Q, ws + OFF_KM + (size_t)b * 256 * 1024 * 2, 256L * 1024 * 2, 256L * 2, 256L * 2, 0, 0);
                EpiSoftmax E{(bf16_t*)(ws + OFF_P), (LAS float*)(lds + STAGE_BYTES)}; gemm_phase(lds, Gemm{1024, 1024, 256}, S, E); }
            GSYNC();
            REP(DUP_GEMM) { KP P = kparams(); unsigned char* ws = P->ws;
                Order S; S.init(64, 4, 1, ws + OFF_P, ws + OFF_VT + (size_t)b * 1024 * 256 * 2, 256L * 1024 * 2, 256L * 256 * 2, 256L * 2, 0, 0);
                EpiBf16<0> E{(bf16_t*)(ws + OFF_O), 1024, 1.0f}; gemm_phase(lds, Gemm{1024, 256, 256}, S, E); }
            GSYNC();
            { KP P = kparams(); unsigned char* ws = P->ws; float* hout = P->out + (size_t)b * TB * DM;
                Order S; S.init(64, 4, 1, ws + OFF_O, ws + OFF_WO, 256L * 1024 * 2, 256L * 1024 * 2, 0, 0, 0);
                EpiResid E{hout, hout}; gemm_phase(lds, Gemm{1024, 1024, 1024}, S, E); }
            GSYNC();
        }
    }
    { KP P = kparams(); rmsnorm_f32_inplace(P->out, (const float*)P->in[33], 2 * TB); }
}

extern "C" void kernel_launch(void* const* d_in, const int* in_sizes, int n_in, void* d_out, int out_size, void* d_ws, size_t ws_size, hipStream_t stream) {
    constexpr size_t kDynLds = pg8::STAGE_BYTES + 16384 + 64;
    static int grid_blocks = 0;
    if (!grid_blocks) {
        int dev = 0, cus = 0, per_cu = 0;
        hipGetDevice(&dev);
        hipDeviceGetAttribute(&cus, hipDeviceAttributeMultiprocessorCount, dev);
        hipFuncSetAttribute((const void*)fwd_megakernel, hipFuncAttributeMaxDynamicSharedMemorySize, (int)kDynLds);
        hipOccupancyMaxActiveBlocksPerMultiprocessor(&per_cu, (const void*)fwd_megakernel, 512, kDynLds);
        if (per_cu < 1) { fprintf(stderr, "occupancy query returned %d\n", per_cu); per_cu = 1; }
        grid_blocks = cus * per_cu;
        if (ws_size < OFF_END) fprintf(stderr, "workspace too small: %zu < %zu\n", ws_size, (size_t)OFF_END);
    }
    hipMemsetAsync((unsigned char*)d_ws + OFF_BAR, 0, 16384, stream);
    Params p{};
    for (int i = 0; i < 34; ++i) p.in[i] = d_in[i];
    p.out = (float*)d_out; p.ws = (unsigned char*)d_ws;
    void* args[] = {&p};
    hipError_t e = hipLaunchCooperativeKernel((const void*)fwd_megakernel, dim3(grid_blocks), dim3(512), args, kDynLds, stream);
    if (e != hipSuccess) fprintf(stderr, "cooperative launch failed: %s (grid %d)\n", hipGetErrorString(e), grid_blocks);
}
```

```cpp
#include <hip/hip_runtime.h>
#include <hip/hip_cooperative_groups.h>
#include <cstdio>
namespace cg = cooperative_groups;

typedef unsigned short bf16_t;
typedef short bf16x8 __attribute__((ext_vector_type(8)));
typedef float f32x4 __attribute__((ext_vector_type(4)));
typedef unsigned u32x4 __attribute__((ext_vector_type(4)));
typedef unsigned u32x2 __attribute__((ext_vector_type(2)));
#define LAS __attribute__((address_space(3)))

constexpr int TB = 16384;
constexpr int DM = 1024;
constexpr int NIN = 10384;
constexpr int NCH = 128, LCH = 128;

constexpr size_t SZ_WIN = (size_t)10752 * 1024 * 2;
constexpr size_t OFF_WIN = 0;
constexpr size_t OFF_WB = OFF_WIN + SZ_WIN;
constexpr size_t OFF_WOUT = OFF_WB + (size_t)4 * 1024 * 512 * 2;
constexpr size_t OFF_WQ = OFF_WOUT + (size_t)1024 * 1024 * 2;
constexpr size_t OFF_WKV = OFF_WQ + (size_t)1024 * 1024 * 2;
constexpr size_t OFF_WO = OFF_WKV + (size_t)2048 * 1024 * 2;
constexpr size_t OFF_UN = OFF_WO + (size_t)1024 * 1024 * 2;
constexpr size_t OFF_MN = OFF_UN + (size_t)TB * 1024 * 2;
constexpr size_t OFF_KM = OFF_MN + (size_t)512 * 1024 * 2;
constexpr size_t OFF_VT = OFF_KM + (size_t)512 * 1024 * 2;
constexpr size_t OFF_ZRW = OFF_VT + (size_t)512 * 1024 * 2;
constexpr size_t OFF_ZGLA = OFF_ZRW + (size_t)TB * 1792 * 2;
constexpr size_t OFF_ZRET = OFF_ZGLA + (size_t)TB * 1280 * 2;
constexpr size_t OFF_ZLRU = OFF_ZRET + (size_t)TB * 1024 * 2;
constexpr size_t OFF_ZG = OFF_ZLRU + (size_t)TB * 512 * 2;
constexpr size_t OFF_MRG = OFF_ZG + (size_t)TB * 2048 * 2;
constexpr size_t OFF_PREP = OFF_MRG + (size_t)TB * 1024 * 2;
constexpr size_t SZ_F = (size_t)TB * 512 * 4;
constexpr size_t OFF_PW = OFF_PREP, OFF_PKK = OFF_PW + SZ_F, OFF_PB = OFF_PKK + SZ_F, OFF_PKM = OFF_PB + SZ_F, OFF_PR = OFF_PKM + SZ_F;
constexpr size_t OFF_PV = OFF_PR + SZ_F;
constexpr size_t OFF_BON = OFF_PV + (size_t)TB * 512 * 2;
constexpr size_t OFF_BAR = OFF_BON + (size_t)TB * 8 * 4;
constexpr size_t OFF_END = OFF_BAR + 16384;
constexpr size_t OFF_G = OFF_ZRW;
constexpr size_t OFF_Q = OFF_ZRW;
constexpr size_t OFF_P = OFF_Q + (size_t)TB * 1024 * 2;
constexpr size_t OFF_O = OFF_P + (size_t)TB * 1024 * 2;
constexpr size_t OFF_PP = OFF_MRG;
constexpr size_t OFF_PL = OFF_MRG + (size_t)8 * NCH * 4096 * 4;
constexpr size_t OFF_DSG = OFF_PREP;
constexpr size_t OFF_DEC = OFF_DSG + (size_t)2 * 256 * 4 * 64 * 128 * 4;
constexpr size_t OFF_HL = OFF_DEC + (size_t)256 * 4 * 64 * 4;
constexpr size_t OFF_CA = OFF_HL + SZ_F;
constexpr size_t OFF_AC = OFF_CA + SZ_F;
constexpr size_t OFF_HC = OFF_AC + (size_t)256 * 512 * 4;
constexpr size_t OFF_HIN = OFF_HC + (size_t)256 * 512 * 4;
static_assert(OFF_HIN + 256 * 512 * 4 <= OFF_END, "overlay");
static_assert(OFF_END <= (size_t)512 * 1024 * 1024, "ws");

struct Params { const void* in[34]; float* out; unsigned char* ws; };
typedef const Params __attribute__((address_space(4)))* KP;
__device__ __forceinline__ KP kparams() { KP p = (KP)__builtin_amdgcn_kernarg_segment_ptr(); asm volatile("" : "+s"(p)); return p; }

__device__ __forceinline__ float bf2f(bf16_t v) { return __uint_as_float(((unsigned)v) << 16); }
__device__ __forceinline__ bf16_t f2bf(float f) { unsigned u = __float_as_uint(f); u += 0x7fffu + ((u >> 16) & 1u); return (bf16_t)(u >> 16); }
__device__ __forceinline__ unsigned cvt_pk_bf16(float lo, float hi) { unsigned r; asm("v_cvt_pk_bf16_f32 %0, %1, %2" : "=v"(r) : "v"(lo), "v"(hi)); return r; }
__device__ __forceinline__ float shx(float v, int lane, int o) { return __int_as_float(__builtin_amdgcn_ds_bpermute((lane ^ o) << 2, __float_as_int(v))); }
__device__ __forceinline__ float wave_sum(float v, int lane) {
#pragma unroll
    for (int o = 32; o >= 1; o >>= 1) v += shx(v, lane, o);
    return v; }
__device__ __forceinline__ float rlane(float v, int k) { return __int_as_float(__builtin_amdgcn_readlane(__float_as_int(v), k)); }
__device__ __forceinline__ float sigmoidf_(float x) { return 1.0f / (1.0f + __expf(-x)); }
__device__ __forceinline__ float siluf_(float x) { return x / (1.0f + __expf(-x)); }
__device__ __forceinline__ float softplusf_(float y) { return fmaxf(y, 0.f) + __logf(1.0f + __expf(-fabsf(y))); }
__device__ __forceinline__ float tanhf_(float x) { float e = __expf(2.0f * x); return 1.0f - 2.0f / (e + 1.0f); }

__device__ __forceinline__ int otid() { int t = threadIdx.x; asm volatile("" : "+v"(t)); return t; }
__device__ __forceinline__ int obid() { int t = blockIdx.x; asm volatile("" : "+s"(t)); return t; }

namespace pg8 {
constexpr int BM = 256, BK = 64, HALF = 128, HTB = HALF * BK * 2, STAGE_BYTES = 8 * HTB, NXCD = 8, WGM = 8;
__device__ __forceinline__ int lds_byte(int r, int c) { const int st = (r >> 4) * 2 + (c >> 5), rr = r & 15, cc = c & 31, ob = rr * 64 + cc * 2; return st * 1024 + (ob ^ (((ob >> 9) & 1) << 5)); }
__device__ __forceinline__ void stage_rc(int b, int& R, int& C) { const int st = b / 1024, sb = b % 1024, swz = sb ^ (((sb >> 9) & 1) << 5); R = (st >> 1) * 16 + swz / 64; C = (st & 1) * 32 + (swz % 64) / 2; }
__device__ __forceinline__ int perm32(int rho) { const int n = rho >> 4, i = rho & 15; return 8 * (i >> 2) + 4 * n + (i & 3); }

struct Unit { int pm, pn, aux; const char* pa; const char* pb; };
struct Gemm { int lda, ldb, K; };

struct Order {
    int nM, nN, nwg, G, c, rep;
    const char* A; const char* B;
    long tA, tB, aPn, aRep, bRep;
    __device__ void init(int nM_, int nN_, int rep_, const void* A_, const void* B_, long tA_, long tB_, long aPn_, long aRep_, long bRep_) {
        nM = nM_; nN = nN_; nwg = nM * nN; G = gridDim.x; c = obid(); rep = rep_; A = (const char*)A_; B = (const char*)B_; tA = tA_; tB = tB_; aPn = aPn_; aRep = aRep_; bRep = bRep_; }
    __device__ bool next(int i, Unit& u) const {
        const int ti = i / rep, r = i - ti * rep;
        const long L = (long)ti * G + c; if (L >= nwg) return false;
        int wgid = (int)L; { const int q = nwg / NXCD, rr = nwg % NXCD, xcd = wgid % NXCD, off = wgid / NXCD; wgid = (xcd < rr ? xcd * (q + 1) : rr * (q + 1) + (xcd - rr) * q) + off; }
        const int nig = WGM * nN, gid = wgid / nig, fm = gid * WGM, gsz = (nM - fm) < WGM ? (nM - fm) : WGM;
        u.pm = fm + ((wgid % nig) % gsz); u.pn = (wgid % nig) / gsz; u.aux = r;
        u.pa = A + (long)u.pm * tA + (long)u.pn * aPn + (long)r * aRep;
        u.pb = B + (long)u.pn * tB + (long)r * bRep;
        return true; }
};

template <class Epi>
__device__ __forceinline__ void gemm_phase(LAS unsigned char* lds, const Gemm g, const Order& S, const Epi& E) {
    const int tid = otid(), wid = __builtin_amdgcn_readfirstlane(tid >> 6), lane = tid & 63, wr = wid >> 2, wc = wid & 3, fr = lane & 15, fq = lane >> 4;
    const int K = g.K, nt = K / BK;
    unsigned voffA[2], voffB[2];
#pragma unroll
    for (int i = 0; i < 2; ++i) { int R, C; stage_rc(tid * 16 + i * 8192, R, C); const int Rb = Epi::PERM ? ((R & ~31) + perm32(R & 31)) : R;
        voffA[i] = (unsigned)(R * g.lda + C) * 2u; voffB[i] = (unsigned)(Rb * g.ldb + C) * 2u; }
    const size_t kstep = (size_t)(BK * 2);
    const size_t hstepA = (size_t)HALF * g.lda * 2, hstepB = (size_t)HALF * g.ldb * 2;
    const unsigned ldsw = (unsigned)wid * 1024u;
    const int aoff = lds_byte(wr * 64 + fr, fq * 8), boff = lds_byte(wc * 32 + fr, fq * 8);
#define PG8_SA(b, h) (((b) * 2 + (h)) * HTB)
#define PG8_SB(b, h) ((4 + (b) * 2 + (h)) * HTB)
#define PG8_STAGE(bufoff, gbase, voff) do { _Pragma("unroll") for (int _i = 0; _i < 2; ++_i) \
        __builtin_amdgcn_global_load_lds((const unsigned*)((const char*)(gbase) + (voff)[_i]), (LAS unsigned*)(lds + (bufoff) + ldsw + _i * 8192), 16, 0, 0); } while (0)
#define PG8_LDA(dst, b, h) do { _Pragma("unroll") for (int m = 0; m < 4; ++m) _Pragma("unroll") for (int k = 0; k < 2; ++k) dst[m][k] = *(const LAS bf16x8*)(lds + PG8_SA(b, h) + aoff + m * 2048 + k * 1024); } while (0)
#define PG8_LDB(dst, b, h) do { _Pragma("unroll") for (int n = 0; n < 2; ++n) _Pragma("unroll") for (int k = 0; k < 2; ++k) dst[n][k] = *(const LAS bf16x8*)(lds + PG8_SB(b, h) + boff + n * 2048 + k * 1024); } while (0)
#define PG8_MMA(ai, bj, At, Bt) do { __builtin_amdgcn_s_setprio(1); _Pragma("unroll") for (int m = 0; m < 4; ++m) _Pragma("unroll") for (int n = 0; n < 2; ++n) _Pragma("unroll") for (int k = 0; k < 2; ++k) \
        acc[ai][bj][m][n] = __builtin_amdgcn_mfma_f32_16x16x32_bf16(Bt[n][k], At[m][k], acc[ai][bj][m][n], 0, 0, 0); __builtin_amdgcn_s_setprio(0); } while (0)
#define PG8_WAIT_V(n) asm volatile("s_waitcnt vmcnt(" #n ")" ::: "memory")
#define PG8_WAIT_L(n) asm volatile("s_waitcnt lgkmcnt(" #n ")" ::: "memory")
#define PG8_BAR __builtin_amdgcn_s_barrier()
#define PG8_SCHED __builtin_amdgcn_sched_barrier(0)
    Unit cur, nxt; int ui = 0;
    if (!S.next(0, cur)) return;
    f32x4 acc[2][2][4][2];
#pragma unroll
    for (int a = 0; a < 2; ++a)
#pragma unroll
        for (int b = 0; b < 2; ++b)
#pragma unroll
            for (int m = 0; m < 4; ++m)
#pragma unroll
                for (int n = 0; n < 2; ++n) acc[a][b][m][n] = (f32x4){0.f, 0.f, 0.f, 0.f};
    bf16x8 At[4][2], B0[2][2], B1[2][2];
    const char* cA = cur.pa; const char* cB = cur.pb;
    PG8_STAGE(PG8_SB(0, 0), cB, voffB); PG8_STAGE(PG8_SA(0, 0), cA, voffA); PG8_STAGE(PG8_SB(0, 1), cB + hstepB, voffB); PG8_STAGE(PG8_SA(0, 1), cA + hstepA, voffA);
    if (wr == 1) PG8_BAR;
    PG8_WAIT_V(4); PG8_BAR;
    PG8_STAGE(PG8_SB(1, 0), cB + kstep, voffB); PG8_STAGE(PG8_SA(1, 0), cA + kstep, voffA); PG8_STAGE(PG8_SB(1, 1), cB + hstepB + kstep, voffB);
    PG8_WAIT_V(6); PG8_BAR;
    for (;;) {
        const bool has_next = S.next(ui + 1, nxt);
        const char* nA = has_next ? nxt.pa : cA; const char* nB = has_next ? nxt.pb : cB;
        for (int t = 0; t < nt; t += 2) {
            const bool last = (t == nt - 2);
            const char* a1 = cA + (size_t)(t + 1) * kstep;
            const char* a2 = last ? nA : cA + (size_t)(t + 2) * kstep; const char* b2 = last ? nB : cB + (size_t)(t + 2) * kstep;
            const char* a3 = a2 + kstep; const char* b3 = b2 + kstep;
            PG8_LDB(B0, 0, 0); PG8_SCHED; PG8_LDA(At, 0, 0); PG8_STAGE(PG8_SA(1, 1), a1 + hstepA, voffA);
            PG8_WAIT_L(8); PG8_BAR; PG8_WAIT_L(0); PG8_MMA(0, 0, At, B0); PG8_BAR; PG8_SCHED;
            PG8_LDB(B1, 0, 1); PG8_STAGE(PG8_SB(0, 0), b2, voffB);
            PG8_BAR; PG8_WAIT_L(0); PG8_MMA(0, 1, At, B1); PG8_BAR;
            PG8_LDA(At, 0, 1); PG8_STAGE(PG8_SA(0, 0), a2, voffA);
            PG8_BAR; PG8_WAIT_L(0); PG8_MMA(1, 0, At, B0); PG8_BAR; PG8_SCHED;
            PG8_STAGE(PG8_SB(0, 1), b2 + hstepB, voffB);
            PG8_WAIT_V(6); PG8_BAR; PG8_MMA(1, 1, At, B1); PG8_BAR;
            PG8_LDB(B0, 1, 0); PG8_SCHED; PG8_LDA(At, 1, 0); PG8_STAGE(PG8_SA(0, 1), a2 + hstepA, voffA);
            PG8_WAIT_L(8); PG8_BAR; PG8_WAIT_L(0); PG8_MMA(0, 0, At, B0); PG8_BAR; PG8_SCHED;
            PG8_LDB(B1, 1, 1); PG8_STAGE(PG8_SB(1, 0), b3, voffB);
            PG8_BAR; PG8_WAIT_L(0); PG8_MMA(0, 1, At, B1); PG8_BAR;
            PG8_LDA(At, 1, 1); PG8_STAGE(PG8_SA(1, 0), a3, voffA);
            PG8_BAR; PG8_WAIT_L(0); PG8_MMA(1, 0, At, B0); PG8_BAR; PG8_SCHED;
            PG8_STAGE(PG8_SB(1, 1), b3 + hstepB, voffB);
            PG8_WAIT_V(6); PG8_BAR; PG8_MMA(1, 1, At, B1); PG8_BAR;
        }
        E(acc, cur, wr, wc, fr, fq);
        if (!has_next) break;
#pragma unroll
        for (int a = 0; a < 2; ++a)
#pragma unroll
            for (int b = 0; b < 2; ++b)
#pragma unroll
                for (int m = 0; m < 4; ++m)
#pragma unroll
                    for (int n = 0; n < 2; ++n) acc[a][b][m][n] = (f32x4){0.f, 0.f, 0.f, 0.f};
        cur = nxt; cA = nA; cB = nB; ++ui;
    }
    PG8_WAIT_V(0);
    if (wr == 0) PG8_BAR;
    PG8_BAR;
#undef PG8_SA
#undef PG8_SB
#undef PG8_STAGE
#undef PG8_LDA
#undef PG8_LDB
#undef PG8_MMA
#undef PG8_WAIT_V
#undef PG8_WAIT_L
#undef PG8_BAR
#undef PG8_SCHED
}

typedef f32x4 Acc[2][2][4][2];

struct EpiInproj {
    static constexpr bool PERM = true;
    unsigned char* ws;
    __device__ __forceinline__ void operator()(Acc& acc, const Unit& u, int wr, int wc, int fr, int fq) const {
        int pn = u.pn, ld, colt; size_t off;
        if (pn < 7) { off = OFF_ZRW; ld = 1792; colt = pn * 256; }
        else if (pn < 12) { off = OFF_ZGLA; ld = 1280; colt = (pn - 7) * 256; }
        else if (pn < 16) { off = OFF_ZRET; ld = 1024; colt = (pn - 12) * 256; }
        else if (pn < 18) { off = OFF_ZLRU; ld = 512; colt = (pn - 16) * 256; }
        else { off = OFF_ZG; ld = 2048; colt = (pn - 18) * 256; }
        bf16_t* base = (bf16_t*)(ws + off);
        const int row0 = u.pm * BM + wr * 64 + fr, col0 = colt + wc * 32 + 8 * fq;
#pragma unroll
        for (int ai = 0; ai < 2; ++ai)
#pragma unroll
            for (int m = 0; m < 4; ++m) { bf16_t* rowp = base + (size_t)(row0 + ai * HALF + m * 16) * ld + col0;
#pragma unroll
                for (int bj = 0; bj < 2; ++bj) { const f32x4 v0 = acc[ai][bj][m][0], v1 = acc[ai][bj][m][1];
                    u32x4 w; w.x = cvt_pk_bf16(v0[0], v0[1]); w.y = cvt_pk_bf16(v0[2], v0[3]); w.z = cvt_pk_bf16(v1[0], v1[1]); w.w = cvt_pk_bf16(v1[2], v1[3]);
                    *(u32x4*)(rowp + bj * HALF) = w; } }
    }
};
template <int ACT> struct EpiBf16 {
    static constexpr bool PERM = true;
    bf16_t* O; int ldc; float scale;
    __device__ __forceinline__ void operator()(Acc& acc, const Unit& u, int wr, int wc, int fr, int fq) const {
        const int row0 = u.pm * BM + wr * 64 + fr, col0 = u.pn * BM + wc * 32 + 8 * fq;
#pragma unroll
        for (int ai = 0; ai < 2; ++ai)
#pragma unroll
            for (int m = 0; m < 4; ++m) { bf16_t* rowp = O + (size_t)(row0 + ai * HALF + m * 16) * ldc + col0;
#pragma unroll
                for (int bj = 0; bj < 2; ++bj) { f32x4 v0 = acc[ai][bj][m][0], v1 = acc[ai][bj][m][1];
                    if (ACT == 1) {
#pragma unroll
                        for (int j = 0; j < 4; ++j) { v0[j] = sigmoidf_(v0[j]); v1[j] = sigmoidf_(v1[j]); } }
                    else { v0 = v0 * scale; v1 = v1 * scale; }
                    u32x4 w; w.x = cvt_pk_bf16(v0[0], v0[1]); w.y = cvt_pk_bf16(v0[2], v0[3]); w.z = cvt_pk_bf16(v1[0], v1[1]); w.w = cvt_pk_bf16(v1[2], v1[3]);
                    *(u32x4*)(rowp + bj * HALF) = w; } }
    }
};
struct EpiKV {
    static constexpr bool PERM = true;
    bf16_t* KM; bf16_t* VT;
    __device__ __forceinline__ void operator()(Acc& acc, const Unit& u, int wr, int wc, int fr, int fq) const {
        const int row0 = u.pm * BM + wr * 64 + fr, col0 = u.pn * BM + wc * 32 + 8 * fq;
#pragma unroll
        for (int ai = 0; ai < 2; ++ai)
#pragma unroll
            for (int m = 0; m < 4; ++m) { const int row = row0 + ai * HALF + m * 16;
#pragma unroll
                for (int bj = 0; bj < 2; ++bj)
#pragma unroll
                    for (int n = 0; n < 2; ++n)
#pragma unroll
                        for (int j = 0; j < 4; ++j) { const int col = col0 + bj * HALF + 4 * n + j; const bf16_t v = f2bf(acc[ai][bj][m][n][j]);
                            if (col < 1024) KM[(size_t)row * 1024 + col] = v;
                            else VT[((size_t)(row >> 8) * 1024 + (col - 1024)) * 256 + (row & 255)] = v; } }
    }
};
struct EpiMerge {
    static constexpr bool PERM = true;
    const bf16_t* G; bf16_t* MRG;
    __device__ __forceinline__ void operator()(Acc& acc, const Unit& u, int wr, int wc, int fr, int fq) const {
        const int row0 = u.pm * BM + wr * 64 + fr, col0 = u.pn * BM + wc * 32 + 8 * fq;
#pragma unroll
        for (int ai = 0; ai < 2; ++ai)
#pragma unroll
            for (int m = 0; m < 4; ++m) { const size_t row = (size_t)(row0 + ai * HALF + m * 16);
#pragma unroll
                for (int bj = 0; bj < 2; ++bj) { const f32x4 v0 = acc[ai][bj][m][0], v1 = acc[ai][bj][m][1];
                    const u32x4 gq = *(const u32x4*)(G + row * 4096 + u.aux * 1024 + col0 + bj * HALF);
                    bf16_t* mp = MRG + row * 1024 + col0 + bj * HALF;
                    float o[8] = {0.f, 0.f, 0.f, 0.f, 0.f, 0.f, 0.f, 0.f};
                    if (u.aux > 0) { const u32x4 mq = *(const u32x4*)mp;
#pragma unroll
                        for (int e = 0; e < 4; ++e) { o[2 * e] = __uint_as_float(mq[e] << 16); o[2 * e + 1] = __uint_as_float(mq[e] & 0xffff0000u); } }
#pragma unroll
                    for (int e = 0; e < 4; ++e) { const float g0 = __uint_as_float(gq[e] << 16), g1 = __uint_as_float(gq[e] & 0xffff0000u);
                        const float a0 = e < 2 ? v0[2 * e] : v1[2 * e - 4], a1 = e < 2 ? v0[2 * e + 1] : v1[2 * e - 3];
                        o[2 * e] += g0 * a0; o[2 * e + 1] += g1 * a1; }
                    u32x4 w; w.x = cvt_pk_bf16(o[0], o[1]); w.y = cvt_pk_bf16(o[2], o[3]); w.z = cvt_pk_bf16(o[4], o[5]); w.w = cvt_pk_bf16(o[6], o[7]);
                    *(u32x4*)mp = w; } }
    }
};
struct EpiResid {
    static constexpr bool PERM = false;
    const float* hin; float* hout;
    __device__ __forceinline__ void operator()(Acc& acc, const Unit& u, int wr, int wc, int fr, int fq) const {
        const int row0 = u.pm * BM + wr * 64 + fr, col0 = u.pn * BM + wc * 32 + 4 * fq;
#pragma unroll
        for (int ai = 0; ai < 2; ++ai)
#pragma unroll
            for (int m = 0; m < 4; ++m) { const size_t ro = (size_t)(row0 + ai * HALF + m * 16) * 1024 + col0;
#pragma unroll
                for (int bj = 0; bj < 2; ++bj)
#pragma unroll
                    for (int n = 0; n < 2; ++n) { const f32x4 r = *(const f32x4*)(hin + ro + bj * HALF + n * 16);
                        *(f32x4*)(hout + ro + bj * HALF + n * 16) = r + acc[ai][bj][m][n]; } }
    }
};
struct EpiSoftmax {
    static constexpr bool PERM = true;
    bf16_t* P; LAS float* xs;
    __device__ __forceinline__ void operator()(Acc& acc, const Unit& u, int wr_, int wc_, int fr_, int fq_) const {
        const int tid2 = otid(), wid2 = tid2 >> 6, wr = wid2 >> 2, wc = wid2 & 3, fr = tid2 & 15, fq = (tid2 >> 4) & 3;
#pragma unroll
        for (int ai = 0; ai < 2; ++ai)
#pragma unroll
            for (int m = 0; m < 4; ++m) { float v = -3.0e38f;
#pragma unroll
                for (int bj = 0; bj < 2; ++bj)
#pragma unroll
                    for (int n = 0; n < 2; ++n)
#pragma unroll
                        for (int j = 0; j < 4; ++j) v = fmaxf(v, acc[ai][bj][m][n][j]);
                xs[(ai * HALF + wr * 64 + m * 16 + fr) * 16 + wc * 4 + fq] = v; }
        asm volatile("s_waitcnt lgkmcnt(0)\n\ts_barrier" ::: "memory");
        float sums[2][4];
#pragma unroll
        for (int ai = 0; ai < 2; ++ai)
#pragma unroll
            for (int m = 0; m < 4; ++m) { const int rl = ai * HALF + wr * 64 + m * 16 + fr;
                f32x4 q = *(const LAS f32x4*)(xs + rl * 16);
#pragma unroll
                for (int e = 1; e < 4; ++e) { const f32x4 q2 = *(const LAS f32x4*)(xs + rl * 16 + 4 * e); q[0] = fmaxf(q[0], q2[0]); q[1] = fmaxf(q[1], q2[1]); q[2] = fmaxf(q[2], q2[2]); q[3] = fmaxf(q[3], q2[3]); }
                const float M = fmaxf(fmaxf(q[0], q[1]), fmaxf(q[2], q[3]));
                float sv = 0.f;
#pragma unroll
                for (int bj = 0; bj < 2; ++bj)
#pragma unroll
                    for (int n = 0; n < 2; ++n)
#pragma unroll
                        for (int j = 0; j < 4; ++j) { const float e = __expf(acc[ai][bj][m][n][j] - M); acc[ai][bj][m][n][j] = e; sv += e; }
                sums[ai][m] = sv; }
        asm volatile("s_waitcnt lgkmcnt(0)\n\ts_barrier" ::: "memory");
#pragma unroll
        for (int ai = 0; ai < 2; ++ai)
#pragma unroll
            for (int m = 0; m < 4; ++m) xs[(ai * HALF + wr * 64 + m * 16 + fr) * 16 + wc * 4 + fq] = sums[ai][m];
        asm volatile("s_waitcnt lgkmcnt(0)\n\ts_barrier" ::: "memory");
        const int row0 = u.pm * BM + wr * 64 + fr, col0 = u.pn * BM + wc * 32 + 8 * fq;
#pragma unroll
        for (int ai = 0; ai < 2; ++ai)
#pragma unroll
            for (int m = 0; m < 4; ++m) { const int rl = ai * HALF + wr * 64 + m * 16 + fr;
                f32x4 q = *(const LAS f32x4*)(xs + rl * 16);
#pragma unroll
                for (int e = 1; e < 4; ++e) q += *(const LAS f32x4*)(xs + rl * 16 + 4 * e);
                const float inv = 1.0f / (q[0] + q[1] + q[2] + q[3]);
                bf16_t* rowp = P + (size_t)(row0 + ai * HALF + m * 16) * 1024 + col0;
#pragma unroll
                for (int bj = 0; bj < 2; ++bj) { const f32x4 v0 = acc[ai][bj][m][0] * inv, v1 = acc[ai][bj][m][1] * inv;
                    u32x4 w; w.x = cvt_pk_bf16(v0[0], v0[1]); w.y = cvt_pk_bf16(v0[2], v0[3]); w.z = cvt_pk_bf16(v1[0], v1[1]); w.w = cvt_pk_bf16(v1[2], v1[3]);
                    *(u32x4*)(rowp + bj * HALF) = w; } }
    }
};
}

__device__ __forceinline__ int win_map(int n) {
    if (n < 1792) return n < 1664 ? n : -1;
    n -= 1792; if (n < 1280) return n < 1040 ? 2176 + n : -1;
    n -= 1280; if (n < 1024) return 3728 + n;
    n -= 1024; if (n < 512) return 5264 + n;
    n -= 512;
    if (n < 512) return 1664 + n;
    if (n < 1024) return 3216 + (n - 512);
    if (n < 1536) return 4752 + (n - 1024);
    if (n < 2048) return 5776 + (n - 1536);
    n -= 2048; return 6288 + n;
}
template <bool WIN>
__device__ __forceinline__ void conv_t(bf16_t* dst, const float* src, int ND, int K, int NS) {
    const size_t total = (size_t)ND * (K / 8);
    for (size_t i = (size_t)obid() * 512 + otid(); i < total; i += (size_t)gridDim.x * 512) {
        const int n = (int)(i % ND), ko = (int)(i / ND);
        const int ms = WIN ? win_map(n) : n;
        float v[8];
#pragma unroll
        for (int j = 0; j < 8; ++j) v[j] = ms >= 0 ? src[(size_t)(ko * 8 + j) * NS + ms] : 0.f;
        u32x4 w; w.x = cvt_pk_bf16(v[0], v[1]); w.y = cvt_pk_bf16(v[2], v[3]); w.z = cvt_pk_bf16(v[4], v[5]); w.w = cvt_pk_bf16(v[6], v[7]);
        *(u32x4*)(dst + (size_t)n * K + ko * 8) = w;
    }
}
__device__ __forceinline__ void rmsnorm_bf16(const float* src, const float* g, bf16_t* dst, int rows) {
    const int lane = otid() & 63, gw = obid() * 8 + (otid() >> 6), nw = gridDim.x * 8;
    for (int r = gw; r < rows; r += nw) {
        const float* p = src + (size_t)r * 1024; f32x4 v[4]; float ss = 0.f;
#pragma unroll
        for (int i = 0; i < 4; ++i) { v[i] = *(const f32x4*)(p + i * 256 + lane * 4); ss += v[i][0] * v[i][0] + v[i][1] * v[i][1] + v[i][2] * v[i][2] + v[i][3] * v[i][3]; }
        ss = wave_sum(ss, lane); const float rs = rsqrtf(ss * (1.0f / 1024.0f) + 1e-6f);
#pragma unroll
        for (int i = 0; i < 4; ++i) { const f32x4 gg = *(const f32x4*)(g + i * 256 + lane * 4);
            u32x2 w; w.x = cvt_pk_bf16(v[i][0] * rs * gg[0], v[i][1] * rs * gg[1]); w.y = cvt_pk_bf16(v[i][2] * rs * gg[2], v[i][3] * rs * gg[3]);
            *(u32x2*)(dst + (size_t)r * 1024 + i * 256 + lane * 4) = w; }
    }
}
__device__ __forceinline__ void rmsnorm_f32_inplace(float* buf, const float* g, int rows) {
    const int lane = otid() & 63, gw = obid() * 8 + (otid() >> 6), nw = gridDim.x * 8;
    for (int r = gw; r < rows; r += nw) {
        float* p = buf + (size_t)r * 1024; f32x4 v[4]; float ss = 0.f;
#pragma unroll
        for (int i = 0; i < 4; ++i) { v[i] = *(const f32x4*)(p + i * 256 + lane * 4); ss += v[i][0] * v[i][0] + v[i][1] * v[i][1] + v[i][2] * v[i][2] + v[i][3] * v[i][3]; }
        ss = wave_sum(ss, lane); const float rs = rsqrtf(ss * (1.0f / 1024.0f) + 1e-6f);
#pragma unroll
        for (int i = 0; i < 4; ++i) { const f32x4 gg = *(const f32x4*)(g + i * 256 + lane * 4); *(f32x4*)(p + i * 256 + lane * 4) = v[i] * rs * gg; }
    }
}

__device__ __forceinline__ void rwkv_prep(KP P, int l) {
    unsigned char* ws = P->ws;
    const int c = otid(), lane = c & 63, h = c >> 6;
    const float* w2 = (const float*)P->in[7] + (size_t)l * 64 * 512; const float* a2 = (const float*)P->in[9] + (size_t)l * 64 * 512;
    const float* mu = (const float*)P->in[5] + (size_t)l * 1664;
    float w2c[64], a2c[64];
#pragma unroll
    for (int j = 0; j < 64; ++j) { w2c[j] = w2[j * 512 + c]; a2c[j] = a2[j * 512 + c]; }
    const float mu_r = mu[c], mu_k = mu[512 + c], mu_v = mu[1024 + c], mu_w = mu[1536 + lane], mu_a = mu[1600 + lane];
    const float w0c = ((const float*)P->in[6])[l * 512 + c], a0c = ((const float*)P->in[8])[l * 512 + c];
    const float kkc = ((const float*)P->in[10])[l * 512 + c], kac = ((const float*)P->in[11])[l * 512 + c], rkc = ((const float*)P->in[12])[l * 512 + c];
    const bf16_t* Z = (const bf16_t*)(ws + OFF_ZRW);
    float* PW = (float*)(ws + OFF_PW); float* PKK = (float*)(ws + OFF_PKK); float* PB = (float*)(ws + OFF_PB); float* PKM = (float*)(ws + OFF_PKM); float* PR = (float*)(ws + OFF_PR);
    bf16_t* PV = (bf16_t*)(ws + OFF_PV); float* BON = (float*)(ws + OFF_BON);
    for (int rng = obid(); rng < TB / 64; rng += gridDim.x) {
        const int t0 = rng * 64;
        float pr = 0.f, pk = 0.f, pv = 0.f, pwl = 0.f, pal = 0.f;
        if (t0 > 0) { const bf16_t* z = Z + (size_t)(t0 - 1) * 1792; pr = bf2f(z[c]); pk = bf2f(z[512 + c]); pv = bf2f(z[1024 + c]); pwl = bf2f(z[1536 + lane]); pal = bf2f(z[1600 + lane]); }
        bf16_t nr, nk, nv, nwl, nal;
        { const bf16_t* z = Z + (size_t)t0 * 1792; nr = z[c]; nk = z[512 + c]; nv = z[1024 + c]; nwl = z[1536 + lane]; nal = z[1600 + lane]; }
        for (int t = t0; t < t0 + 64; ++t) {
            const float cr = bf2f(nr), ck = bf2f(nk), cv = bf2f(nv), cwl = bf2f(nwl), cal = bf2f(nal);
            { const bf16_t* z = Z + (size_t)(t + 1 < t0 + 64 ? t + 1 : t) * 1792; nr = z[c]; nk = z[512 + c]; nv = z[1024 + c]; nwl = z[1536 + lane]; nal = z[1600 + lane]; }
            const float rs = cr + (pr - cr) * mu_r, ks = ck + (pk - ck) * mu_k, vs = cv + (pv - cv) * mu_v;
            const float wl = tanhf_(cwl + (pwl - cwl) * mu_w), al = cal + (pal - cal) * mu_a;
            float accw = w0c, acca = a0c;
#pragma unroll
            for (int j = 0; j < 64; ++j) { accw += rlane(wl, j) * w2c[j]; acca += rlane(al, j) * a2c[j]; }
            const float logw = -softplusf_(-accw) - 0.5f;
            const float wdec = __expf(-__expf(logw));
            const float a = sigmoidf_(acca);
            const float kraw = ks * kkc;
            const float ss = wave_sum(kraw * kraw, lane);
            const float kk = kraw / fmaxf(sqrtf(ss), 1e-12f);
            const float km = ks * (1.0f + (a - 1.0f) * kac);
            const float bb = kk * a;
            const float bon = wave_sum(rs * km * rkc, lane);
            const size_t o = (size_t)t * 512 + c;
            PW[o] = wdec; PKK[o] = kk; PB[o] = bb; PKM[o] = km; PR[o] = rs; PV[o] = f2bf(vs);
            if (lane == 0) BON[(size_t)t * 8 + h] = bon;
            pr = cr; pk = ck; pv = cv; pwl = cwl; pal = cal;
        }
    }
}
__device__ __forceinline__ void rwkv_pass1(KP P) {
    unsigned char* ws = P->ws;
    const int wave = otid() >> 6, lane = otid() & 63;
    if (wave >= 4) return;
    const float* PW = (const float*)(ws + OFF_PW); const float* PKK = (const float*)(ws + OFF_PKK); const float* PB = (const float*)(ws + OFF_PB); const float* PKM = (const float*)(ws + OFF_PKM);
    const bf16_t* PV = (const bf16_t*)(ws + OFF_PV);
    bf16_t* PP = (bf16_t*)(ws + OFF_PP); float* PL = (float*)(ws + OFF_PL);
    for (int u = obid() * 4 + wave; u < 8 * NCH; u += gridDim.x * 4) {
        const int c = u >> 3, h = u & 7, col = h * 64 + lane;
        float sp[64], sl[64];
#pragma unroll
        for (int k = 0; k < 64; ++k) { sp[k] = (k == lane) ? 1.f : 0.f; sl[k] = 0.f; }
        size_t o = (size_t)c * LCH * 512 + col;
        float wv = PW[o], kkv = PKK[o], bv = PB[o], kmv = PKM[o], vv = bf2f(PV[o]);
        for (int i = 0; i < LCH; ++i) {
            const size_t on = (i + 1 < LCH) ? o + 512 : o;
            const float nwv = PW[on], nkkv = PKK[on], nbv = PB[on], nkmv = PKM[on], nvv = bf2f(PV[on]);
            float sap = 0.f, sal = 0.f;
#pragma unroll
            for (int k = 0; k < 64; ++k) { const float q = rlane(kkv, k); sap += sp[k] * q; sal += sl[k] * q; }
            sap = -sap; sal = -sal;
#pragma unroll
            for (int k = 0; k < 64; ++k) { const float wk = rlane(wv, k), bk = rlane(bv, k), kmk = rlane(kmv, k);
                sp[k] = sp[k] * wk + sap * bk;
                sl[k] = sl[k] * wk + (sal * bk + vv * kmk); }
            o = on; wv = nwv; kkv = nkkv; bv = nbv; kmv = nkmv; vv = nvv;
        }
        bf16_t* pp = PP + (size_t)(h * NCH + c) * 4096 + lane; float* pl = PL + ((size_t)(h * NCH + c) * 64 + lane) * 64;
#pragma unroll
        for (int k = 0; k < 64; ++k) pp[k * 64] = f2bf(sp[k]);
#pragma unroll
        for (int k = 0; k < 64; k += 4) *(f32x4*)(pl + k) = (f32x4){sl[k], sl[k + 1], sl[k + 2], sl[k + 3]};
    }
}
__device__ __forceinline__ void rwkv_cscan(KP P, unsigned char* sm) {
    unsigned char* ws = P->ws;
    bf16_t* Sb = (bf16_t*)sm;
    const int tid = otid(), wave = tid >> 6, lane = tid & 63, nt = wave & 3, mt0 = (wave >> 2) * 2, lr = lane & 15, lq = lane >> 4;
    const bf16_t* PPT = (const bf16_t*)(ws + OFF_PP); float* PL = (float*)(ws + OFF_PL);
    for (int h = obid(); h < 8; h += gridDim.x) {
        for (int i = tid; i < 64 * 72 / 2; i += 512) ((unsigned*)Sb)[i] = 0u;
        f32x4 mine[2] = {(f32x4){0.f, 0.f, 0.f, 0.f}, (f32x4){0.f, 0.f, 0.f, 0.f}};
        bf16x8 bfr[2]; f32x4 lv[2];
        { const size_t base = (size_t)(h * NCH) * 4096;
#pragma unroll
          for (int ks = 0; ks < 2; ++ks) bfr[ks] = *(const bf16x8*)(PPT + base + (nt * 16 + lr) * 64 + ks * 32 + lq * 8);
#pragma unroll
          for (int i = 0; i < 2; ++i)
#pragma unroll
              for (int q = 0; q < 4; ++q) lv[i][q] = PL[base + ((mt0 + i) * 16 + lq * 4 + q) * 64 + nt * 16 + lr]; }
        __syncthreads();
        for (int c = 0; c < NCH; ++c) {
            const size_t base = (size_t)(h * NCH + c) * 4096, basen = (size_t)(h * NCH + (c + 1 < NCH ? c + 1 : c)) * 4096;
            bf16x8 nbfr[2]; f32x4 nlv[2];
#pragma unroll
            for (int ks = 0; ks < 2; ++ks) nbfr[ks] = *(const bf16x8*)(PPT + basen + (nt * 16 + lr) * 64 + ks * 32 + lq * 8);
#pragma unroll
            for (int i = 0; i < 2; ++i)
#pragma unroll
                for (int q = 0; q < 4; ++q) nlv[i][q] = PL[basen + ((mt0 + i) * 16 + lq * 4 + q) * 64 + nt * 16 + lr];
            f32x4 acc[2] = {lv[0], lv[1]};
#pragma unroll
            for (int ks = 0; ks < 2; ++ks)
#pragma unroll
                for (int i = 0; i < 2; ++i) { const bf16x8 af = *(const bf16x8*)(Sb + ((mt0 + i) * 16 + lr) * 72 + ks * 32 + lq * 8);
                    acc[i] = __builtin_amdgcn_mfma_f32_16x16x32_bf16(af, bfr[ks], acc[i], 0, 0, 0); }
            if (c + 1 < NCH || true) {
#pragma unroll
                for (int i = 0; i < 2; ++i)
#pragma unroll
                    for (int q = 0; q < 4; ++q) PL[base + ((mt0 + i) * 16 + lq * 4 + q) * 64 + nt * 16 + lr] = mine[i][q]; }
            mine[0] = acc[0]; mine[1] = acc[1];
            __syncthreads();
#pragma unroll
            for (int i = 0; i < 2; ++i)
#pragma unroll
                for (int q = 0; q < 4; ++q) Sb[((mt0 + i) * 16 + lq * 4 + q) * 72 + nt * 16 + lr] = f2bf(acc[i][q]);
            __syncthreads();
            bfr[0] = nbfr[0]; bfr[1] = nbfr[1]; lv[0] = nlv[0]; lv[1] = nlv[1];
        }
    }
}
__device__ __forceinline__ void rwkv_pass2(KP P, int l) {
    unsigned char* ws = P->ws;
    const int wave = otid() >> 6, lane = otid() & 63;
    if (wave >= 4) return;
    const float* PW = (const float*)(ws + OFF_PW); const float* PKK = (const float*)(ws + OFF_PKK); const float* PB = (const float*)(ws + OFF_PB); const float* PKM = (const float*)(ws + OFF_PKM); const float* PR = (const float*)(ws + OFF_PR);
    const bf16_t* PV = (const bf16_t*)(ws + OFF_PV); const float* BON = (const float*)(ws + OFF_BON);
    const float* PL = (const float*)(ws + OFF_PL); bf16_t* ZG = (bf16_t*)(ws + OFF_ZG);
    for (int u = obid() * 4 + wave; u < 8 * NCH; u += gridDim.x * 4) {
        const int c = u >> 3, h = u & 7, col = h * 64 + lane;
        const float lng = ((const float*)P->in[13])[l * 512 + col], lnb = ((const float*)P->in[14])[l * 512 + col];
        float s[64];
        const float* s0 = PL + ((size_t)(h * NCH + c) * 64 + lane) * 64;
#pragma unroll
        for (int k = 0; k < 64; k += 4) { const f32x4 q = *(const f32x4*)(s0 + k); s[k] = q[0]; s[k + 1] = q[1]; s[k + 2] = q[2]; s[k + 3] = q[3]; }
        int t = c * LCH;
        size_t o = (size_t)t * 512 + col;
        float wv = PW[o], kkv = PKK[o], bv = PB[o], kmv = PKM[o], rv = PR[o], vv = bf2f(PV[o]);
        for (int i = 0; i < LCH; ++i, ++t) {
            const size_t on = (i + 1 < LCH) ? o + 512 : o;
            const float nwv = PW[on], nkkv = PKK[on], nbv = PB[on], nkmv = PKM[on], nrv = PR[on], nvv = bf2f(PV[on]);
            const float gg = bf2f(ZG[(size_t)t * 2048 + col]); const float bon = BON[(size_t)t * 8 + h];
            float sa = 0.f;
#pragma unroll
            for (int k = 0; k < 64; ++k) sa += s[k] * rlane(kkv, k);
            sa = -sa;
            float y = 0.f;
#pragma unroll
            for (int k = 0; k < 64; ++k) { const float wk = rlane(wv, k), bk = rlane(bv, k), kmk = rlane(kmv, k), rk = rlane(rv, k);
                s[k] = s[k] * wk + (sa * bk + vv * kmk);
                y += s[k] * rk; }
            const float mean = wave_sum(y, lane) * (1.0f / 64.0f); const float d = y - mean;
            const float var = wave_sum(d * d, lane) * (1.0f / 64.0f);
            const float yn = d * rsqrtf(var + 64e-5f) * lng + lnb + bon * vv;
            ZG[(size_t)t * 2048 + col] = f2bf(yn * siluf_(gg));
            o = on; wv = nwv; kkv = nkkv; bv = nbv; kmv = nkmv; rv = nrv; vv = nvv;
        }
    }
}

__device__ __forceinline__ void rope_cs(int i, float posf, float& cs, float& sn) {
    const float inv = (float)exp2(-(double)i * (13.287712379549449 / 32.0));
    const float ang = posf * inv;
    const double a = (double)ang; const double kq = rint(a * 0.15915494309189535); const float r = (float)(a - kq * 6.283185307179586);
    cs = __cosf(r); sn = __sinf(r);
}
__device__ __forceinline__ void gr_stage_b(KP P, int l, int kind, int n, int h, float* Bm) {
    const int tid = otid(), t = tid >> 3, dg = tid & 7;
    if (kind == 0) {
        const bf16_t* zr = (const bf16_t*)(P->ws + OFF_ZGLA) + (size_t)(n * 64 + t) * 1280 + 1024;
        float fl[16];
        const u32x4 q0 = *(const u32x4*)zr, q1 = *(const u32x4*)(zr + 8);
#pragma unroll
        for (int e = 0; e < 4; ++e) { fl[2 * e] = __uint_as_float(q0[e] << 16); fl[2 * e + 1] = __uint_as_float(q0[e] & 0xffff0000u); fl[8 + 2 * e] = __uint_as_float(q1[e] << 16); fl[8 + 2 * e + 1] = __uint_as_float(q1[e] & 0xffff0000u); }
        const float* fup = (const float*)P->in[15] + (size_t)l * 16 * 256; const float* fb = (const float*)P->in[16] + (size_t)l * 256;
#pragma unroll
        for (int dd = 0; dd < 8; ++dd) { const int d = dg * 8 + dd; float x = fb[h * 64 + d];
#pragma unroll
            for (int j = 0; j < 16; ++j) x += fl[j] * fup[j * 256 + h * 64 + d];
            Bm[t * 64 + d] = -softplusf_(-x) * (1.0f / 16.0f); }
    } else {
        const float lg = __logf(1.0f - exp2f(-5.0f - (float)h));
#pragma unroll
        for (int dd = 0; dd < 8; ++dd) Bm[t * 64 + dg * 8 + dd] = lg;
    }
    __syncthreads();
    if (tid < 64) { float run = 0.f; for (int tt = 0; tt < 64; ++tt) { run += Bm[tt * 64 + tid]; Bm[tt * 64 + tid] = run; } }
    __syncthreads();
}
__device__ __forceinline__ float gr_qk(KP P, int b, int kind, int which, int tg, int h, int d) {
    if (kind == 0) { const bf16_t* z = (const bf16_t*)(P->ws + OFF_ZGLA) + (size_t)tg * 1280 + which * 256 + h * 64; return bf2f(z[d]); }
    const bf16_t* z = (const bf16_t*)(P->ws + OFF_ZRET) + (size_t)tg * 1024 + which * 256 + h * 64;
    const int i = d & 31; const float x1 = bf2f(z[i]), x2 = bf2f(z[i + 32]);
    const float posf = (float)((const int*)P->in[2])[(size_t)b * TB + tg];
    float cs, sn; rope_cs(i, posf, cs, sn);
    return d < 32 ? x1 * cs - x2 * sn : x1 * sn + x2 * cs;
}
__device__ __forceinline__ const bf16_t* gr_vptr(KP P, int kind, int tg, int h) {
    return kind == 0 ? (const bf16_t*)(P->ws + OFF_ZGLA) + (size_t)tg * 1280 + 512 + h * 128 : (const bf16_t*)(P->ws + OFF_ZRET) + (size_t)tg * 1024 + 512 + h * 128;
}
__device__ __forceinline__ void gr_ds(KP P, int l, int b, unsigned char* sm) {
    float* Bm = (float*)sm; bf16_t* KET = (bf16_t*)(sm + 16384); bf16_t* VT = (bf16_t*)(sm + 25600);
    const int tid = otid(), t = tid >> 3, dg = tid & 7, wave = tid >> 6, lane = tid & 63;
    float* DS = (float*)(P->ws + OFF_DSG); float* DEC = (float*)(P->ws + OFF_DEC);
    for (int idx = obid(); idx < 2048; idx += gridDim.x) {
        const int kind = idx >> 10, n = (idx >> 2) & 255, h = idx & 3, tg = n * 64 + t;
        gr_stage_b(P, l, kind, n, h, Bm);
#pragma unroll
        for (int dd = 0; dd < 8; ++dd) { const int d = dg * 8 + dd; const float bl = Bm[63 * 64 + d], bt = Bm[t * 64 + d];
            float kv = gr_qk(P, b, kind, 1, tg, h, d); if (kind == 1) kv *= 0.125f;
            KET[d * 72 + t] = f2bf(kv * __expf(bl - bt));
            if (t == 63 && kind == 0) DEC[(size_t)(n * 4 + h) * 64 + d] = __expf(bl); }
        { const bf16_t* vp = gr_vptr(P, kind, tg, h) + dg * 16;
#pragma unroll
            for (int e = 0; e < 16; ++e) VT[(dg * 16 + e) * 72 + t] = vp[e]; }
        __syncthreads();
        f32x4 acc[4];
#pragma unroll
        for (int mt = 0; mt < 4; ++mt) acc[mt] = (f32x4){0.f, 0.f, 0.f, 0.f};
#pragma unroll
        for (int ks = 0; ks < 2; ++ks) { const bf16x8 bf = *(const bf16x8*)(VT + (wave * 16 + (lane & 15)) * 72 + ks * 32 + (lane >> 4) * 8);
#pragma unroll
            for (int mt = 0; mt < 4; ++mt) { const bf16x8 af = *(const bf16x8*)(KET + (mt * 16 + (lane & 15)) * 72 + ks * 32 + (lane >> 4) * 8);
                acc[mt] = __builtin_amdgcn_mfma_f32_16x16x32_bf16(af, bf, acc[mt], 0, 0, 0); } }
        float* dsp = DS + ((size_t)(kind * 256 + n) * 4 + h) * 64 * 128;
#pragma unroll
        for (int mt = 0; mt < 4; ++mt)
#pragma unroll
            for (int j = 0; j < 4; ++j) dsp[(size_t)(mt * 16 + (lane >> 4) * 4 + j) * 128 + wave * 16 + (lane & 15)] = acc[mt][j];
        __syncthreads();
    }
}
__device__ __forceinline__ void gr_scan(KP P) {
    float* DS = (float*)(P->ws + OFF_DSG); const float* DEC = (const float*)(P->ws + OFF_DEC);
    for (int blk = obid(); blk < 129; blk += gridDim.x) {
        if (blk < 128) {
            const int gid = blk * 512 + otid(), kind = gid >> 15, e = gid & 32767, h = e >> 13, d = (e >> 7) & 63, vch = e & 127;
            const float rdec = __expf(64.0f * __logf(1.0f - exp2f(-5.0f - (float)h)));
            float st = 0.f;
            for (int n0 = 0; n0 < 256; n0 += 8) {
                float dsv[8], dc[8];
#pragma unroll
                for (int q = 0; q < 8; ++q) { const int n = n0 + q; dsv[q] = DS[(((size_t)(kind * 256 + n) * 4 + h) * 64 + d) * 128 + vch]; dc[q] = kind == 0 ? DEC[(size_t)(n * 4 + h) * 64 + d] : rdec; }
#pragma unroll
                for (int q = 0; q < 8; ++q) { const int n = n0 + q; DS[(((size_t)(kind * 256 + n) * 4 + h) * 64 + d) * 128 + vch] = st; st = st * dc[q] + dsv[q]; }
            }
        } else {
            const float* AC = (const float*)(P->ws + OFF_AC); const float* HC = (const float*)(P->ws + OFF_HC); float* HIN = (float*)(P->ws + OFF_HIN);
            const int d = otid(); float hin = 0.f;
            for (int n = 0; n < 256; ++n) { HIN[n * 512 + d] = hin; hin = AC[n * 512 + d] * hin + HC[n * 512 + d]; }
        }
    }
}
__device__ __forceinline__ void gr_out(KP P, int l, int b, unsigned char* sm) {
    float* Bm = (float*)sm; bf16_t* QD = (bf16_t*)(sm + 16384); bf16_t* KD = (bf16_t*)(sm + 25600); bf16_t* ATT = (bf16_t*)(sm + 34816);
    bf16_t* VT = (bf16_t*)(sm + 44032); bf16_t* ST = (bf16_t*)(sm + 62464); float* O = (float*)(sm + 80896);
    const int tid = otid(), t = tid >> 3, dg = tid & 7, wave = tid >> 6, lane = tid & 63;
    const float* DS = (const float*)(P->ws + OFF_DSG); bf16_t* ZG = (bf16_t*)(P->ws + OFF_ZG);
    for (int idx = obid(); idx < 2048; idx += gridDim.x) {
        const int kind = idx >> 10, n = (idx >> 2) & 255, h = idx & 3, tg = n * 64 + t;
        gr_stage_b(P, l, kind, n, h, Bm);
#pragma unroll
        for (int dd = 0; dd < 8; ++dd) { const int d = dg * 8 + dd; const float bt = Bm[t * 64 + d];
            float qv = gr_qk(P, b, kind, 0, tg, h, d), kv = gr_qk(P, b, kind, 1, tg, h, d);
            if (kind == 0) qv *= 0.125f; else kv *= 0.125f;
            QD[t * 72 + d] = f2bf(qv * __expf(bt)); KD[t * 72 + d] = f2bf(kv * __expf(-bt)); }
        { const bf16_t* vp = gr_vptr(P, kind, tg, h) + dg * 16;
#pragma unroll
            for (int e = 0; e < 16; ++e) VT[(dg * 16 + e) * 72 + t] = vp[e]; }
        { const float* dsp = DS + ((size_t)(kind * 256 + n) * 4 + h) * 64 * 128;
#pragma unroll
            for (int i = 0; i < 16; ++i) { const int e = tid + i * 512, d = e >> 7, vch = e & 127; ST[vch * 72 + d] = f2bf(dsp[e]); } }
        __syncthreads();
        {
            const int nt = wave & 3, mt0 = (wave >> 2) * 2;
            f32x4 a2[2] = {(f32x4){0.f, 0.f, 0.f, 0.f}, (f32x4){0.f, 0.f, 0.f, 0.f}};
#pragma unroll
            for (int ks = 0; ks < 2; ++ks) { const bf16x8 bf = *(const bf16x8*)(KD + (nt * 16 + (lane & 15)) * 72 + ks * 32 + (lane >> 4) * 8);
#pragma unroll
                for (int i = 0; i < 2; ++i) { const bf16x8 af = *(const bf16x8*)(QD + ((mt0 + i) * 16 + (lane & 15)) * 72 + ks * 32 + (lane >> 4) * 8);
                    a2[i] = __builtin_amdgcn_mfma_f32_16x16x32_bf16(af, bf, a2[i], 0, 0, 0); } }
#pragma unroll
            for (int i = 0; i < 2; ++i)
#pragma unroll
                for (int j = 0; j < 4; ++j) { const int tt = (mt0 + i) * 16 + (lane >> 4) * 4 + j, ss = nt * 16 + (lane & 15);
                    ATT[tt * 72 + ss] = f2bf(ss <= tt ? a2[i][j] : 0.f); }
        }
        __syncthreads();
        {
            f32x4 acc[4];
#pragma unroll
            for (int mt = 0; mt < 4; ++mt) acc[mt] = (f32x4){0.f, 0.f, 0.f, 0.f};
#pragma unroll
            for (int ks = 0; ks < 2; ++ks) {
                const bf16x8 b1 = *(const bf16x8*)(VT + (wave * 16 + (lane & 15)) * 72 + ks * 32 + (lane >> 4) * 8);
                const bf16x8 b2 = *(const bf16x8*)(ST + (wave * 16 + (lane & 15)) * 72 + ks * 32 + (lane >> 4) * 8);
#pragma unroll
                for (int mt = 0; mt < 4; ++mt) {
                    const bf16x8 a1 = *(const bf16x8*)(ATT + (mt * 16 + (lane & 15)) * 72 + ks * 32 + (lane >> 4) * 8);
                    const bf16x8 aq = *(const bf16x8*)(QD + (mt * 16 + (lane & 15)) * 72 + ks * 32 + (lane >> 4) * 8);
                    acc[mt] = __builtin_amdgcn_mfma_f32_16x16x32_bf16(a1, b1, acc[mt], 0, 0, 0);
                    acc[mt] = __builtin_amdgcn_mfma_f32_16x16x32_bf16(aq, b2, acc[mt], 0, 0, 0); } }
#pragma unroll
            for (int mt = 0; mt < 4; ++mt)
#pragma unroll
                for (int j = 0; j < 4; ++j) O[(mt * 16 + (lane >> 4) * 4 + j) * 132 + wave * 16 + (lane & 15)] = acc[mt][j];
        }
        __syncthreads();
        {
            float v[16]; float s1 = 0.f, s2 = 0.f;
#pragma unroll
            for (int e = 0; e < 16; ++e) { v[e] = O[t * 132 + dg * 16 + e]; s1 += v[e]; s2 += v[e] * v[e]; }
#pragma unroll
            for (int o = 1; o <= 4; o <<= 1) { s1 += shx(s1, lane, o); s2 += shx(s2, lane, o); }
            float mean = 0.f, rs;
            if (kind == 0) rs = rsqrtf(s2 * (1.0f / 128.0f) + 1e-6f);
            else { mean = s1 * (1.0f / 128.0f); const float var = fmaxf(s2 * (1.0f / 128.0f) - mean * mean, 0.f); rs = rsqrtf(var + 1e-6f); }
            const float* gn = (kind == 0 ? (const float*)P->in[17] : (const float*)P->in[18]) + (size_t)l * 512 + h * 128 + dg * 16;
            bf16_t* gp = ZG + (size_t)tg * 2048 + (kind == 0 ? 512 : 1024) + h * 128 + dg * 16;
            const u32x4 g0 = *(const u32x4*)gp, g1 = *(const u32x4*)(gp + 8);
            float gv[16];
#pragma unroll
            for (int e = 0; e < 4; ++e) { gv[2 * e] = __uint_as_float(g0[e] << 16); gv[2 * e + 1] = __uint_as_float(g0[e] & 0xffff0000u); gv[8 + 2 * e] = __uint_as_float(g1[e] << 16); gv[8 + 2 * e + 1] = __uint_as_float(g1[e] & 0xffff0000u); }
            float r[16];
#pragma unroll
            for (int e = 0; e < 16; ++e) r[e] = (v[e] - mean) * rs * gn[e] * siluf_(gv[e]);
            u32x4 w0, w1;
            w0.x = cvt_pk_bf16(r[0], r[1]); w0.y = cvt_pk_bf16(r[2], r[3]); w0.z = cvt_pk_bf16(r[4], r[5]); w0.w = cvt_pk_bf16(r[6], r[7]);
            w1.x = cvt_pk_bf16(r[8], r[9]); w1.y = cvt_pk_bf16(r[10], r[11]); w1.z = cvt_pk_bf16(r[12], r[13]); w1.w = cvt_pk_bf16(r[14], r[15]);
            *(u32x4*)gp = w0; *(u32x4*)(gp + 8) = w1;
        }
        __syncthreads();
    }
}

__device__ __forceinline__ void lru_p1(KP P, int l) {
    unsigned char* ws = P->ws;
    const int d = otid(), lane = d & 63, blk = d >> 6;
    const float* wa = (const float*)P->in[21] + ((size_t)l * 8 + blk) * 4096; const float* wx = (const float*)P->in[23] + ((size_t)l * 8 + blk) * 4096;
    float wac[64], wxc[64];
#pragma unroll
    for (int c = 0; c < 64; ++c) { wac[c] = wa[c * 64 + lane]; wxc[c] = wx[c * 64 + lane]; }
    const float* cwp = (const float*)P->in[19] + (size_t)l * 4 * 512;
    const float cw0 = cwp[d], cw1 = cwp[512 + d], cw2 = cwp[1024 + d], cw3 = cwp[1536 + d], cb = ((const float*)P->in[20])[l * 512 + d];
    const float ba = ((const float*)P->in[22])[l * 512 + d], bx = ((const float*)P->in[24])[l * 512 + d];
    const float sp = softplusf_(-((const float*)P->in[25])[l * 512 + d]);
    const bf16_t* X = (const bf16_t*)(ws + OFF_ZLRU);
    float* HL = (float*)(ws + OFF_HL); float* CA = (float*)(ws + OFF_CA); float* AC = (float*)(ws + OFF_AC); float* HC = (float*)(ws + OFF_HC);
    for (int n = obid(); n < 256; n += gridDim.x) {
        const int t0 = n * 64;
        float x1 = 0.f, x2 = 0.f, x3 = 0.f;
        if (t0 > 0) { x1 = bf2f(X[(size_t)(t0 - 1) * 512 + d]); x2 = bf2f(X[(size_t)(t0 - 2) * 512 + d]); x3 = bf2f(X[(size_t)(t0 - 3) * 512 + d]); }
        float hloc = 0.f, cum = 1.f;
        bf16_t xa[16], xb[16];
#pragma unroll
        for (int q = 0; q < 16; ++q) xa[q] = X[(size_t)(t0 + q) * 512 + d];
        for (int tg = 0; tg < 4; ++tg) {
#pragma unroll
          for (int q = 0; q < 16; ++q) xb[q] = X[(size_t)(t0 + (tg < 3 ? tg + 1 : tg) * 16 + q) * 512 + d];
#pragma unroll
          for (int q = 0; q < 16; ++q) {
            const int t = t0 + tg * 16 + q;
            const float x0 = bf2f(xa[q]);
            const float xc = x3 * cw0 + x2 * cw1 + x1 * cw2 + x0 * cw3 + cb;
            float ra = ba, ri = bx;
#pragma unroll
            for (int c = 0; c < 64; ++c) { const float xv = rlane(xc, c); ra += xv * wac[c]; ri += xv * wxc[c]; }
            const float r = sigmoidf_(ra), ig = sigmoidf_(ri);
            const float la = -8.0f * r * sp; const float a = __expf(la);
            const float x2l = 2.0f * la;
            const float om = x2l > -0.02f ? -(x2l * (1.0f + x2l * (0.5f + x2l * (1.0f / 6.0f)))) : 1.0f - __expf(x2l);
            const float uu = sqrtf(fmaxf(om, 0.f)) * (ig * xc);
            hloc = a * hloc + uu; cum *= a;
            HL[(size_t)t * 512 + d] = hloc; CA[(size_t)t * 512 + d] = cum;
            x3 = x2; x2 = x1; x1 = x0;
          }
#pragma unroll
          for (int q = 0; q < 16; ++q) xa[q] = xb[q];
        }
        AC[n * 512 + d] = cum; HC[n * 512 + d] = hloc;
    }
}
__device__ __forceinline__ void lru_p3(KP P) {
    unsigned char* ws = P->ws;
    const float* HL = (const float*)(ws + OFF_HL); const float* CA = (const float*)(ws + OFF_CA); const float* HIN = (const float*)(ws + OFF_HIN);
    bf16_t* ZG = (bf16_t*)(ws + OFF_ZG);
    const size_t total = (size_t)TB * 128;
    for (size_t i = (size_t)obid() * 512 + otid(); i < total; i += (size_t)gridDim.x * 512) {
        const int t = (int)(i >> 7), d4 = (int)(i & 127) * 4;
        const f32x4 hl = *(const f32x4*)(HL + (size_t)t * 512 + d4), ca = *(const f32x4*)(CA + (size_t)t * 512 + d4), hi = *(const f32x4*)(HIN + (size_t)(t >> 6) * 512 + d4);
        bf16_t* gp = ZG + (size_t)t * 2048 + 1536 + d4;
        const u32x2 gq = *(const u32x2*)gp;
        const float g0 = __uint_as_float(gq.x << 16), g1 = __uint_as_float(gq.x & 0xffff0000u), g2 = __uint_as_float(gq.y << 16), g3 = __uint_as_float(gq.y & 0xffff0000u);
        u32x2 w; w.x = cvt_pk_bf16((hl[0] + ca[0] * hi[0]) * siluf_(g0), (hl[1] + ca[1] * hi[1]) * siluf_(g1));
        w.y = cvt_pk_bf16((hl[2] + ca[2] * hi[2]) * siluf_(g2), (hl[3] + ca[3] * hi[3]) * siluf_(g3));
        *(u32x2*)gp = w;
    }
}

#define XB_TMO      128
#define XB_XCNT(j)  (256  + 64 * (j))
#define XB_XSUB(j)  (1280 + 64 * (j))
#define XB_XGEN(j)  (2304 + 64 * (j))
#define XB_TOP      3328
#define XB_TOPGEN   3392
#define XCD_BAR_WORDS 3456
#define XB_SPIN_CAP (1u << 22)
__device__ __forceinline__ unsigned xb_ld(unsigned* p)              { return __hip_atomic_load(p, __ATOMIC_RELAXED, __HIP_MEMORY_SCOPE_AGENT); }
__device__ __forceinline__ unsigned xb_add(unsigned* p, unsigned v) { return __hip_atomic_fetch_add(p, v, __ATOMIC_RELAXED, __HIP_MEMORY_SCOPE_AGENT); }
__device__ __forceinline__ unsigned xb_xcc_id() { return (unsigned)__builtin_amdgcn_s_getreg((3 << 11) | 20) & 0xFu; }
#define XB_SPIN(cond, bar) do { unsigned _sp = 0; while (cond) { __builtin_amdgcn_s_sleep(1); \
    if ((++_sp & 255u) == 0u) { if (xb_ld(&(bar)[XB_TMO])) break; if (_sp > XB_SPIN_CAP) { atomicAdd(&(bar)[XB_TMO], 1u); break; } } } } while (0)
struct XcdBarrier { unsigned* bar; unsigned x; volatile LAS unsigned* st; };
__device__ __forceinline__ XcdBarrier xcd_barrier_post(unsigned* bar, volatile LAS unsigned* st) {
    XcdBarrier b; b.bar = bar; b.x = xb_xcc_id(); b.st = st;
    if (threadIdx.x == 0) (void)xb_add(&bar[XB_XCNT(b.x)], 1u);
    return b;
}
__device__ __forceinline__ void xcd_barrier_complete(unsigned* bar, unsigned x, unsigned& nloc, unsigned& nx) {
    const unsigned G = gridDim.x * gridDim.y * gridDim.z;
    unsigned sum, cnt, mine, sp = 0u;
    for (;;) {
        sum = 0u; cnt = 0u; mine = 0u;
#pragma unroll
        for (unsigned j = 0; j < 16; ++j) { const unsigned c = xb_ld(&bar[XB_XCNT(j)]); sum += c; cnt += (c > 0u) ? 1u : 0u; mine = (j == x) ? c : mine; }
        if (sum == G) break;
        __builtin_amdgcn_s_sleep(1);
        if ((++sp & 255u) == 0u) { if (xb_ld(&bar[XB_TMO])) break; if (sp > XB_SPIN_CAP) { atomicAdd(&bar[XB_TMO], 1u); break; } }
    }
    nloc = mine > 0u ? mine : 1u; nx = cnt > 0u ? cnt : 1u;
}
__device__ __forceinline__ void xcd_barrier(const XcdBarrier& b) {
    asm volatile("s_waitcnt vmcnt(0)" ::: "memory");
    __syncthreads();
    if (threadIdx.x == 0) {
        unsigned* bar = b.bar;
        __builtin_amdgcn_s_waitcnt(0);
        unsigned nloc = b.st[0], nx = b.st[1];
        if (nloc == 0u) { xcd_barrier_complete(bar, b.x, nloc, nx); b.st[0] = nloc; b.st[1] = nx; }
        const unsigned old = xb_add(&bar[XB_XSUB(b.x)], 1u);
        const unsigned gen = old / nloc;
        if (old + 1u == (gen + 1u) * nloc) {
            __builtin_amdgcn_fence(__ATOMIC_RELEASE, "agent");
            asm volatile("s_waitcnt vmcnt(0)" ::: "memory");
            const unsigned og = xb_add(&bar[XB_TOP], 1u);
            const unsigned tg = og / nx;
            if (og + 1u == (tg + 1u) * nx) xb_add(&bar[XB_TOPGEN], 1u);
            else XB_SPIN(xb_ld(&bar[XB_TOPGEN]) == tg, bar);
            __builtin_amdgcn_fence(__ATOMIC_ACQUIRE, "agent");
            xb_add(&bar[XB_XGEN(b.x)], 1u);
            asm volatile("s_waitcnt vmcnt(0)" ::: "memory");
        } else {
            XB_SPIN(xb_ld(&bar[XB_XGEN(b.x)]) == gen, bar);
            __builtin_amdgcn_fence(__ATOMIC_ACQUIRE, "agent");
            asm volatile("s_waitcnt vmcnt(0)" ::: "memory");
        }
    }
    __syncthreads();
}

__global__ void __launch_bounds__(512) fwd_megakernel(Params Parg) {
    extern __shared__ __attribute__((aligned(16))) unsigned char shm[];
    cg::grid_group grid = cg::this_grid();
    LAS unsigned char* lds = (LAS unsigned char*)shm;
    using namespace pg8;
    if (threadIdx.x < 4) ((volatile LAS unsigned*)(lds + STAGE_BYTES + 16384))[threadIdx.x] = 0u;
    __syncthreads();
    { KP Pb = kparams(); (void)xcd_barrier_post((unsigned*)(Pb->ws + OFF_BAR), (volatile LAS unsigned*)(lds + STAGE_BYTES + 16384)); }
    grid.sync();
#ifndef DUP_GEMM
#define DUP_GEMM 1
#endif
#ifndef DUP_RW
#define DUP_RW 1
#endif
#ifndef DUP_GR
#define DUP_GR 1
#endif
#ifndef DUP_MISC
#define DUP_MISC 1
#endif
#ifndef NSYNC
#define NSYNC 1
#endif
#define REP(n) _Pragma("nounroll") for (int _d = 0; _d < (n); ++_d)
#define GSYNC() do { REP(NSYNC) { KP Pb = kparams(); XcdBarrier xb_; xb_.bar = (unsigned*)(Pb->ws + OFF_BAR); xb_.x = xb_xcc_id(); xb_.st = (volatile LAS unsigned*)(lds + STAGE_BYTES + 16384); xcd_barrier(xb_); } } while (0)
    for (int l = 0; l < 2; ++l) {
        { KP P = kparams(); unsigned char* ws = P->ws;
          conv_t<true>((bf16_t*)(ws + OFF_WIN), (const float*)P->in[4] + (size_t)l * 1024 * NIN, 10752, 1024, NIN); }
        for (int n = 0; n < 4; ++n) { KP P = kparams(); unsigned char* ws = P->ws;
          conv_t<false>((bf16_t*)(ws + OFF_WB) + (size_t)n * 1024 * 512, (const float*)P->in[26] + ((size_t)l * 4 + n) * 512 * 1024, 1024, 512, 1024); }
        { KP P = kparams(); unsigned char* ws = P->ws; conv_t<false>((bf16_t*)(ws + OFF_WOUT), (const float*)P->in[27] + (size_t)l * 1024 * 1024, 1024, 1024, 1024); }
        { KP P = kparams(); unsigned char* ws = P->ws; conv_t<false>((bf16_t*)(ws + OFF_WQ), (const float*)P->in[30] + (size_t)l * 1024 * 1024, 1024, 1024, 1024); }
        { KP P = kparams(); unsigned char* ws = P->ws; conv_t<false>((bf16_t*)(ws + OFF_WKV), (const float*)P->in[31] + (size_t)l * 1024 * 2048, 2048, 1024, 2048); }
        { KP P = kparams(); unsigned char* ws = P->ws; conv_t<false>((bf16_t*)(ws + OFF_WO), (const float*)P->in[32] + (size_t)l * 1024 * 1024, 1024, 1024, 1024); }
        { KP P = kparams(); unsigned char* ws = P->ws; rmsnorm_bf16((const float*)P->in[1], (const float*)P->in[29] + l * 1024, (bf16_t*)(ws + OFF_MN), 512); }
        for (int b = 0; b < 2; ++b) {
            { KP P = kparams(); unsigned char* ws = P->ws;
              const float* hin = (l == 0 ? (const float*)P->in[0] : (const float*)P->out) + (size_t)b * TB * DM;
              rmsnorm_bf16(hin, (const float*)P->in[3] + l * 1024, (bf16_t*)(ws + OFF_UN), TB); }
            GSYNC();
            if (b == 0) { KP P = kparams(); unsigned char* ws = P->ws;
                Order S; S.init(2, 8, 1, ws + OFF_MN, ws + OFF_WKV, 256L * 1024 * 2, 256L * 1024 * 2, 0, 0, 0);
                EpiKV E{(bf16_t*)(ws + OFF_KM), (bf16_t*)(ws + OFF_VT)}; gemm_phase(lds, Gemm{1024, 1024, 1024}, S, E); }
            REP(DUP_GEMM) { KP P = kparams(); unsigned char* ws = P->ws;
                Order S; S.init(64, 26, 1, ws + OFF_UN, ws + OFF_WIN, 256L * 1024 * 2, 256L * 1024 * 2, 0, 0, 0);
                EpiInproj E{ws}; gemm_phase(lds, Gemm{1024, 1024, 1024}, S, E); }
            GSYNC();
            REP(DUP_RW) rwkv_prep(kparams(), l);
            GSYNC();
            REP(DUP_RW) rwkv_pass1(kparams());
            GSYNC();
            rwkv_cscan(kparams(), shm);
            GSYNC();
            rwkv_pass2(kparams(), l);
            GSYNC();
            REP(DUP_GR) gr_ds(kparams(), l, b, shm);
            REP(DUP_MISC) lru_p1(kparams(), l);
            GSYNC();
            gr_scan(kparams());
            GSYNC();
            gr_out(kparams(), l, b, shm);
            lru_p3(kparams());
            GSYNC();
            REP(DUP_GEMM) { KP P = kparams(); unsigned char* ws = P->ws;
                Order S; S.init(64, 16, 1, ws + OFF_UN, ws + OFF_WIN + (size_t)6656 * 1024 * 2, 256L * 1024 * 2, 256L * 1024 * 2, 0, 0, 0);
                EpiBf16<1> E{(bf16_t*)(ws + OFF_G), 4096, 1.0f}; gemm_phase(lds, Gemm{1024, 1024, 1024}, S, E); }
            GSYNC();
            REP(DUP_GEMM) { KP P = kparams(); unsigned char* ws = P->ws;
                Order S; S.init(64, 4, 4, ws + OFF_ZG, ws + OFF_WB, 256L * 2048 * 2, 256L * 512 * 2, 0, 512L * 2, 1024L * 512 * 2);
                EpiMerge E{(const bf16_t*)(ws + OFF_G), (bf16_t*)(ws + OFF_MRG)}; gemm_phase(lds, Gemm{2048, 512, 512}, S, E); }
            GSYNC();
            { KP P = kparams(); unsigned char* ws = P->ws;
                const float* hin = (l == 0 ? (const float*)P->in[0] : (const float*)P->out) + (size_t)b * TB * DM; float* hout = P->out + (size_t)b * TB * DM;
                Order S; S.init(64, 4, 1, ws + OFF_MRG, ws + OFF_WOUT, 256L * 1024 * 2, 256L * 1024 * 2, 0, 0, 0);
                EpiResid E{hin, hout}; gemm_phase(lds, Gemm{1024, 1024, 1024}, S, E); }
            GSYNC();
            { KP P = kparams(); unsigned char* ws = P->ws; const float* hout = P->out + (size_t)b * TB * DM;
              rmsnorm_bf16(hout, (const float*)P->in[28] + l * 1024, (bf16_t*)(ws + OFF_UN), TB); }
            GSYNC();
            REP(DUP_GEMM) { KP P = kparams(); unsigned char* ws = P->ws;
                Order S; S.init(64, 4, 1, ws + OFF_UN, ws + OFF_WQ, 256L * 1024 * 2, 256L * 1024 * 2, 0, 0, 0);
                EpiBf16<0> E{(bf16_t*)(ws + OFF_Q), 1024, 0.0625f}; gemm_phase(lds, Gemm{1024, 1024, 1024}, S, E); }
            GSYNC();
            REP(DUP_GEMM) { KP P = kparams(); unsigned char* ws = P->ws;
                Order S; S.init(64, 4, 1, ws + OFF_Q, ws + OFF_KM + (size_t)b * 256 * 1024 * 2, 256L * 1024 * 2, 256L * 2, 256L * 2, 0, 0);
                EpiSoftmax E{(bf16_t*)(ws + OFF_P), (LAS float*)(lds + STAGE_BYTES)}; gemm_phase(lds, Gemm{1024, 1024, 256}, S, E); }
            GSYNC();
            REP(DUP_GEMM) { KP P = kparams(); unsigned char* ws = P->ws;
                Order S; S.init(64, 4, 1, ws + OFF_P, ws + OFF_VT + (size_t)b * 1024 * 256 * 2, 256L * 1024 * 2, 256L * 256 * 2, 256L * 2, 0, 0);
                EpiBf16<0> E{(bf16_t*)(ws + OFF_O), 1024, 1.0f}; gemm_phase(lds, Gemm{1024, 256, 256}, S, E); }
            GSYNC();
            { KP P = kparams(); unsigned char* ws = P->ws; float* hout = P->out + (size_t)b * TB * DM;
                Order S; S.init(64, 4, 1, ws + OFF_O, ws + OFF_WO, 256L * 1024 * 2, 256L * 1024 * 2, 0, 0, 0);
                EpiResid E{hout, hout}; gemm_phase(lds, Gemm{1024, 1024, 1024}, S, E); }
            GSYNC();
        }
    }
    { KP P = kparams(); rmsnorm_f32_inplace(P->out, (const float*)P->in[33], 2 * TB); }
}

extern "C" void kernel_launch(void* const* d_in, const int* in_sizes, int n_in, void* d_out, int out_size, void* d_ws, size_t ws_size, hipStream_t stream) {
    constexpr size_t kDynLds = pg8::STAGE_BYTES + 16384 + 64;
    static int grid_blocks = 0;
    if (!grid_blocks) {
        int dev = 0, cus = 0, per_cu = 0;
        hipGetDevice(&dev);
        hipDeviceGetAttribute(&cus, hipDeviceAttributeMultiprocessorCount, dev);
        hipFuncSetAttribute((const void*)fwd_megakernel, hipFuncAttributeMaxDynamicSharedMemorySize, (int)kDynLds);
        hipOccupancyMaxActiveBlocksPerMultiprocessor(&per_cu, (const void*)fwd_megakernel, 512, kDynLds);
        if (per_cu < 1) { fprintf(stderr, "occupancy query returned %d\n", per_cu); per_cu = 1; }
        grid_blocks = cus * per_cu;
        if (ws_size < OFF_END) fprintf(stderr, "workspace too small: %zu < %zu\n", ws_size, (size_t)OFF_END);
    }
    hipMemsetAsync((unsigned char*)d_ws + OFF_BAR, 0, 16384, stream);
    Params p{};
    for (int i = 0; i < 34; ++i) p.in[i] = d_in[i];
    p.out = (float*)d_out; p.ws = (unsigned char*)d_ws;
    void* args[] = {&p};
    hipError_t e = hipLaunchCooperativeKernel((const void*)fwd_megakernel, dim3(grid_blocks), dim3(512), args, kDynLds, stream);
    if (e != hipSuccess) fprintf(stderr, "cooperative launch failed: %s (grid %d)\n", hipGetErrorString(e), grid_blocks);
}
```

```cpp
#include <hip/hip_runtime.h>
#include <hip/hip_cooperative_groups.h>
#include <cstdio>
namespace cg = cooperative_groups;

typedef unsigned short bf16_t;
typedef short bf16x8 __attribute__((ext_vector_type(8)));
typedef float f32x4 __attribute__((ext_vector_type(4)));
typedef unsigned u32x4 __attribute__((ext_vector_type(4)));
typedef unsigned u32x2 __attribute__((ext_vector_type(2)));
#define LAS __attribute__((address_space(3)))

constexpr int TB = 16384;
constexpr int DM = 1024;
constexpr int NIN = 10384;
constexpr int NCH = 128, LCH = 128;

constexpr size_t SZ_WIN = (size_t)10752 * 1024 * 2;
constexpr size_t OFF_WIN = 0;
constexpr size_t OFF_WB = OFF_WIN + SZ_WIN;
constexpr size_t OFF_WOUT = OFF_WB + (size_t)4 * 1024 * 512 * 2;
constexpr size_t OFF_WQ = OFF_WOUT + (size_t)1024 * 1024 * 2;
constexpr size_t OFF_WKV = OFF_WQ + (size_t)1024 * 1024 * 2;
constexpr size_t OFF_WO = OFF_WKV + (size_t)2048 * 1024 * 2;
constexpr size_t OFF_UN = OFF_WO + (size_t)1024 * 1024 * 2;
constexpr size_t OFF_MN = OFF_UN + (size_t)TB * 1024 * 2;
constexpr size_t OFF_KM = OFF_MN + (size_t)512 * 1024 * 2;
constexpr size_t OFF_VT = OFF_KM + (size_t)512 * 1024 * 2;
constexpr size_t OFF_ZRW = OFF_VT + (size_t)512 * 1024 * 2;
constexpr size_t OFF_ZGLA = OFF_ZRW + (size_t)TB * 1792 * 2;
constexpr size_t OFF_ZRET = OFF_ZGLA + (size_t)TB * 1280 * 2;
constexpr size_t OFF_ZLRU = OFF_ZRET + (size_t)TB * 1024 * 2;
constexpr size_t OFF_ZG = OFF_ZLRU + (size_t)TB * 512 * 2;
constexpr size_t OFF_MRG = OFF_ZG + (size_t)TB * 2048 * 2;
constexpr size_t OFF_PREP = OFF_MRG + (size_t)TB * 1024 * 2;
constexpr size_t SZ_F = (size_t)TB * 512 * 4;
constexpr size_t OFF_PW = OFF_PREP, OFF_PKK = OFF_PW + SZ_F, OFF_PB = OFF_PKK + SZ_F, OFF_PKM = OFF_PB + SZ_F, OFF_PR = OFF_PKM + SZ_F;
constexpr size_t OFF_PV = OFF_PR + SZ_F;
constexpr size_t OFF_BON = OFF_PV + (size_t)TB * 512 * 2;
constexpr size_t OFF_BAR = OFF_BON + (size_t)TB * 8 * 4;
constexpr size_t OFF_END = OFF_BAR + 16384;
constexpr size_t OFF_G = OFF_ZRW;
constexpr size_t OFF_Q = OFF_ZRW;
constexpr size_t OFF_P = OFF_Q + (size_t)TB * 1024 * 2;
constexpr size_t OFF_O = OFF_P + (size_t)TB * 1024 * 2;
constexpr size_t OFF_PP = OFF_MRG;
constexpr size_t OFF_PL = OFF_MRG + (size_t)8 * NCH * 4096 * 4;
constexpr size_t OFF_DSG = OFF_PREP;
constexpr size_t OFF_DEC = OFF_DSG + (size_t)2 * 256 * 4 * 64 * 128 * 4;
constexpr size_t OFF_HL = OFF_DEC + (size_t)256 * 4 * 64 * 4;
constexpr size_t OFF_CA = OFF_HL + SZ_F;
constexpr size_t OFF_AC = OFF_CA + SZ_F;
constexpr size_t OFF_HC = OFF_AC + (size_t)256 * 512 * 4;
constexpr size_t OFF_HIN = OFF_HC + (size_t)256 * 512 * 4;
static_assert(OFF_HIN + 256 * 512 * 4 <= OFF_END, "overlay");
static_assert(OFF_END <= (size_t)512 * 1024 * 1024, "ws");

struct Params { const void* in[34]; float* out; unsigned char* ws; };
typedef const Params __attribute__((address_space(4)))* KP;
__device__ __forceinline__ KP kparams() { KP p = (KP)__builtin_amdgcn_kernarg_segment_ptr(); asm volatile("" : "+s"(p)); return p; }

__device__ __forceinline__ float bf2f(bf16_t v) { return __uint_as_float(((unsigned)v) << 16); }
__device__ __forceinline__ bf16_t f2bf(float f) { unsigned u = __float_as_uint(f); u += 0x7fffu + ((u >> 16) & 1u); return (bf16_t)(u >> 16); }
__device__ __forceinline__ unsigned cvt_pk_bf16(float lo, float hi) { unsigned r; asm("v_cvt_pk_bf16_f32 %0, %1, %2" : "=v"(r) : "v"(lo), "v"(hi)); return r; }
__device__ __forceinline__ float shx(float v, int lane, int o) { return __int_as_float(__builtin_amdgcn_ds_bpermute((lane ^ o) << 2, __float_as_int(v))); }
__device__ __forceinline__ float wave_sum(float v, int lane) {
#pragma unroll
    for (int o = 32; o >= 1; o >>= 1) v += shx(v, lane, o);
    return v; }
__device__ __forceinline__ float rlane(float v, int k) { return __int_as_float(__builtin_amdgcn_readlane(__float_as_int(v), k)); }
__device__ __forceinline__ float sigmoidf_(float x) { return 1.0f / (1.0f + __expf(-x)); }
__device__ __forceinline__ float siluf_(float x) { return x / (1.0f + __expf(-x)); }
__device__ __forceinline__ float softplusf_(float y) { return fmaxf(y, 0.f) + __logf(1.0f + __expf(-fabsf(y))); }
__device__ __forceinline__ float tanhf_(float x) { float e = __expf(2.0f * x); return 1.0f - 2.0f / (e + 1.0f); }

__device__ __forceinline__ int otid() { int t = threadIdx.x; asm volatile("" : "+v"(t)); return t; }
__device__ __forceinline__ int obid() { int t = blockIdx.x; asm volatile("" : "+s"(t)); return t; }

namespace pg8 {
constexpr int BM = 256, BK = 64, HALF = 128, HTB = HALF * BK * 2, STAGE_BYTES = 8 * HTB, NXCD = 8, WGM = 8;
__device__ __forceinline__ int lds_byte(int r, int c) { const int st = (r >> 4) * 2 + (c >> 5), rr = r & 15, cc = c & 31, ob = rr * 64 + cc * 2; return st * 1024 + (ob ^ (((ob >> 9) & 1) << 5)); }
__device__ __forceinline__ void stage_rc(int b, int& R, int& C) { const int st = b / 1024, sb = b % 1024, swz = sb ^ (((sb >> 9) & 1) << 5); R = (st >> 1) * 16 + swz / 64; C = (st & 1) * 32 + (swz % 64) / 2; }
__device__ __forceinline__ int perm32(int rho) { const int n = rho >> 4, i = rho & 15; return 8 * (i >> 2) + 4 * n + (i & 3); }

struct Unit { int pm, pn, aux; const char* pa; const char* pb; };
struct Gemm { int lda, ldb, K; };

struct Order {
    int nM, nN, nwg, G, c, rep;
    const char* A; const char* B;
    long tA, tB, aPn, aRep, bRep;
    __device__ void init(int nM_, int nN_, int rep_, const void* A_, const void* B_, long tA_, long tB_, long aPn_, long aRep_, long bRep_) {
        nM = nM_; nN = nN_; nwg = nM * nN; G = gridDim.x; c = obid(); rep = rep_; A = (const char*)A_; B = (const char*)B_; tA = tA_; tB = tB_; aPn = aPn_; aRep = aRep_; bRep = bRep_; }
    __device__ bool next(int i, Unit& u) const {
        const int ti = i / rep, r = i - ti * rep;
        const long L = (long)ti * G + c; if (L >= nwg) return false;
        int wgid = (int)L; { const int q = nwg / NXCD, rr = nwg % NXCD, xcd = wgid % NXCD, off = wgid / NXCD; wgid = (xcd < rr ? xcd * (q + 1) : rr * (q + 1) + (xcd - rr) * q) + off; }
        const int nig = WGM * nN, gid = wgid / nig, fm = gid * WGM, gsz = (nM - fm) < WGM ? (nM - fm) : WGM;
        u.pm = fm + ((wgid % nig) % gsz); u.pn = (wgid % nig) / gsz; u.aux = r;
        u.pa = A + (long)u.pm * tA + (long)u.pn * aPn + (long)r * aRep;
        u.pb = B + (long)u.pn * tB + (long)r * bRep;
        return true; }
};

template <class Epi>
__device__ __forceinline__ void gemm_phase(LAS unsigned char* lds, const Gemm g, const Order& S, const Epi& E) {
    const int tid = otid(), wid = __builtin_amdgcn_readfirstlane(tid >> 6), lane = tid & 63, wr = wid >> 2, wc = wid & 3, fr = lane & 15, fq = lane >> 4;
    const int K = g.K, nt = K / BK;
    unsigned voffA[2], voffB[2];
#pragma unroll
    for (int i = 0; i < 2; ++i) { int R, C; stage_rc(tid * 16 + i * 8192, R, C); const int Rb = Epi::PERM ? ((R & ~31) + perm32(R & 31)) : R;
        voffA[i] = (unsigned)(R * g.lda + C) * 2u; voffB[i] = (unsigned)(Rb * g.ldb + C) * 2u; }
    const size_t kstep = (size_t)(BK * 2);
    const size_t hstepA = (size_t)HALF * g.lda * 2, hstepB = (size_t)HALF * g.ldb * 2;
    const unsigned ldsw = (unsigned)wid * 1024u;
    const int aoff = lds_byte(wr * 64 + fr, fq * 8), boff = lds_byte(wc * 32 + fr, fq * 8);
#define PG8_SA(b, h) (((b) * 2 + (h)) * HTB)
#define PG8_SB(b, h) ((4 + (b) * 2 + (h)) * HTB)
#define PG8_STAGE(bufoff, gbase, voff) do { _Pragma("unroll") for (int _i = 0; _i < 2; ++_i) \
        __builtin_amdgcn_global_load_lds((const unsigned*)((const char*)(gbase) + (voff)[_i]), (LAS unsigned*)(lds + (bufoff) + ldsw + _i * 8192), 16, 0, 0); } while (0)
#define PG8_LDA(dst, b, h) do { _Pragma("unroll") for (int m = 0; m < 4; ++m) _Pragma("unroll") for (int k = 0; k < 2; ++k) dst[m][k] = *(const LAS bf16x8*)(lds + PG8_SA(b, h) + aoff + m * 2048 + k * 1024); } while (0)
#define PG8_LDB(dst, b, h) do { _Pragma("unroll") for (int n = 0; n < 2; ++n) _Pragma("unroll") for (int k = 0; k < 2; ++k) dst[n][k] = *(const LAS bf16x8*)(lds + PG8_SB(b, h) + boff + n * 2048 + k * 1024); } while (0)
#define PG8_MMA(ai, bj, At, Bt) do { __builtin_amdgcn_s_setprio(1); _Pragma("unroll") for (int m = 0; m < 4; ++m) _Pragma("unroll") for (int n = 0; n < 2; ++n) _Pragma("unroll") for (int k = 0; k < 2; ++k) \
        acc[ai][bj][m][n] = __builtin_amdgcn_mfma_f32_16x16x32_bf16(Bt[n][k], At[m][k], acc[ai][bj][m][n], 0, 0, 0); __builtin_amdgcn_s_setprio(0); } while (0)
#define PG8_WAIT_V(n) asm volatile("s_waitcnt vmcnt(" #n ")" ::: "memory")
#define PG8_WAIT_L(n) asm volatile("s_waitcnt lgkmcnt(" #n ")" ::: "memory")
#define PG8_BAR __builtin_amdgcn_s_barrier()
#define PG8_SCHED __builtin_amdgcn_sched_barrier(0)
    Unit cur, nxt; int ui = 0;
    if (!S.next(0, cur)) return;
    f32x4 acc[2][2][4][2];
#pragma unroll
    for (int a = 0; a < 2; ++a)
#pragma unroll
        for (int b = 0; b < 2; ++b)
#pragma unroll
            for (int m = 0; m < 4; ++m)
#pragma unroll
                for (int n = 0; n < 2; ++n) acc[a][b][m][n] = (f32x4){0.f, 0.f, 0.f, 0.f};
    bf16x8 At[4][2], B0[2][2], B1[2][2];
    const char* cA = cur.pa; const char* cB = cur.pb;
    PG8_STAGE(PG8_SB(0, 0), cB, voffB); PG8_STAGE(PG8_SA(0, 0), cA, voffA); PG8_STAGE(PG8_SB(0, 1), cB + hstepB, voffB); PG8_STAGE(PG8_SA(0, 1), cA + hstepA, voffA);
    if (wr == 1) PG8_BAR;
    PG8_WAIT_V(4); PG8_BAR;
    PG8_STAGE(PG8_SB(1, 0), cB + kstep, voffB); PG8_STAGE(PG8_SA(1, 0), cA + kstep, voffA); PG8_STAGE(PG8_SB(1, 1), cB + hstepB + kstep, voffB);
    PG8_WAIT_V(6); PG8_BAR;
    for (;;) {
        const bool has_next = S.next(ui + 1, nxt);
        const char* nA = has_next ? nxt.pa : cA; const char* nB = has_next ? nxt.pb : cB;
        for (int t = 0; t < nt; t += 2) {
            const bool last = (t == nt - 2);
            const char* a1 = cA + (size_t)(t + 1) * kstep;
            const char* a2 = last ? nA : cA + (size_t)(t + 2) * kstep; const char* b2 = last ? nB : cB + (size_t)(t + 2) * kstep;
            const char* a3 = a2 + kstep; const char* b3 = b2 + kstep;
            PG8_LDB(B0, 0, 0); PG8_SCHED; PG8_LDA(At, 0, 0); PG8_STAGE(PG8_SA(1, 1), a1 + hstepA, voffA);
            PG8_WAIT_L(8); PG8_BAR; PG8_WAIT_L(0); PG8_MMA(0, 0, At, B0); PG8_BAR; PG8_SCHED;
            PG8_LDB(B1, 0, 1); PG8_STAGE(PG8_SB(0, 0), b2, voffB);
            PG8_BAR; PG8_WAIT_L(0); PG8_MMA(0, 1, At, B1); PG8_BAR;
            PG8_LDA(At, 0, 1); PG8_STAGE(PG8_SA(0, 0), a2, voffA);
            PG8_BAR; PG8_WAIT_L(0); PG8_MMA(1, 0, At, B0); PG8_BAR; PG8_SCHED;
            PG8_STAGE(PG8_SB(0, 1), b2 + hstepB, voffB);
            PG8_WAIT_V(6); PG8_BAR; PG8_MMA(1, 1, At, B1); PG8_BAR;
            PG8_LDB(B0, 1, 0); PG8_SCHED; PG8_LDA(At, 1, 0); PG8_STAGE(PG8_SA(0, 1), a2 + hstepA, voffA);
            PG8_WAIT_L(8); PG8_BAR; PG8_WAIT_L(0); PG8_MMA(0, 0, At, B0); PG8_BAR; PG8_SCHED;
            PG8_LDB(B1, 1, 1); PG8_STAGE(PG8_SB(1, 0), b3, voffB);
            PG8_BAR; PG8_WAIT_L(0); PG8_MMA(0, 1, At, B1); PG8_BAR;
            PG8_LDA(At, 1, 1); PG8_STAGE(PG8_SA(1, 0), a3, voffA);
            PG8_BAR; PG8_WAIT_L(0); PG8_MMA(1, 0, At, B0); PG8_BAR; PG8_SCHED;
            PG8_STAGE(PG8_SB(1, 1), b3 + hstepB, voffB);
            PG8_WAIT_V(6); PG8_BAR; PG8_MMA(1, 1, At, B1); PG8_BAR;
        }
        E(acc, cur, wr, wc, fr, fq);
        if (!has_next) break;
#pragma unroll
        for (int a = 0; a < 2; ++a)
#pragma unroll
            for (int b = 0; b < 2; ++b)
#pragma unroll
                for (int m = 0; m < 4; ++m)
#pragma unroll
                    for (int n = 0; n < 2; ++n) acc[a][b][m][n] = (f32x4){0.f, 0.f, 0.f, 0.f};
        cur = nxt; cA = nA; cB = nB; ++ui;
    }
    PG8_WAIT_V(0);
    if (wr == 0) PG8_BAR;
    PG8_BAR;
#undef PG8_SA
#undef PG8_SB
#undef PG8_STAGE
#undef PG8_LDA
#undef PG8_LDB
#undef PG8_MMA
#undef PG8_WAIT_V
#undef PG8_WAIT_L
#undef PG8_BAR
#undef PG8_SCHED
}

typedef f32x4 Acc[2][2][4][2];

struct EpiInproj {
    static constexpr bool PERM = true;
    unsigned char* ws;
    __device__ __forceinline__ void operator()(Acc& acc, const Unit& u, int wr, int wc, int fr, int fq) const {
        int pn = u.pn, ld, colt; size_t off;
        if (pn < 7) { off = OFF_ZRW; ld = 1792; colt = pn * 256; }
        else if (pn < 12) { off = OFF_ZGLA; ld = 1280; colt = (pn - 7) * 256; }
        else if (pn < 16) { off = OFF_ZRET; ld = 1024; colt = (pn - 12) * 256; }
        else if (pn < 18) { off = OFF_ZLRU; ld = 512; colt = (pn - 16) * 256; }
        else { off = OFF_ZG; ld = 2048; colt = (pn - 18) * 256; }
        bf16_t* base = (bf16_t*)(ws + off);
        const int row0 = u.pm * BM + wr * 64 + fr, col0 = colt + wc * 32 + 8 * fq;
#pragma unroll
        for (int ai = 0; ai < 2; ++ai)
#pragma unroll
            for (int m = 0; m < 4; ++m) { bf16_t* rowp = base + (size_t)(row0 + ai * HALF + m * 16) * ld + col0;
#pragma unroll
                for (int bj = 0; bj < 2; ++bj) { const f32x4 v0 = acc[ai][bj][m][0], v1 = acc[ai][bj][m][1];
                    u32x4 w; w.x = cvt_pk_bf16(v0[0], v0[1]); w.y = cvt_pk_bf16(v0[2], v0[3]); w.z = cvt_pk_bf16(v1[0], v1[1]); w.w = cvt_pk_bf16(v1[2], v1[3]);
                    *(u32x4*)(rowp + bj * HALF) = w; } }
    }
};
template <int ACT> struct EpiBf16 {
    static constexpr bool PERM = true;
    bf16_t* O; int ldc; float scale;
    __device__ __forceinline__ void operator()(Acc& acc, const Unit& u, int wr, int wc, int fr, int fq) const {
        const int row0 = u.pm * BM + wr * 64 + fr, col0 = u.pn * BM + wc * 32 + 8 * fq;
#pragma unroll
        for (int ai = 0; ai < 2; ++ai)
#pragma unroll
            for (int m = 0; m < 4; ++m) { bf16_t* rowp = O + (size_t)(row0 + ai * HALF + m * 16) * ldc + col0;
#pragma unroll
                for (int bj = 0; bj < 2; ++bj) { f32x4 v0 = acc[ai][bj][m][0], v1 = acc[ai][bj][m][1];
                    if (ACT == 1) {
#pragma unroll
                        for (int j = 0; j < 4; ++j) { v0[j] = sigmoidf_(v0[j]); v1[j] = sigmoidf_(v1[j]); } }
                    else { v0 = v0 * scale; v1 = v1 * scale; }
                    u32x4 w; w.x = cvt_pk_bf16(v0[0], v0[1]); w.y = cvt_pk_bf16(v0[2], v0[3]); w.z = cvt_pk_bf16(v1[0], v1[1]); w.w = cvt_pk_bf16(v1[2], v1[3]);
                    *(u32x4*)(rowp + bj * HALF) = w; } }
    }
};
struct EpiKV {
    static constexpr bool PERM = true;
    bf16_t* KM; bf16_t* VT;
    __device__ __forceinline__ void operator()(Acc& acc, const Unit& u, int wr, int wc, int fr, int fq) const {
        const int row0 = u.pm * BM + wr * 64 + fr, col0 = u.pn * BM + wc * 32 + 8 * fq;
#pragma unroll
        for (int ai = 0; ai < 2; ++ai)
#pragma unroll
            for (int m = 0; m < 4; ++m) { const int row = row0 + ai * HALF + m * 16;
#pragma unroll
                for (int bj = 0; bj < 2; ++bj)
#pragma unroll
                    for (int n = 0; n < 2; ++n)
#pragma unroll
                        for (int j = 0; j < 4; ++j) { const int col = col0 + bj * HALF + 4 * n + j; const bf16_t v = f2bf(acc[ai][bj][m][n][j]);
                            if (col < 1024) KM[(size_t)row * 1024 + col] = v;
                            else VT[((size_t)(row >> 8) * 1024 + (col - 1024)) * 256 + (row & 255)] = v; } }
    }
};
struct EpiMerge {
    static constexpr bool PERM = true;
    const bf16_t* G; bf16_t* MRG;
    __device__ __forceinline__ void operator()(Acc& acc, const Unit& u, int wr, int wc, int fr, int fq) const {
        const int row0 = u.pm * BM + wr * 64 + fr, col0 = u.pn * BM + wc * 32 + 8 * fq;
#pragma unroll
        for (int ai = 0; ai < 2; ++ai)
#pragma unroll
            for (int m = 0; m < 4; ++m) { const size_t row = (size_t)(row0 + ai * HALF + m * 16);
#pragma unroll
                for (int bj = 0; bj < 2; ++bj) { const f32x4 v0 = acc[ai][bj][m][0], v1 = acc[ai][bj][m][1];
                    const u32x4 gq = *(const u32x4*)(G + row * 4096 + u.aux * 1024 + col0 + bj * HALF);
                    bf16_t* mp = MRG + row * 1024 + col0 + bj * HALF;
                    float o[8] = {0.f, 0.f, 0.f, 0.f, 0.f, 0.f, 0.f, 0.f};
                    if (u.aux > 0) { const u32x4 mq = *(const u32x4*)mp;
#pragma unroll
                        for (int e = 0; e < 4; ++e) { o[2 * e] = __uint_as_float(mq[e] << 16); o[2 * e + 1] = __uint_as_float(mq[e] & 0xffff0000u); } }
#pragma unroll
                    for (int e = 0; e < 4; ++e) { const float g0 = __uint_as_float(gq[e] << 16), g1 = __uint_as_float(gq[e] & 0xffff0000u);
                        const float a0 = e < 2 ? v0[2 * e] : v1[2 * e - 4], a1 = e < 2 ? v0[2 * e + 1] : v1[2 * e - 3];
                        o[2 * e] += g0 * a0; o[2 * e + 1] += g1 * a1; }
                    u32x4 w; w.x = cvt_pk_bf16(o[0], o[1]); w.y = cvt_pk_bf16(o[2], o[3]); w.z = cvt_pk_bf16(o[4], o[5]); w.w = cvt_pk_bf16(o[6], o[7]);
                    *(u32x4*)mp = w; } }
    }
};
struct EpiResid {
    static constexpr bool PERM = false;
    const float* hin; float* hout;
    __device__ __forceinline__ void operator()(Acc& acc, const Unit& u, int wr, int wc, int fr, int fq) const {
        const int row0 = u.pm * BM + wr * 64 + fr, col0 = u.pn * BM + wc * 32 + 4 * fq;
#pragma unroll
        for (int ai = 0; ai < 2; ++ai)
#pragma unroll
            for (int m = 0; m < 4; ++m) { const size_t ro = (size_t)(row0 + ai * HALF + m * 16) * 1024 + col0;
#pragma unroll
                for (int bj = 0; bj < 2; ++bj)
#pragma unroll
                    for (int n = 0; n < 2; ++n) { const f32x4 r = *(const f32x4*)(hin + ro + bj * HALF + n * 16);
                        *(f32x4*)(hout + ro + bj * HALF + n * 16) = r + acc[ai][bj][m][n]; } }
    }
};
struct EpiSoftmax {
    static constexpr bool PERM = true;
    bf16_t* P; LAS float* xs;
    __device__ __forceinline__ void operator()(Acc& acc, const Unit& u, int wr_, int wc_, int fr_, int fq_) const {
        const int tid2 = otid(), wid2 = tid2 >> 6, wr = wid2 >> 2, wc = wid2 & 3, fr = tid2 & 15, fq = (tid2 >> 4) & 3;
#pragma unroll
        for (int ai = 0; ai < 2; ++ai)
#pragma unroll
            for (int m = 0; m < 4; ++m) { float v = -3.0e38f;
#pragma unroll
                for (int bj = 0; bj < 2; ++bj)
#pragma unroll
                    for (int n = 0; n < 2; ++n)
#pragma unroll
                        for (int j = 0; j < 4; ++j) v = fmaxf(v, acc[ai][bj][m][n][j]);
                xs[(ai * HALF + wr * 64 + m * 16 + fr) * 16 + wc * 4 + fq] = v; }
        asm volatile("s_waitcnt lgkmcnt(0)\n\ts_barrier" ::: "memory");
        float sums[2][4];
#pragma unroll
        for (int ai = 0; ai < 2; ++ai)
#pragma unroll
            for (int m = 0; m < 4; ++m) { const int rl = ai * HALF + wr * 64 + m * 16 + fr;
                f32x4 q = *(const LAS f32x4*)(xs + rl * 16);
#pragma unroll
                for (int e = 1; e < 4; ++e) { const f32x4 q2 = *(const LAS f32x4*)(xs + rl * 16 + 4 * e); q[0] = fmaxf(q[0], q2[0]); q[1] = fmaxf(q[1], q2[1]); q[2] = fmaxf(q[2], q2[2]); q[3] = fmaxf(q[3], q2[3]); }
                const float M = fmaxf(fmaxf(q[0], q[1]), fmaxf(q[2], q[3]));
                float sv = 0.f;
#pragma unroll
                for (int bj = 0; bj < 2; ++bj)
#pragma unroll
                    for (int n = 0; n < 2; ++n)
#pragma unroll
                        for (int j = 0; j < 4; ++j) { const float e = __expf(acc[ai][bj][m][n][j] - M); acc[ai][bj][m][n][j] = e; sv += e; }
                sums[ai][m] = sv; }
        asm volatile("s_waitcnt lgkmcnt(0)\n\ts_barrier" ::: "memory");
#pragma unroll
        for (int ai = 0; ai < 2; ++ai)
#pragma unroll
            for (int m = 0; m < 4; ++m) xs[(ai * HALF + wr * 64 + m * 16 + fr) * 16 + wc * 4 + fq] = sums[ai][m];
        asm volatile("s_waitcnt lgkmcnt(0)\n\ts_barrier" ::: "memory");
        const int row0 = u.pm * BM + wr * 64 + fr, col0 = u.pn * BM + wc * 32 + 8 * fq;
#pragma unroll
        for (int ai = 0; ai < 2; ++ai)
#pragma unroll
            for (int m = 0; m < 4; ++m) { const int rl = ai * HALF + wr * 64 + m * 16 + fr;
                f32x4 q = *(const LAS f32x4*)(xs + rl * 16);
#pragma unroll
                for (int e = 1; e < 4; ++e) q += *(const LAS f32x4*)(xs + rl * 16 + 4 * e);
                const float inv = 1.0f / (q[0] + q[1] + q[2] + q[3]);
                bf16_t* rowp = P + (size_t)(row0 + ai * HALF + m * 16) * 1024 + col0;
#pragma unroll
                for (int bj = 0; bj < 2; ++bj) { const f32x4 v0 = acc[ai][bj][m][0] * inv, v1 = acc[ai][bj][m][1] * inv;
                    u32x4 w; w.x = cvt_pk_bf16(v0[0], v0[1]); w.y = cvt_pk_bf16(v0[2], v0[3]); w.z = cvt_pk_bf16(v1[0], v1[1]); w.w = cvt_pk_bf16(v1[2], v1[3]);
                    *(u32x4*)(rowp + bj * HALF) = w; } }
    }
};
}

__device__ __forceinline__ int win_map(int n) {
    if (n < 1792) return n < 1664 ? n : -1;
    n -= 1792; if (n < 1280) return n < 1040 ? 2176 + n : -1;
    n -= 1280; if (n < 1024) return 3728 + n;
    n -= 1024; if (n < 512) return 5264 + n;
    n -= 512;
    if (n < 512) return 1664 + n;
    if (n < 1024) return 3216 + (n - 512);
    if (n < 1536) return 4752 + (n - 1024);
    if (n < 2048) return 5776 + (n - 1536);
    n -= 2048; return 6288 + n;
}
template <bool WIN>
__device__ __forceinline__ void conv_t(bf16_t* dst, const float* src, int ND, int K, int NS) {
    const size_t total = (size_t)ND * (K / 8);
    for (size_t i = (size_t)obid() * 512 + otid(); i < total; i += (size_t)gridDim.x * 512) {
        const int n = (int)(i % ND), ko = (int)(i / ND);
        const int ms = WIN ? win_map(n) : n;
        float v[8];
#pragma unroll
        for (int j = 0; j < 8; ++j) v[j] = ms >= 0 ? src[(size_t)(ko * 8 + j) * NS + ms] : 0.f;
        u32x4 w; w.x = cvt_pk_bf16(v[0], v[1]); w.y = cvt_pk_bf16(v[2], v[3]); w.z = cvt_pk_bf16(v[4], v[5]); w.w = cvt_pk_bf16(v[6], v[7]);
        *(u32x4*)(dst + (size_t)n * K + ko * 8) = w;
    }
}
__device__ __forceinline__ void rmsnorm_bf16(const float* src, const float* g, bf16_t* dst, int rows) {
    const int lane = otid() & 63, gw = obid() * 8 + (otid() >> 6), nw = gridDim.x * 8;
    for (int r = gw; r < rows; r += nw) {
        const float* p = src + (size_t)r * 1024; f32x4 v[4]; float ss = 0.f;
#pragma unroll
        for (int i = 0; i < 4; ++i) { v[i] = *(const f32x4*)(p + i * 256 + lane * 4); ss += v[i][0] * v[i][0] + v[i][1] * v[i][1] + v[i][2] * v[i][2] + v[i][3] * v[i][3]; }
        ss = wave_sum(ss, lane); const float rs = rsqrtf(ss * (1.0f / 1024.0f) + 1e-6f);
#pragma unroll
        for (int i = 0; i < 4; ++i) { const f32x4 gg = *(const f32x4*)(g + i * 256 + lane * 4);
            u32x2 w; w.x = cvt_pk_bf16(v[i][0] * rs * gg[0], v[i][1] * rs * gg[1]); w.y = cvt_pk_bf16(v[i][2] * rs * gg[2], v[i][3] * rs * gg[3]);
            *(u32x2*)(dst + (size_t)r * 1024 + i * 256 + lane * 4) = w; }
    }
}
__device__ __forceinline__ void rmsnorm_f32_inplace(float* buf, const float* g, int rows) {
    const int lane = otid() & 63, gw = obid() * 8 + (otid() >> 6), nw = gridDim.x * 8;
    for (int r = gw; r < rows; r += nw) {
        float* p = buf + (size_t)r * 1024; f32x4 v[4]; float ss = 0.f;
#pragma unroll
        for (int i = 0; i < 4; ++i) { v[i] = *(const f32x4*)(p + i * 256 + lane * 4); ss += v[i][0] * v[i][0] + v[i][1] * v[i][1] + v[i][2] * v[i][2] + v[i][3] * v[i][3]; }
        ss = wave_sum(ss, lane); const float rs = rsqrtf(ss * (1.0f / 1024.0f) + 1e-6f);
#pragma unroll
        for (int i = 0; i < 4; ++i) { const f32x4 gg = *(const f32x4*)(g + i * 256 + lane * 4); *(f32x4*)(p + i * 256 + lane * 4) = v[i] * rs * gg; }
    }
}

__device__ __forceinline__ void rwkv_prep(KP P, int l) {
    unsigned char* ws = P->ws;
    const int c = otid(), lane = c & 63, h = c >> 6;
    const float* w2 = (const float*)P->in[7] + (size_t)l * 64 * 512; const float* a2 = (const float*)P->in[9] + (size_t)l * 64 * 512;
    const float* mu = (const float*)P->in[5] + (size_t)l * 1664;
    float w2c[64], a2c[64];
#pragma unroll
    for (int j = 0; j < 64; ++j) { w2c[j] = w2[j * 512 + c]; a2c[j] = a2[j * 512 + c]; }
    const float mu_r = mu[c], mu_k = mu[512 + c], mu_v = mu[1024 + c], mu_w = mu[1536 + lane], mu_a = mu[1600 + lane];
    const float w0c = ((const float*)P->in[6])[l * 512 + c], a0c = ((const float*)P->in[8])[l * 512 + c];
    const float kkc = ((const float*)P->in[10])[l * 512 + c], kac = ((const float*)P->in[11])[l * 512 + c], rkc = ((const float*)P->in[12])[l * 512 + c];
    const bf16_t* Z = (const bf16_t*)(ws + OFF_ZRW);
    float* PW = (float*)(ws + OFF_PW); bf16_t* PKK = (bf16_t*)(ws + OFF_PKK); bf16_t* PB = (bf16_t*)(ws + OFF_PB); bf16_t* PKM = (bf16_t*)(ws + OFF_PKM); bf16_t* PR = (bf16_t*)(ws + OFF_PR);
    bf16_t* PV = (bf16_t*)(ws + OFF_PV); float* BON = (float*)(ws + OFF_BON);
    for (int rng = obid(); rng < TB / 64; rng += gridDim.x) {
        const int t0 = rng * 64;
        float pr = 0.f, pk = 0.f, pv = 0.f, pwl = 0.f, pal = 0.f;
        if (t0 > 0) { const bf16_t* z = Z + (size_t)(t0 - 1) * 1792; pr = bf2f(z[c]); pk = bf2f(z[512 + c]); pv = bf2f(z[1024 + c]); pwl = bf2f(z[1536 + lane]); pal = bf2f(z[1600 + lane]); }
        bf16_t nr, nk, nv, nwl, nal;
        { const bf16_t* z = Z + (size_t)t0 * 1792; nr = z[c]; nk = z[512 + c]; nv = z[1024 + c]; nwl = z[1536 + lane]; nal = z[1600 + lane]; }
        for (int t = t0; t < t0 + 64; ++t) {
            const float cr = bf2f(nr), ck = bf2f(nk), cv = bf2f(nv), cwl = bf2f(nwl), cal = bf2f(nal);
            { const bf16_t* z = Z + (size_t)(t + 1 < t0 + 64 ? t + 1 : t) * 1792; nr = z[c]; nk = z[512 + c]; nv = z[1024 + c]; nwl = z[1536 + lane]; nal = z[1600 + lane]; }
            const float rs = cr + (pr - cr) * mu_r, ks = ck + (pk - ck) * mu_k, vs = cv + (pv - cv) * mu_v;
            const float wl = tanhf_(cwl + (pwl - cwl) * mu_w), al = cal + (pal - cal) * mu_a;
            float accw = w0c, acca = a0c;
#pragma unroll
            for (int j = 0; j < 64; ++j) { accw += rlane(wl, j) * w2c[j]; acca += rlane(al, j) * a2c[j]; }
            const float logw = -softplusf_(-accw) - 0.5f;
            const float wdec = __expf(-__expf(logw));
            const float a = sigmoidf_(acca);
            const float kraw = ks * kkc;
            const float ss = wave_sum(kraw * kraw, lane);
            const float kk = kraw / fmaxf(sqrtf(ss), 1e-12f);
            const float km = ks * (1.0f + (a - 1.0f) * kac);
            const float bb = kk * a;
            const float bon = wave_sum(rs * km * rkc, lane);
            const size_t o = (size_t)t * 512 + c;
            PW[o] = wdec; PKK[o] = f2bf(kk); PB[o] = f2bf(bb); PKM[o] = f2bf(km); PR[o] = f2bf(rs); PV[o] = f2bf(vs);
            if (lane == 0) BON[(size_t)t * 8 + h] = bon;
            pr = cr; pk = ck; pv = cv; pwl = cwl; pal = cal;
        }
    }
}
typedef float f32x2 __attribute__((ext_vector_type(2)));
template <int CTRL, int RM> __device__ __forceinline__ float dppf(float x) { return __int_as_float(__builtin_amdgcn_update_dpp(0, __float_as_int(x), CTRL, RM, 0xf, false)); }
__device__ __forceinline__ float red8(float x) { x += dppf<0xB1, 0xf>(x); x += dppf<0x4E, 0xf>(x); x += dppf<0x141, 0xf>(x); return x; }
__device__ __forceinline__ float wave_total_from_groups(float x) {
    x += dppf<0x128, 0xf>(x);
    x += dppf<0x142, 0xa>(x);
    x += dppf<0x143, 0xc>(x);
    return rlane(x, 63); }
struct RwVec { f32x4 w[2]; u32x4 kk, b, km, r, v; };
template <bool NEED_KM, bool NEED_R>
__device__ __forceinline__ RwVec rw_load(const unsigned char* ws, size_t okv, size_t ov) {
    RwVec q;
    const float* PW = (const float*)(ws + OFF_PW) + okv;
    q.w[0] = *(const f32x4*)PW; q.w[1] = *(const f32x4*)(PW + 4);
    q.kk = *(const u32x4*)((const bf16_t*)(ws + OFF_PKK) + okv); q.b = *(const u32x4*)((const bf16_t*)(ws + OFF_PB) + okv);
    if (NEED_KM) { q.km = *(const u32x4*)((const bf16_t*)(ws + OFF_PKM) + okv); q.v = *(const u32x4*)((const bf16_t*)(ws + OFF_PV) + ov); }
    if (NEED_R) q.r = *(const u32x4*)((const bf16_t*)(ws + OFF_PR) + okv);
    return q;
}
#define RW_PAIR(vec, q) ((f32x2){(vec)[(q) >> 1][((q) & 1) * 2], (vec)[(q) >> 1][((q) & 1) * 2 + 1]})
#define RW_PAIRH(u, q) ((f32x2){__uint_as_float((u)[q] << 16), __uint_as_float((u)[q] & 0xffff0000u)})
template <int MODE>
__device__ __forceinline__ void rw_step(f32x2 (&s)[8][4], const RwVec& q) {
    float sa[8];
    { f32x2 kk2[4];
#pragma unroll
      for (int p = 0; p < 4; ++p) kk2[p] = RW_PAIRH(q.kk, p);
#pragma unroll
      for (int vi = 0; vi < 8; ++vi) { f32x2 a = s[vi][0] * kk2[0];
#pragma unroll
        for (int p = 1; p < 4; ++p) a += s[vi][p] * kk2[p];
        sa[vi] = -red8(a.x + a.y); } }
    f32x2 b2[4], km2[4];
#pragma unroll
    for (int p = 0; p < 4; ++p) { b2[p] = RW_PAIRH(q.b, p); km2[p] = MODE ? RW_PAIRH(q.km, p) : (f32x2){0.f, 0.f}; }
#pragma unroll
    for (int vi = 0; vi < 8; ++vi) {
        const float vv = MODE ? __uint_as_float((vi & 1) ? (q.v[vi >> 1] & 0xffff0000u) : (q.v[vi >> 1] << 16)) : 0.f;
        const f32x2 sa2 = {sa[vi], sa[vi]}, vv2 = {vv, vv};
#pragma unroll
        for (int p = 0; p < 4; ++p) { f32x2 t = sa2 * b2[p]; if (MODE) t += vv2 * km2[p];
            s[vi][p] = s[vi][p] * RW_PAIR(q.w, p) + t; } }
}
template <int MODE>
__device__ __forceinline__ void rwkv_pass1_part(const unsigned char* ws, int wv, int lane) {
    const int vg = lane >> 3, kg = lane & 7;
    for (int u = obid() * 4 + wv; u < 8 * NCH; u += gridDim.x * 4) {
        const int c = u >> 3, h = u & 7;
        f32x2 s[8][4];
#pragma unroll
        for (int vi = 0; vi < 8; ++vi)
#pragma unroll
            for (int p = 0; p < 4; ++p) { s[vi][p].x = (!MODE && vg == kg && vi == 2 * p) ? 1.f : 0.f; s[vi][p].y = (!MODE && vg == kg && vi == 2 * p + 1) ? 1.f : 0.f; }
        const size_t o0 = (size_t)c * LCH * 512 + h * 64, okv = o0 + kg * 8, ov = o0 + vg * 8;
        RwVec A = rw_load<MODE != 0, false>(ws, okv, ov), B = rw_load<MODE != 0, false>(ws, okv + 512, ov + 512), C;
        int i = 0;
        for (; i + 3 <= LCH; i += 3) {
            { const size_t d = (size_t)(i + 2 < LCH ? i + 2 : LCH - 1) * 512; C = rw_load<MODE != 0, false>(ws, okv + d, ov + d); }
            rw_step<MODE>(s, A);
            { const size_t d = (size_t)(i + 3 < LCH ? i + 3 : LCH - 1) * 512; A = rw_load<MODE != 0, false>(ws, okv + d, ov + d); }
            rw_step<MODE>(s, B);
            { const size_t d = (size_t)(i + 4 < LCH ? i + 4 : LCH - 1) * 512; B = rw_load<MODE != 0, false>(ws, okv + d, ov + d); }
            rw_step<MODE>(s, C);
        }
        if (i < LCH) rw_step<MODE>(s, A);
        if (i + 1 < LCH) rw_step<MODE>(s, B);
        if (!MODE) {
            bf16_t* pp = (bf16_t*)(const_cast<unsigned char*>(ws) + OFF_PP) + (size_t)(h * NCH + c) * 4096 + vg * 8;
#pragma unroll
            for (int ki = 0; ki < 8; ++ki) { u32x4 w4;
#pragma unroll
                for (int e = 0; e < 4; ++e) { const float lo = (ki & 1) ? s[2 * e][ki >> 1].y : s[2 * e][ki >> 1].x, hi = (ki & 1) ? s[2 * e + 1][ki >> 1].y : s[2 * e + 1][ki >> 1].x; w4[e] = cvt_pk_bf16(lo, hi); }
                *(u32x4*)(pp + (kg * 8 + ki) * 64) = w4; }
        } else {
            float* pl = (float*)(const_cast<unsigned char*>(ws) + OFF_PL) + (size_t)(h * NCH + c) * 4096 + kg * 8;
#pragma unroll
            for (int vi = 0; vi < 8; ++vi) { *(f32x4*)(pl + (vg * 8 + vi) * 64) = (f32x4){s[vi][0].x, s[vi][0].y, s[vi][1].x, s[vi][1].y}; *(f32x4*)(pl + (vg * 8 + vi) * 64 + 4) = (f32x4){s[vi][2].x, s[vi][2].y, s[vi][3].x, s[vi][3].y}; }
        }
    }
}
__device__ __forceinline__ void rwkv_pass1(KP P) {
    const unsigned char* ws = P->ws;
    const int wave = otid() >> 6, lane = otid() & 63;
    if (wave < 4) rwkv_pass1_part<0>(ws, wave, lane); else rwkv_pass1_part<1>(ws, wave - 4, lane);
}
__device__ __forceinline__ void rwkv_cscan(KP P, unsigned char* sm) {
    unsigned char* ws = P->ws;
    bf16_t* Sb = (bf16_t*)sm;
    const int tid = otid(), wave = tid >> 6, lane = tid & 63, nt = wave & 3, mt0 = (wave >> 2) * 2, lr = lane & 15, lq = lane >> 4;
    const bf16_t* PPT = (const bf16_t*)(ws + OFF_PP); float* PL = (float*)(ws + OFF_PL);
    for (int h = obid(); h < 8; h += gridDim.x) {
        for (int i = tid; i < 64 * 72 / 2; i += 512) ((unsigned*)Sb)[i] = 0u;
        f32x4 mine[2] = {(f32x4){0.f, 0.f, 0.f, 0.f}, (f32x4){0.f, 0.f, 0.f, 0.f}};
        bf16x8 bfr[2]; f32x4 lv[2];
        { const size_t base = (size_t)(h * NCH) * 4096;
#pragma unroll
          for (int ks = 0; ks < 2; ++ks) bfr[ks] = *(const bf16x8*)(PPT + base + (nt * 16 + lr) * 64 + ks * 32 + lq * 8);
#pragma unroll
          for (int i = 0; i < 2; ++i)
#pragma unroll
              for (int q = 0; q < 4; ++q) lv[i][q] = PL[base + ((mt0 + i) * 16 + lq * 4 + q) * 64 + nt * 16 + lr]; }
        __syncthreads();
        for (int c = 0; c < NCH; ++c) {
            const size_t base = (size_t)(h * NCH + c) * 4096, basen = (size_t)(h * NCH + (c + 1 < NCH ? c + 1 : c)) * 4096;
            bf16x8 nbfr[2]; f32x4 nlv[2];
#pragma unroll
            for (int ks = 0; ks < 2; ++ks) nbfr[ks] = *(const bf16x8*)(PPT + basen + (nt * 16 + lr) * 64 + ks * 32 + lq * 8);
#pragma unroll
            for (int i = 0; i < 2; ++i)
#pragma unroll
                for (int q = 0; q < 4; ++q) nlv[i][q] = PL[basen + ((mt0 + i) * 16 + lq * 4 + q) * 64 + nt * 16 + lr];
            f32x4 acc[2] = {lv[0], lv[1]};
#pragma unroll
            for (int ks = 0; ks < 2; ++ks)
#pragma unroll
                for (int i = 0; i < 2; ++i) { const bf16x8 af = *(const bf16x8*)(Sb + ((mt0 + i) * 16 + lr) * 72 + ks * 32 + lq * 8);
                    acc[i] = __builtin_amdgcn_mfma_f32_16x16x32_bf16(af, bfr[ks], acc[i], 0, 0, 0); }
            if (c + 1 < NCH || true) {
#pragma unroll
                for (int i = 0; i < 2; ++i)
#pragma unroll
                    for (int q = 0; q < 4; ++q) PL[base + ((mt0 + i) * 16 + lq * 4 + q) * 64 + nt * 16 + lr] = mine[i][q]; }
            mine[0] = acc[0]; mine[1] = acc[1];
            __syncthreads();
#pragma unroll
            for (int i = 0; i < 2; ++i)
#pragma unroll
                for (int q = 0; q < 4; ++q) Sb[((mt0 + i) * 16 + lq * 4 + q) * 72 + nt * 16 + lr] = f2bf(acc[i][q]);
            __syncthreads();
            bfr[0] = nbfr[0]; bfr[1] = nbfr[1]; lv[0] = nlv[0]; lv[1] = nlv[1];
        }
    }
}
__device__ __forceinline__ void rw_out(f32x2 (&s)[8][4], const RwVec& q, int lane, int kg, int t, int h, float lng, float lnb, const unsigned char* ws) {
    float y[8]; float s1 = 0.f, s2 = 0.f;
    f32x2 r2[4];
#pragma unroll
    for (int p = 0; p < 4; ++p) r2[p] = RW_PAIRH(q.r, p);
#pragma unroll
    for (int vi = 0; vi < 8; ++vi) { f32x2 a = s[vi][0] * r2[0];
#pragma unroll
        for (int p = 1; p < 4; ++p) a += s[vi][p] * r2[p];
        y[vi] = red8(a.x + a.y); s1 += y[vi]; s2 += y[vi] * y[vi]; }
    const float mean = wave_total_from_groups(s1) * (1.0f / 64.0f);
    const float var = fmaxf(wave_total_from_groups(s2) * (1.0f / 64.0f) - mean * mean, 0.f);
    float yo = y[0];
#pragma unroll
    for (int vi = 1; vi < 8; ++vi) yo = (kg == vi) ? y[vi] : yo;
    const int col = h * 64 + lane;
    bf16_t* zg = (bf16_t*)(const_cast<unsigned char*>(ws) + OFF_ZG) + (size_t)t * 2048 + col;
    const float gg = bf2f(*zg), vv = bf2f(((const bf16_t*)(ws + OFF_PV))[(size_t)t * 512 + col]), bon = ((const float*)(ws + OFF_BON))[(size_t)t * 8 + h];
    const float yn = (yo - mean) * rsqrtf(var + 64e-5f) * lng + lnb + bon * vv;
    *zg = f2bf(yn * siluf_(gg));
}
__device__ __forceinline__ void rwkv_pass2(KP P, int l) {
    const unsigned char* ws = P->ws;
    const int wave = otid() >> 6, lane = otid() & 63, vg = lane >> 3, kg = lane & 7;
    if (wave >= 4) return;
    for (int u = obid() * 4 + wave; u < 8 * NCH; u += gridDim.x * 4) {
        const int c = u >> 3, h = u & 7;
        const float lng = ((const float*)P->in[13])[l * 512 + h * 64 + lane], lnb = ((const float*)P->in[14])[l * 512 + h * 64 + lane];
        f32x2 s[8][4];
        { const float* pl = (const float*)(ws + OFF_PL) + (size_t)(h * NCH + c) * 4096 + kg * 8;
#pragma unroll
          for (int vi = 0; vi < 8; ++vi) { const f32x4 a = *(const f32x4*)(pl + (vg * 8 + vi) * 64), b = *(const f32x4*)(pl + (vg * 8 + vi) * 64 + 4);
              s[vi][0] = (f32x2){a[0], a[1]}; s[vi][1] = (f32x2){a[2], a[3]}; s[vi][2] = (f32x2){b[0], b[1]}; s[vi][3] = (f32x2){b[2], b[3]}; } }
        const int t0 = c * LCH;
        const size_t o0 = (size_t)t0 * 512 + h * 64, okv = o0 + kg * 8, ov = o0 + vg * 8;
        RwVec A = rw_load<true, true>(ws, okv, ov), B = rw_load<true, true>(ws, okv + 512, ov + 512), C;
        int i = 0;
        for (; i + 3 <= LCH; i += 3) {
            { const size_t d = (size_t)(i + 2 < LCH ? i + 2 : LCH - 1) * 512; C = rw_load<true, true>(ws, okv + d, ov + d); }
            rw_step<1>(s, A); rw_out(s, A, lane, kg, t0 + i, h, lng, lnb, ws);
            { const size_t d = (size_t)(i + 3 < LCH ? i + 3 : LCH - 1) * 512; A = rw_load<true, true>(ws, okv + d, ov + d); }
            rw_step<1>(s, B); rw_out(s, B, lane, kg, t0 + i + 1, h, lng, lnb, ws);
            { const size_t d = (size_t)(i + 4 < LCH ? i + 4 : LCH - 1) * 512; B = rw_load<true, true>(ws, okv + d, ov + d); }
            rw_step<1>(s, C); rw_out(s, C, lane, kg, t0 + i + 2, h, lng, lnb, ws);
        }
        if (i < LCH) { rw_step<1>(s, A); rw_out(s, A, lane, kg, t0 + i, h, lng, lnb, ws); }
        if (i + 1 < LCH) { rw_step<1>(s, B); rw_out(s, B, lane, kg, t0 + i + 1, h, lng, lnb, ws); }
    }
}

__device__ __forceinline__ void rope_cs(int i, float posf, float& cs, float& sn) {
    const float inv = (float)exp2(-(double)i * (13.287712379549449 / 32.0));
    const float ang = posf * inv;
    const double a = (double)ang; const double kq = rint(a * 0.15915494309189535); const float r = (float)(a - kq * 6.283185307179586);
    cs = __cosf(r); sn = __sinf(r);
}
__device__ __forceinline__ void gr_stage_b(KP P, int l, int kind, int n, int h, float* Bm) {
    const int tid = otid(), t = tid >> 3, dg = tid & 7;
    if (kind == 0) {
        const bf16_t* zr = (const bf16_t*)(P->ws + OFF_ZGLA) + (size_t)(n * 64 + t) * 1280 + 1024;
        float fl[16];
        const u32x4 q0 = *(const u32x4*)zr, q1 = *(const u32x4*)(zr + 8);
#pragma unroll
        for (int e = 0; e < 4; ++e) { fl[2 * e] = __uint_as_float(q0[e] << 16); fl[2 * e + 1] = __uint_as_float(q0[e] & 0xffff0000u); fl[8 + 2 * e] = __uint_as_float(q1[e] << 16); fl[8 + 2 * e + 1] = __uint_as_float(q1[e] & 0xffff0000u); }
        const float* fup = (const float*)P->in[15] + (size_t)l * 16 * 256; const float* fb = (const float*)P->in[16] + (size_t)l * 256;
#pragma unroll
        for (int dd = 0; dd < 8; ++dd) { const int d = dg * 8 + dd; float x = fb[h * 64 + d];
#pragma unroll
            for (int j = 0; j < 16; ++j) x += fl[j] * fup[j * 256 + h * 64 + d];
            Bm[t * 64 + d] = -softplusf_(-x) * (1.0f / 16.0f); }
    } else {
        const float lg = __logf(1.0f - exp2f(-5.0f - (float)h));
#pragma unroll
        for (int dd = 0; dd < 8; ++dd) Bm[t * 64 + dg * 8 + dd] = lg;
    }
    __syncthreads();
    if (tid < 64) { float run = 0.f; for (int tt = 0; tt < 64; ++tt) { run += Bm[tt * 64 + tid]; Bm[tt * 64 + tid] = run; } }
    __syncthreads();
}
__device__ __forceinline__ float gr_qk(KP P, int b, int kind, int which, int tg, int h, int d) {
    if (kind == 0) { const bf16_t* z = (const bf16_t*)(P->ws + OFF_ZGLA) + (size_t)tg * 1280 + which * 256 + h * 64; return bf2f(z[d]); }
    const bf16_t* z = (const bf16_t*)(P->ws + OFF_ZRET) + (size_t)tg * 1024 + which * 256 + h * 64;
    const int i = d & 31; const float x1 = bf2f(z[i]), x2 = bf2f(z[i + 32]);
    const float posf = (float)((const int*)P->in[2])[(size_t)b * TB + tg];
    float cs, sn; rope_cs(i, posf, cs, sn);
    return d < 32 ? x1 * cs - x2 * sn : x1 * sn + x2 * cs;
}
__device__ __forceinline__ const bf16_t* gr_vptr(KP P, int kind, int tg, int h) {
    return kind == 0 ? (const bf16_t*)(P->ws + OFF_ZGLA) + (size_t)tg * 1280 + 512 + h * 128 : (const bf16_t*)(P->ws + OFF_ZRET) + (size_t)tg * 1024 + 512 + h * 128;
}
__device__ __forceinline__ void gr_ds(KP P, int l, int b, unsigned char* sm) {
    float* Bm = (float*)sm; bf16_t* KET = (bf16_t*)(sm + 16384); bf16_t* VT = (bf16_t*)(sm + 25600);
    const int tid = otid(), t = tid >> 3, dg = tid & 7, wave = tid >> 6, lane = tid & 63;
    float* DS = (float*)(P->ws + OFF_DSG); float* DEC = (float*)(P->ws + OFF_DEC);
    for (int idx = obid(); idx < 2048; idx += gridDim.x) {
        const int kind = idx >> 10, n = (idx >> 2) & 255, h = idx & 3, tg = n * 64 + t;
        gr_stage_b(P, l, kind, n, h, Bm);
#pragma unroll
        for (int dd = 0; dd < 8; ++dd) { const int d = dg * 8 + dd; const float bl = Bm[63 * 64 + d], bt = Bm[t * 64 + d];
            float kv = gr_qk(P, b, kind, 1, tg, h, d); if (kind == 1) kv *= 0.125f;
            KET[d * 72 + t] = f2bf(kv * __expf(bl - bt));
            if (t == 63 && kind == 0) DEC[(size_t)(n * 4 + h) * 64 + d] = __expf(bl); }
        { const bf16_t* vp = gr_vptr(P, kind, tg, h) + dg * 16;
#pragma unroll
            for (int e = 0; e < 16; ++e) VT[(dg * 16 + e) * 72 + t] = vp[e]; }
        __syncthreads();
        f32x4 acc[4];
#pragma unroll
        for (int mt = 0; mt < 4; ++mt) acc[mt] = (f32x4){0.f, 0.f, 0.f, 0.f};
#pragma unroll
        for (int ks = 0; ks < 2; ++ks) { const bf16x8 bf = *(const bf16x8*)(VT + (wave * 16 + (lane & 15)) * 72 + ks * 32 + (lane >> 4) * 8);
#pragma unroll
            for (int mt = 0; mt < 4; ++mt) { const bf16x8 af = *(const bf16x8*)(KET + (mt * 16 + (lane & 15)) * 72 + ks * 32 + (lane >> 4) * 8);
                acc[mt] = __builtin_amdgcn_mfma_f32_16x16x32_bf16(af, bf, acc[mt], 0, 0, 0); } }
        float* dsp = DS + ((size_t)(kind * 256 + n) * 4 + h) * 64 * 128;
#pragma unroll
        for (int mt = 0; mt < 4; ++mt)
#pragma unroll
            for (int j = 0; j < 4; ++j) dsp[(size_t)(mt * 16 + (lane >> 4) * 4 + j) * 128 + wave * 16 + (lane & 15)] = acc[mt][j];
        __syncthreads();
    }
}
__device__ __forceinline__ void gr_scan(KP P) {
    float* DS = (float*)(P->ws + OFF_DSG); const float* DEC = (const float*)(P->ws + OFF_DEC);
    for (int blk = obid(); blk < 129; blk += gridDim.x) {
        if (blk < 128) {
            const int gid = blk * 512 + otid(), kind = gid >> 15, e = gid & 32767, h = e >> 13, d = (e >> 7) & 63, vch = e & 127;
            const float rdec = __expf(64.0f * __logf(1.0f - exp2f(-5.0f - (float)h)));
            float st = 0.f;
            for (int n0 = 0; n0 < 256; n0 += 8) {
                float dsv[8], dc[8];
#pragma unroll
                for (int q = 0; q < 8; ++q) { const int n = n0 + q; dsv[q] = DS[(((size_t)(kind * 256 + n) * 4 + h) * 64 + d) * 128 + vch]; dc[q] = kind == 0 ? DEC[(size_t)(n * 4 + h) * 64 + d] : rdec; }
#pragma unroll
                for (int q = 0; q < 8; ++q) { const int n = n0 + q; DS[(((size_t)(kind * 256 + n) * 4 + h) * 64 + d) * 128 + vch] = st; st = st * dc[q] + dsv[q]; }
            }
        } else {
            const float* AC = (const float*)(P->ws + OFF_AC); const float* HC = (const float*)(P->ws + OFF_HC); float* HIN = (float*)(P->ws + OFF_HIN);
            const int d = otid(); float hin = 0.f;
            for (int n = 0; n < 256; ++n) { HIN[n * 512 + d] = hin; hin = AC[n * 512 + d] * hin + HC[n * 512 + d]; }
        }
    }
}
__device__ __forceinline__ void gr_out(KP P, int l, int b, unsigned char* sm) {
    float* Bm = (float*)sm; bf16_t* QD = (bf16_t*)(sm + 16384); bf16_t* KD = (bf16_t*)(sm + 25600); bf16_t* ATT = (bf16_t*)(sm + 34816);
    bf16_t* VT = (bf16_t*)(sm + 44032); bf16_t* ST = (bf16_t*)(sm + 62464); float* O = (float*)(sm + 80896);
    const int tid = otid(), t = tid >> 3, dg = tid & 7, wave = tid >> 6, lane = tid & 63;
    const float* DS = (const float*)(P->ws + OFF_DSG); bf16_t* ZG = (bf16_t*)(P->ws + OFF_ZG);
    for (int idx = obid(); idx < 2048; idx += gridDim.x) {
        const int kind = idx >> 10, n = (idx >> 2) & 255, h = idx & 3, tg = n * 64 + t;
        gr_stage_b(P, l, kind, n, h, Bm);
#pragma unroll
        for (int dd = 0; dd < 8; ++dd) { const int d = dg * 8 + dd; const float bt = Bm[t * 64 + d];
            float qv = gr_qk(P, b, kind, 0, tg, h, d), kv = gr_qk(P, b, kind, 1, tg, h, d);
            if (kind == 0) qv *= 0.125f; else kv *= 0.125f;
            QD[t * 72 + d] = f2bf(qv * __expf(bt)); KD[t * 72 + d] = f2bf(kv * __expf(-bt)); }
        { const bf16_t* vp = gr_vptr(P, kind, tg, h) + dg * 16;
#pragma unroll
            for (int e = 0; e < 16; ++e) VT[(dg * 16 + e) * 72 + t] = vp[e]; }
        { const float* dsp = DS + ((size_t)(kind * 256 + n) * 4 + h) * 64 * 128;
#pragma unroll
            for (int i = 0; i < 16; ++i) { const int e = tid + i * 512, d = e >> 7, vch = e & 127; ST[vch * 72 + d] = f2bf(dsp[e]); } }
        __syncthreads();
        {
            const int nt = wave & 3, mt0 = (wave >> 2) * 2;
            f32x4 a2[2] = {(f32x4){0.f, 0.f, 0.f, 0.f}, (f32x4){0.f, 0.f, 0.f, 0.f}};
#pragma unroll
            for (int ks = 0; ks < 2; ++ks) { const bf16x8 bf = *(const bf16x8*)(KD + (nt * 16 + (lane & 15)) * 72 + ks * 32 + (lane >> 4) * 8);
#pragma unroll
                for (int i = 0; i < 2; ++i) { const bf16x8 af = *(const bf16x8*)(QD + ((mt0 + i) * 16 + (lane & 15)) * 72 + ks * 32 + (lane >> 4) * 8);
                    a2[i] = __builtin_amdgcn_mfma_f32_16x16x32_bf16(af, bf, a2[i], 0, 0, 0); } }
#pragma unroll
            for (int i = 0; i < 2; ++i)
#pragma unroll
                for (int j = 0; j < 4; ++j) { const int tt = (mt0 + i) * 16 + (lane >> 4) * 4 + j, ss = nt * 16 + (lane & 15);
                    ATT[tt * 72 + ss] = f2bf(ss <= tt ? a2[i][j] : 0.f); }
        }
        __syncthreads();
        {
            f32x4 acc[4];
#pragma unroll
            for (int mt = 0; mt < 4; ++mt) acc[mt] = (f32x4){0.f, 0.f, 0.f, 0.f};
#pragma unroll
            for (int ks = 0; ks < 2; ++ks) {
                const bf16x8 b1 = *(const bf16x8*)(VT + (wave * 16 + (lane & 15)) * 72 + ks * 32 + (lane >> 4) * 8);
                const bf16x8 b2 = *(const bf16x8*)(ST + (wave * 16 + (lane & 15)) * 72 + ks * 32 + (lane >> 4) * 8);
#pragma unroll
                for (int mt = 0; mt < 4; ++mt) {
                    const bf16x8 a1 = *(const bf16x8*)(ATT + (mt * 16 + (lane & 15)) * 72 + ks * 32 + (lane >> 4) * 8);
                    const bf16x8 aq = *(const bf16x8*)(QD + (mt * 16 + (lane & 15)) * 72 + ks * 32 + (lane >> 4) * 8);
                    acc[mt] = __builtin_amdgcn_mfma_f32_16x16x32_bf16(a1, b1, acc[mt], 0, 0, 0);
                    acc[mt] = __builtin_amdgcn_mfma_f32_16x16x32_bf16(aq, b2, acc[mt], 0, 0, 0); } }
#pragma unroll
            for (int mt = 0; mt < 4; ++mt)
#pragma unroll
                for (int j = 0; j < 4; ++j) O[(mt * 16 + (lane >> 4) * 4 + j) * 132 + wave * 16 + (lane & 15)] = acc[mt][j];
        }
        __syncthreads();
        {
            float v[16]; float s1 = 0.f, s2 = 0.f;
#pragma unroll
            for (int e = 0; e < 16; ++e) { v[e] = O[t * 132 + dg * 16 + e]; s1 += v[e]; s2 += v[e] * v[e]; }
#pragma unroll
            for (int o = 1; o <= 4; o <<= 1) { s1 += shx(s1, lane, o); s2 += shx(s2, lane, o); }
            float mean = 0.f, rs;
            if (kind == 0) rs = rsqrtf(s2 * (1.0f / 128.0f) + 1e-6f);
            else { mean = s1 * (1.0f / 128.0f); const float var = fmaxf(s2 * (1.0f / 128.0f) - mean * mean, 0.f); rs = rsqrtf(var + 1e-6f); }
            const float* gn = (kind == 0 ? (const float*)P->in[17] : (const float*)P->in[18]) + (size_t)l * 512 + h * 128 + dg * 16;
            bf16_t* gp = ZG + (size_t)tg * 2048 + (kind == 0 ? 512 : 1024) + h * 128 + dg * 16;
            const u32x4 g0 = *(const u32x4*)gp, g1 = *(const u32x4*)(gp + 8);
            float gv[16];
#pragma unroll
            for (int e = 0; e < 4; ++e) { gv[2 * e] = __uint_as_float(g0[e] << 16); gv[2 * e + 1] = __uint_as_float(g0[e] & 0xffff0000u); gv[8 + 2 * e] = __uint_as_float(g1[e] << 16); gv[8 + 2 * e + 1] = __uint_as_float(g1[e] & 0xffff0000u); }
            float r[16];
#pragma unroll
            for (int e = 0; e < 16; ++e) r[e] = (v[e] - mean) * rs * gn[e] * siluf_(gv[e]);
            u32x4 w0, w1;
            w0.x = cvt_pk_bf16(r[0], r[1]); w0.y = cvt_pk_bf16(r[2], r[3]); w0.z = cvt_pk_bf16(r[4], r[5]); w0.w = cvt_pk_bf16(r[6], r[7]);
            w1.x = cvt_pk_bf16(r[8], r[9]); w1.y = cvt_pk_bf16(r[10], r[11]); w1.z = cvt_pk_bf16(r[12], r[13]); w1.w = cvt_pk_bf16(r[14], r[15]);
            *(u32x4*)gp = w0; *(u32x4*)(gp + 8) = w1;
        }
        __syncthreads();
    }
}

__device__ __forceinline__ void lru_p1(KP P, int l) {
    unsigned char* ws = P->ws;
    const int d = otid(), lane = d & 63, blk = d >> 6;
    const float* wa = (const float*)P->in[21] + ((size_t)l * 8 + blk) * 4096; const float* wx = (const float*)P->in[23] + ((size_t)l * 8 + blk) * 4096;
    float wac[64], wxc[64];
#pragma unroll
    for (int c = 0; c < 64; ++c) { wac[c] = wa[c * 64 + lane]; wxc[c] = wx[c * 64 + lane]; }
    const float* cwp = (const float*)P->in[19] + (size_t)l * 4 * 512;
    const float cw0 = cwp[d], cw1 = cwp[512 + d], cw2 = cwp[1024 + d], cw3 = cwp[1536 + d], cb = ((const float*)P->in[20])[l * 512 + d];
    const float ba = ((const float*)P->in[22])[l * 512 + d], bx = ((const float*)P->in[24])[l * 512 + d];
    const float sp = softplusf_(-((const float*)P->in[25])[l * 512 + d]);
    const bf16_t* X = (const bf16_t*)(ws + OFF_ZLRU);
    float* HL = (float*)(ws + OFF_HL); float* CA = (float*)(ws + OFF_CA); float* AC = (float*)(ws + OFF_AC); float* HC = (float*)(ws + OFF_HC);
    for (int n = obid(); n < 256; n += gridDim.x) {
        const int t0 = n * 64;
        float x1 = 0.f, x2 = 0.f, x3 = 0.f;
        if (t0 > 0) { x1 = bf2f(X[(size_t)(t0 - 1) * 512 + d]); x2 = bf2f(X[(size_t)(t0 - 2) * 512 + d]); x3 = bf2f(X[(size_t)(t0 - 3) * 512 + d]); }
        float hloc = 0.f, cum = 1.f;
        bf16_t xa[16], xb[16];
#pragma unroll
        for (int q = 0; q < 16; ++q) xa[q] = X[(size_t)(t0 + q) * 512 + d];
        for (int tg = 0; tg < 4; ++tg) {
#pragma unroll
          for (int q = 0; q < 16; ++q) xb[q] = X[(size_t)(t0 + (tg < 3 ? tg + 1 : tg) * 16 + q) * 512 + d];
#pragma unroll
          for (int q = 0; q < 16; ++q) {
            const int t = t0 + tg * 16 + q;
            const float x0 = bf2f(xa[q]);
            const float xc = x3 * cw0 + x2 * cw1 + x1 * cw2 + x0 * cw3 + cb;
            float ra = ba, ri = bx;
#pragma unroll
            for (int c = 0; c < 64; ++c) { const float xv = rlane(xc, c); ra += xv * wac[c]; ri += xv * wxc[c]; }
            const float r = sigmoidf_(ra), ig = sigmoidf_(ri);
            const float la = -8.0f * r * sp; const float a = __expf(la);
            const float x2l = 2.0f * la;
            const float om = x2l > -0.02f ? -(x2l * (1.0f + x2l * (0.5f + x2l * (1.0f / 6.0f)))) : 1.0f - __expf(x2l);
            const float uu = sqrtf(fmaxf(om, 0.f)) * (ig * xc);
            hloc = a * hloc + uu; cum *= a;
            HL[(size_t)t * 512 + d] = hloc; CA[(size_t)t * 512 + d] = cum;
            x3 = x2; x2 = x1; x1 = x0;
          }
#pragma unroll
          for (int q = 0; q < 16; ++q) xa[q] = xb[q];
        }
        AC[n * 512 + d] = cum; HC[n * 512 + d] = hloc;
    }
}
__device__ __forceinline__ void lru_p3(KP P) {
    unsigned char* ws = P->ws;
    const float* HL = (const float*)(ws + OFF_HL); const float* CA = (const float*)(ws + OFF_CA); const float* HIN = (const float*)(ws + OFF_HIN);
    bf16_t* ZG = (bf16_t*)(ws + OFF_ZG);
    const size_t total = (size_t)TB * 128;
    for (size_t i = (size_t)obid() * 512 + otid(); i < total; i += (size_t)gridDim.x * 512) {
        const int t = (int)(i >> 7), d4 = (int)(i & 127) * 4;
        const f32x4 hl = *(const f32x4*)(HL + (size_t)t * 512 + d4), ca = *(const f32x4*)(CA + (size_t)t * 512 + d4), hi = *(const f32x4*)(HIN + (size_t)(t >> 6) * 512 + d4);
        bf16_t* gp = ZG + (size_t)t * 2048 + 1536 + d4;
        const u32x2 gq = *(const u32x2*)gp;
        const float g0 = __uint_as_float(gq.x << 16), g1 = __uint_as_float(gq.x & 0xffff0000u), g2 = __uint_as_float(gq.y << 16), g3 = __uint_as_float(gq.y & 0xffff0000u);
        u32x2 w; w.x = cvt_pk_bf16((hl[0] + ca[0] * hi[0]) * siluf_(g0), (hl[1] + ca[1] * hi[1]) * siluf_(g1));
        w.y = cvt_pk_bf16((hl[2] + ca[2] * hi[2]) * siluf_(g2), (hl[3] + ca[3] * hi[3]) * siluf_(g3));
        *(u32x2*)gp = w;
    }
}

#define XB_TMO      128
#define XB_XCNT(j)  (256  + 64 * (j))
#define XB_XSUB(j)  (1280 + 64 * (j))
#define XB_XGEN(j)  (2304 + 64 * (j))
#define XB_TOP      3328
#define XB_TOPGEN   3392
#define XCD_BAR_WORDS 3456
#define XB_SPIN_CAP (1u << 22)
__device__ __forceinline__ unsigned xb_ld(unsigned* p)              { return __hip_atomic_load(p, __ATOMIC_RELAXED, __HIP_MEMORY_SCOPE_AGENT); }
__device__ __forceinline__ unsigned xb_add(unsigned* p, unsigned v) { return __hip_atomic_fetch_add(p, v, __ATOMIC_RELAXED, __HIP_MEMORY_SCOPE_AGENT); }
__device__ __forceinline__ unsigned xb_xcc_id() { return (unsigned)__builtin_amdgcn_s_getreg((3 << 11) | 20) & 0xFu; }
#define XB_SPIN(cond, bar) do { unsigned _sp = 0; while (cond) { __builtin_amdgcn_s_sleep(1); \
    if ((++_sp & 255u) == 0u) { if (xb_ld(&(bar)[XB_TMO])) break; if (_sp > XB_SPIN_CAP) { atomicAdd(&(bar)[XB_TMO], 1u); break; } } } } while (0)
struct XcdBarrier { unsigned* bar; unsigned x; volatile LAS unsigned* st; };
__device__ __forceinline__ XcdBarrier xcd_barrier_post(unsigned* bar, volatile LAS unsigned* st) {
    XcdBarrier b; b.bar = bar; b.x = xb_xcc_id(); b.st = st;
    if (threadIdx.x == 0) (void)xb_add(&bar[XB_XCNT(b.x)], 1u);
    return b;
}
__device__ __forceinline__ void xcd_barrier_complete(unsigned* bar, unsigned x, unsigned& nloc, unsigned& nx) {
    const unsigned G = gridDim.x * gridDim.y * gridDim.z;
    unsigned sum, cnt, mine, sp = 0u;
    for (;;) {
        sum = 0u; cnt = 0u; mine = 0u;
#pragma unroll
        for (unsigned j = 0; j < 16; ++j) { const unsigned c = xb_ld(&bar[XB_XCNT(j)]); sum += c; cnt += (c > 0u) ? 1u : 0u; mine = (j == x) ? c : mine; }
        if (sum == G) break;
        __builtin_amdgcn_s_sleep(1);
        if ((++sp & 255u) == 0u) { if (xb_ld(&bar[XB_TMO])) break; if (sp > XB_SPIN_CAP) { atomicAdd(&bar[XB_TMO], 1u); break; } }
    }
    nloc = mine > 0u ? mine : 1u; nx = cnt > 0u ? cnt : 1u;
}
__device__ __forceinline__ void xcd_barrier(const XcdBarrier& b) {
    asm volatile("s_waitcnt vmcnt(0)" ::: "memory");
    __syncthreads();
    if (threadIdx.x == 0) {
        unsigned* bar = b.bar;
        __builtin_amdgcn_s_waitcnt(0);
        unsigned nloc = b.st[0], nx = b.st[1];
        if (nloc == 0u) { xcd_barrier_complete(bar, b.x, nloc, nx); b.st[0] = nloc; b.st[1] = nx; }
        const unsigned old = xb_add(&bar[XB_XSUB(b.x)], 1u);
        const unsigned gen = old / nloc;
        if (old + 1u == (gen + 1u) * nloc) {
            __builtin_amdgcn_fence(__ATOMIC_RELEASE, "agent");
            asm volatile("s_waitcnt vmcnt(0)" ::: "memory");
            const unsigned og = xb_add(&bar[XB_TOP], 1u);
            const unsigned tg = og / nx;
            if (og + 1u == (tg + 1u) * nx) xb_add(&bar[XB_TOPGEN], 1u);
            else XB_SPIN(xb_ld(&bar[XB_TOPGEN]) == tg, bar);
            __builtin_amdgcn_fence(__ATOMIC_ACQUIRE, "agent");
            xb_add(&bar[XB_XGEN(b.x)], 1u);
            asm volatile("s_waitcnt vmcnt(0)" ::: "memory");
        } else {
            XB_SPIN(xb_ld(&bar[XB_XGEN(b.x)]) == gen, bar);
            __builtin_amdgcn_fence(__ATOMIC_ACQUIRE, "agent");
            asm volatile("s_waitcnt vmcnt(0)" ::: "memory");
        }
    }
    __syncthreads();
}

__global__ void __launch_bounds__(512) fwd_megakernel(Params Parg) {
    extern __shared__ __attribute__((aligned(16))) unsigned char shm[];
    cg::grid_group grid = cg::this_grid();
    LAS unsigned char* lds = (LAS unsigned char*)shm;
    using namespace pg8;
    if (threadIdx.x < 4) ((volatile LAS unsigned*)(lds + STAGE_BYTES + 16384))[threadIdx.x] = 0u;
    __syncthreads();
    { KP Pb = kparams(); (void)xcd_barrier_post((unsigned*)(Pb->ws + OFF_BAR), (volatile LAS unsigned*)(lds + STAGE_BYTES + 16384)); }
    grid.sync();
#ifndef DUP_GEMM
#define DUP_GEMM 1
#endif
#ifndef DUP_RW
#define DUP_RW 1
#endif
#ifndef DUP_GR
#define DUP_GR 1
#endif
#ifndef DUP_MISC
#define DUP_MISC 1
#endif
#ifndef NSYNC
#define NSYNC 1
#endif
#define REP(n) _Pragma("nounroll") for (int _d = 0; _d < (n); ++_d)
#define GSYNC() do { REP(NSYNC) { KP Pb = kparams(); XcdBarrier xb_; xb_.bar = (unsigned*)(Pb->ws + OFF_BAR); xb_.x = xb_xcc_id(); xb_.st = (volatile LAS unsigned*)(lds + STAGE_BYTES + 16384); xcd_barrier(xb_); } } while (0)
    for (int l = 0; l < 2; ++l) {
        { KP P = kparams(); unsigned char* ws = P->ws;
          conv_t<true>((bf16_t*)(ws + OFF_WIN), (const float*)P->in[4] + (size_t)l * 1024 * NIN, 10752, 1024, NIN); }
        for (int n = 0; n < 4; ++n) { KP P = kparams(); unsigned char* ws = P->ws;
          conv_t<false>((bf16_t*)(ws + OFF_WB) + (size_t)n * 1024 * 512, (const float*)P->in[26] + ((size_t)l * 4 + n) * 512 * 1024, 1024, 512, 1024); }
        { KP P = kparams(); unsigned char* ws = P->ws; conv_t<false>((bf16_t*)(ws + OFF_WOUT), (const float*)P->in[27] + (size_t)l * 1024 * 1024, 1024, 1024, 1024); }
        { KP P = kparams(); unsigned char* ws = P->ws; conv_t<false>((bf16_t*)(ws + OFF_WQ), (const float*)P->in[30] + (size_t)l * 1024 * 1024, 1024, 1024, 1024); }
        { KP P = kparams(); unsigned char* ws = P->ws; conv_t<false>((bf16_t*)(ws + OFF_WKV), (const float*)P->in[31] + (size_t)l * 1024 * 2048, 2048, 1024, 2048); }
        { KP P = kparams(); unsigned char* ws = P->ws; conv_t<false>((bf16_t*)(ws + OFF_WO), (const float*)P->in[32] + (size_t)l * 1024 * 1024, 1024, 1024, 1024); }
        { KP P = kparams(); unsigned char* ws = P->ws; rmsnorm_bf16((const float*)P->in[1], (const float*)P->in[29] + l * 1024, (bf16_t*)(ws + OFF_MN), 512); }
        for (int b = 0; b < 2; ++b) {
            { KP P = kparams(); unsigned char* ws = P->ws;
              const float* hin = (l == 0 ? (const float*)P->in[0] : (const float*)P->out) + (size_t)b * TB * DM;
              rmsnorm_bf16(hin, (const float*)P->in[3] + l * 1024, (bf16_t*)(ws + OFF_UN), TB); }
            GSYNC();
            if (b == 0) { KP P = kparams(); unsigned char* ws = P->ws;
                Order S; S.init(2, 8, 1, ws + OFF_MN, ws + OFF_WKV, 256L * 1024 * 2, 256L * 1024 * 2, 0, 0, 0);
                EpiKV E{(bf16_t*)(ws + OFF_KM), (bf16_t*)(ws + OFF_VT)}; gemm_phase(lds, Gemm{1024, 1024, 1024}, S, E); }
            REP(DUP_GEMM) { KP P = kparams(); unsigned char* ws = P->ws;
                Order S; S.init(64, 26, 1, ws + OFF_UN, ws + OFF_WIN, 256L * 1024 * 2, 256L * 1024 * 2, 0, 0, 0);
                EpiInproj E{ws}; gemm_phase(lds, Gemm{1024, 1024, 1024}, S, E); }
            GSYNC();
            REP(DUP_RW) rwkv_prep(kparams(), l);
            GSYNC();
            REP(DUP_RW) rwkv_pass1(kparams());
            GSYNC();
            rwkv_cscan(kparams(), shm);
            GSYNC();
            rwkv_pass2(kparams(), l);
            GSYNC();
            REP(DUP_GR) gr_ds(kparams(), l, b, shm);
            REP(DUP_MISC) lru_p1(kparams(), l);
            GSYNC();
            gr_scan(kparams());
            GSYNC();
            gr_out(kparams(), l, b, shm);
            lru_p3(kparams());
            GSYNC();
            REP(DUP_GEMM) { KP P = kparams(); unsigned char* ws = P->ws;
                Order S; S.init(64, 16, 1, ws + OFF_UN, ws + OFF_WIN + (size_t)6656 * 1024 * 2, 256L * 1024 * 2, 256L * 1024 * 2, 0, 0, 0);
                EpiBf16<1> E{(bf16_t*)(ws + OFF_G), 4096, 1.0f}; gemm_phase(lds, Gemm{1024, 1024, 1024}, S, E); }
            GSYNC();
            REP(DUP_GEMM) { KP P = kparams(); unsigned char* ws = P->ws;
                Order S; S.init(64, 4, 4, ws + OFF_ZG, ws + OFF_WB, 256L * 2048 * 2, 256L * 512 * 2, 0, 512L * 2, 1024L * 512 * 2);
                EpiMerge E{(const bf16_t*)(ws + OFF_G), (bf16_t*)(ws + OFF_MRG)}; gemm_phase(lds, Gemm{2048, 512, 512}, S, E); }
            GSYNC();
            { KP P = kparams(); unsigned char* ws = P->ws;
                const float* hin = (l == 0 ? (const float*)P->in[0] : (const float*)P->out) + (size_t)b * TB * DM; float* hout = P->out + (size_t)b * TB * DM;
                Order S; S.init(64, 4, 1, ws + OFF_MRG, ws + OFF_WOUT, 256L * 1024 * 2, 256L * 1024 * 2, 0, 0, 0);
                EpiResid E{hin, hout}; gemm_phase(lds, Gemm{1024, 1024, 1024}, S, E); }
            GSYNC();
            { KP P = kparams(); unsigned char* ws = P->ws; const float* hout = P->out + (size_t)b * TB * DM;
              rmsnorm_bf16(hout, (const float*)P->in[28] + l * 1024, (bf16_t*)(ws + OFF_UN), TB); }
            GSYNC();
            REP(DUP_GEMM) { KP P = kparams(); unsigned char* ws = P->ws;
                Order S; S.init(64, 4, 1, ws + OFF_UN, ws + OFF_WQ, 256L * 1024 * 2, 256L * 1024 * 2, 0, 0, 0);
                EpiBf16<0> E{(bf16_t*)(ws + OFF_Q), 1024, 0.0625f}; gemm_phase(lds, Gemm{1024, 1024, 1024}, S, E); }
            GSYNC();
            REP(DUP_GEMM) { KP P = kparams(); unsigned char* ws = P->ws;
                Order S; S.init(64, 4, 1, ws + OFF_Q, ws + OFF_KM + (size_t)b * 256 * 1024 * 2, 256L * 1024 * 2, 256L * 2, 256L * 2, 0, 0);
                EpiSoftmax E{(bf16_t*)(ws + OFF_P), (LAS float*)(lds + STAGE_BYTES)}; gemm_phase(lds, Gemm{1024, 1024, 256}, S, E); }
            GSYNC();
            REP(DUP_GEMM) { KP P = kparams(); unsigned char* ws = P->ws;
                Order S; S.init(64, 4, 1, ws + OFF_P, ws + OFF_VT + (size_t)b * 1024 * 256 * 2, 256L * 1024 * 2, 256L * 256 * 2, 256L * 2, 0, 0);
                EpiBf16<0> E{(bf16_t*)(ws + OFF_O), 1024, 1.0f}; gemm_phase(lds, Gemm{1024, 256, 256}, S, E); }
            GSYNC();
            { KP P = kparams(); unsigned char* ws = P->ws; float* hout = P->out + (size_t)b * TB * DM;
                Order S; S.init(64, 4, 1, ws + OFF_O, ws + OFF_WO, 256L * 1024 * 2, 256L * 1024 * 2, 0, 0, 0);
                EpiResid E{hout, hout}; gemm_phase(lds, Gemm{1024, 1024, 1024}, S, E); }
            GSYNC();
        }
    }
    { KP P = kparams(); rmsnorm_f32_inplace(P->out, (const float*)P->in[33], 2 * TB); }
}

extern "C" void kernel_launch(void* const* d_in, const int* in_sizes, int n_in, void* d_out, int out_size, void* d_ws, size_t ws_size, hipStream_t stream) {
    constexpr size_t kDynLds = pg8::STAGE_BYTES + 16384 + 64;
    static int grid_blocks = 0;
    if (!grid_blocks) {
        int dev = 0, cus = 0, per_cu = 0;
        hipGetDevice(&dev);
        hipDeviceGetAttribute(&cus, hipDeviceAttributeMultiprocessorCount, dev);
        hipFuncSetAttribute((const void*)fwd_megakernel, hipFuncAttributeMaxDynamicSharedMemorySize, (int)kDynLds);
        hipOccupancyMaxActiveBlocksPerMultiprocessor(&per_cu, (const void*)fwd_megakernel, 512, kDynLds);
        if (per_cu < 1) { fprintf(stderr, "occupancy query returned %d\n", per_cu); per_cu = 1; }
        grid_blocks = cus * per_cu;
        if (ws_size < OFF_END) fprintf(stderr, "workspace too small: %zu < %zu\n", ws_size, (size_t)OFF_END);
    }
    hipMemsetAsync((unsigned char*)d_ws + OFF_BAR, 0, 16384, stream);
    Params p{};
    for (int i = 0; i < 34; ++i) p.in[i] = d_in[i];
    p.out = (float*)d_out; p.ws = (unsigned char*)d_ws;
    void* args[] = {&p};
    hipError_t e = hipLaunchCooperativeKernel((const void*)fwd_megakernel, dim3(grid_blocks), dim3(512), args, kDynLds, stream);
    if (e != hipSuccess) fprintf(stderr, "cooperative launch failed: %s (grid %d)\n", hipGetErrorString(e), grid_blocks);
}
```

```cpp
#include <hip/hip_runtime.h>
#include <hip/hip_cooperative_groups.h>
#include <cstdio>
namespace cg = cooperative_groups;

typedef unsigned short bf16_t;
typedef short bf16x8 __attribute__((ext_vector_type(8)));
typedef float f32x4 __attribute__((ext_vector_type(4)));
typedef float f32x2 __attribute__((ext_vector_type(2)));
typedef unsigned u32x4 __attribute__((ext_vector_type(4)));
typedef unsigned u32x2 __attribute__((ext_vector_type(2)));
#define LAS __attribute__((address_space(3)))

constexpr int TB = 16384;
constexpr int DM = 1024;
constexpr int NIN = 10384;
constexpr int NCH = 128, LCH = 128;

constexpr size_t SZ_WIN = (size_t)10752 * 1024 * 2;
constexpr size_t OFF_WIN = 0;
constexpr size_t OFF_WB = OFF_WIN + SZ_WIN;
constexpr size_t OFF_WOUT = OFF_WB + (size_t)4 * 1024 * 512 * 2;
constexpr size_t OFF_WQ = OFF_WOUT + (size_t)1024 * 1024 * 2;
constexpr size_t OFF_WKV = OFF_WQ + (size_t)1024 * 1024 * 2;
constexpr size_t OFF_WO = OFF_WKV + (size_t)2048 * 1024 * 2;
constexpr size_t OFF_UN = OFF_WO + (size_t)1024 * 1024 * 2;
constexpr size_t OFF_MN = OFF_UN + (size_t)TB * 1024 * 2;
constexpr size_t OFF_KM = OFF_MN + (size_t)512 * 1024 * 2;
constexpr size_t OFF_VT = OFF_KM + (size_t)512 * 1024 * 2;
constexpr size_t OFF_ZRW = OFF_VT + (size_t)512 * 1024 * 2;
constexpr size_t OFF_ZGLA = OFF_ZRW + (size_t)TB * 1792 * 2;
constexpr size_t OFF_ZRET = OFF_ZGLA + (size_t)TB * 1280 * 2;
constexpr size_t OFF_ZLRU = OFF_ZRET + (size_t)TB * 1024 * 2;
constexpr size_t OFF_ZG = OFF_ZLRU + (size_t)TB * 512 * 2;
constexpr size_t OFF_MRG = OFF_ZG + (size_t)TB * 2048 * 2;
constexpr size_t OFF_PREP = OFF_MRG + (size_t)TB * 1024 * 2;
constexpr size_t SZ_F = (size_t)TB * 512 * 4;
constexpr size_t OFF_PW = OFF_PREP, OFF_PKK = OFF_PW + SZ_F, OFF_PB = OFF_PKK + SZ_F, OFF_PKM = OFF_PB + SZ_F, OFF_PR = OFF_PKM + SZ_F;
constexpr size_t OFF_PV = OFF_PR + SZ_F;
constexpr size_t OFF_BON = OFF_PV + (size_t)TB * 512 * 2;
constexpr size_t OFF_BAR = OFF_BON + (size_t)TB * 8 * 4;
constexpr size_t OFF_ROPE = OFF_BAR + 16384;
constexpr size_t OFF_DSG0 = OFF_PKK + SZ_F / 2;
constexpr size_t OFF_DSG1 = OFF_PB + SZ_F / 2;
constexpr size_t OFF_HL = OFF_PKM + SZ_F / 2;
constexpr size_t OFF_CA = OFF_PR + SZ_F / 2;
constexpr size_t OFF_DEC = OFF_ROPE + (size_t)2 * TB * 32 * 8;
constexpr size_t OFF_AC = OFF_DEC + (size_t)256 * 4 * 64 * 4;
constexpr size_t OFF_HC = OFF_AC + (size_t)256 * 512 * 4;
constexpr size_t OFF_HIN = OFF_HC + (size_t)256 * 512 * 4;
constexpr size_t OFF_W2T = OFF_HIN + (size_t)256 * 512 * 4;
constexpr size_t OFF_A2T = OFF_W2T + (size_t)512 * 64 * 2;
constexpr size_t OFF_WAT = OFF_A2T + (size_t)512 * 64 * 2;
constexpr size_t OFF_WXT = OFF_WAT + (size_t)8 * 64 * 64 * 2;
constexpr size_t OFF_END = OFF_WXT + (size_t)8 * 64 * 64 * 2;
constexpr size_t OFF_G = OFF_ZRW;
constexpr size_t OFF_Q = OFF_ZRW;
constexpr size_t OFF_P = OFF_Q + (size_t)TB * 1024 * 2;
constexpr size_t OFF_O = OFF_P + (size_t)TB * 1024 * 2;
constexpr size_t OFF_PP = OFF_MRG;
constexpr size_t OFF_PL = OFF_MRG + (size_t)8 * NCH * 4096 * 4;
struct Params { const void* in[34]; float* out; unsigned char* ws; };
typedef const Params __attribute__((address_space(4)))* KP;
__device__ __forceinline__ KP kparams() { KP p = (KP)__builtin_amdgcn_kernarg_segment_ptr(); asm volatile("" : "+s"(p)); return p; }

__device__ __forceinline__ float bf2f(bf16_t v) { return __uint_as_float(((unsigned)v) << 16); }
__device__ __forceinline__ bf16_t f2bf(float f) { const __bf16 b = (__bf16)f; return __builtin_bit_cast(bf16_t, b); }
typedef __bf16 bf16x2_t __attribute__((ext_vector_type(2)));
__device__ __forceinline__ unsigned cvt_pk_bf16(float lo, float hi) { const f32x2 v = {lo, hi}; const bf16x2_t b = __builtin_convertvector(v, bf16x2_t); return __builtin_bit_cast(unsigned, b); }
__device__ __forceinline__ float shx(float v, int lane, int o) { return __int_as_float(__builtin_amdgcn_ds_bpermute((lane ^ o) << 2, __float_as_int(v))); }
__device__ __forceinline__ float wave_sum(float v, int lane) {
#pragma unroll
    for (int o = 32; o >= 1; o >>= 1) v += shx(v, lane, o);
    return v; }
__device__ __forceinline__ float rlane(float v, int k) { return __int_as_float(__builtin_amdgcn_readlane(__float_as_int(v), k)); }
__device__ __forceinline__ float sigmoidf_(float x) { return __builtin_amdgcn_rcpf(1.0f + __expf(-x)); }
__device__ __forceinline__ float siluf_(float x) { return x * __builtin_amdgcn_rcpf(1.0f + __expf(-x)); }
__device__ __forceinline__ float softplusf_(float y) { return fmaxf(y, 0.f) + __logf(1.0f + __expf(-fabsf(y))); }
__device__ __forceinline__ float tanhf_(float x) { float e = __expf(2.0f * x); return 1.0f - 2.0f * __builtin_amdgcn_rcpf(e + 1.0f); }

__device__ __forceinline__ int otid() { int t = threadIdx.x; asm volatile("" : "+v"(t)); return t; }
__device__ __forceinline__ int obid() { int t = blockIdx.x; asm volatile("" : "+s"(t)); return t; }

namespace pg8 {
constexpr int BM = 256, BK = 64, HALF = 128, HTB = HALF * BK * 2, STAGE_BYTES = 8 * HTB, NXCD = 8, WGM = 8;
__device__ __forceinline__ int lds_byte(int r, int c) { const int st = (r >> 4) * 2 + (c >> 5), rr = r & 15, cc = c & 31, ob = rr * 64 + cc * 2; return st * 1024 + (ob ^ (((ob >> 9) & 1) << 5)); }
__device__ __forceinline__ void stage_rc(int b, int& R, int& C) { const int st = b / 1024, sb = b % 1024, swz = sb ^ (((sb >> 9) & 1) << 5); R = (st >> 1) * 16 + swz / 64; C = (st & 1) * 32 + (swz % 64) / 2; }
__device__ __forceinline__ int perm32(int rho) { const int n = rho >> 4, i = rho & 15; return 8 * (i >> 2) + 4 * n + (i & 3); }

struct Unit { int pm, pn, aux; const char* pa; const char* pb; };
struct Gemm { int lda, ldb, K; };

struct Order {
    int nM, nN, nwg, G, c, rep;
    const char* A; const char* B;
    long tA, tB, aPn, aRep, bRep;
    __device__ void init(int nM_, int nN_, int rep_, const void* A_, const void* B_, long tA_, long tB_, long aPn_, long aRep_, long bRep_) {
        nM = nM_; nN = nN_; nwg = nM * nN; G = gridDim.x; c = obid(); rep = rep_; A = (const char*)A_; B = (const char*)B_; tA = tA_; tB = tB_; aPn = aPn_; aRep = aRep_; bRep = bRep_; }
    __device__ bool next(int i, Unit& u) const {
        const int ti = i / rep, r = i - ti * rep;
        const long L = (long)ti * G + c; if (L >= nwg) return false;
        int wgid = (int)L; { const int q = nwg / NXCD, rr = nwg % NXCD, xcd = wgid % NXCD, off = wgid / NXCD; wgid = (xcd < rr ? xcd * (q + 1) : rr * (q + 1) + (xcd - rr) * q) + off; }
        const int nig = WGM * nN, gid = wgid / nig, fm = gid * WGM, gsz = (nM - fm) < WGM ? (nM - fm) : WGM;
        u.pm = fm + ((wgid % nig) % gsz); u.pn = (wgid % nig) / gsz; u.aux = r;
        u.pa = A + (long)u.pm * tA + (long)u.pn * aPn + (long)r * aRep;
        u.pb = B + (long)u.pn * tB + (long)r * bRep;
        return true; }
};

template <class Epi>
__device__ __forceinline__ void gemm_phase(LAS unsigned char* lds, const Gemm g, const Order& S, const Epi& E) {
    const int tid = otid(), wid = __builtin_amdgcn_readfirstlane(tid >> 6), lane = tid & 63, wr = wid >> 2, wc = wid & 3, fr = lane & 15, fq = lane >> 4;
    const int K = g.K, nt = K / BK;
    unsigned voffA[2], voffB[2];
#pragma unroll
    for (int i = 0; i < 2; ++i) { int R, C; stage_rc(tid * 16 + i * 8192, R, C); const int Rb = Epi::PERM ? ((R & ~31) + perm32(R & 31)) : R;
        voffA[i] = (unsigned)(R * g.lda + C) * 2u; voffB[i] = (unsigned)(Rb * g.ldb + C) * 2u; }
    const size_t kstep = (size_t)(BK * 2);
    const size_t hstepA = (size_t)HALF * g.lda * 2, hstepB = (size_t)HALF * g.ldb * 2;
    const unsigned ldsw = (unsigned)wid * 1024u;
    const int aoff = lds_byte(wr * 64 + fr, fq * 8), boff = lds_byte(wc * 32 + fr, fq * 8);
#define PG8_SA(b, h) (((b) * 2 + (h)) * HTB)
#define PG8_SB(b, h) ((4 + (b) * 2 + (h)) * HTB)
#define PG8_STAGE(bufoff, gbase, voff) do { _Pragma("unroll") for (int _i = 0; _i < 2; ++_i) \
        __builtin_amdgcn_global_load_lds((const unsigned*)((const char*)(gbase) + (voff)[_i]), (LAS unsigned*)(lds + (bufoff) + ldsw + _i * 8192), 16, 0, 0); } while (0)
#define PG8_LDA(dst, b, h) do { _Pragma("unroll") for (int m = 0; m < 4; ++m) _Pragma("unroll") for (int k = 0; k < 2; ++k) dst[m][k] = *(const LAS bf16x8*)(lds + PG8_SA(b, h) + aoff + m * 2048 + k * 1024); } while (0)
#define PG8_LDB(dst, b, h) do { _Pragma("unroll") for (int n = 0; n < 2; ++n) _Pragma("unroll") for (int k = 0; k < 2; ++k) dst[n][k] = *(const LAS bf16x8*)(lds + PG8_SB(b, h) + boff + n * 2048 + k * 1024); } while (0)
#define PG8_MMA(ai, bj, At, Bt) do { __builtin_amdgcn_s_setprio(1); _Pragma("unroll") for (int m = 0; m < 4; ++m) _Pragma("unroll") for (int n = 0; n < 2; ++n) _Pragma("unroll") for (int k = 0; k < 2; ++k) \
        acc[ai][bj][m][n] = __builtin_amdgcn_mfma_f32_16x16x32_bf16(Bt[n][k], At[m][k], acc[ai][bj][m][n], 0, 0, 0); __builtin_amdgcn_s_setprio(0); } while (0)
#define PG8_WAIT_V(n) asm volatile("s_waitcnt vmcnt(" #n ")" ::: "memory")
#define PG8_WAIT_L(n) asm volatile("s_waitcnt lgkmcnt(" #n ")" ::: "memory")
#define PG8_BAR __builtin_amdgcn_s_barrier()
#define PG8_SCHED __builtin_amdgcn_sched_barrier(0)
    Unit cur, nxt; int ui = 0;
    if (!S.next(0, cur)) return;
    f32x4 acc[2][2][4][2];
#pragma unroll
    for (int a = 0; a < 2; ++a)
#pragma unroll
        for (int b = 0; b < 2; ++b)
#pragma unroll
            for (int m = 0; m < 4; ++m)
#pragma unroll
                for (int n = 0; n < 2; ++n) acc[a][b][m][n] = (f32x4){0.f, 0.f, 0.f, 0.f};
    bf16x8 At[4][2], B0[2][2], B1[2][2];
    const char* cA = cur.pa; const char* cB = cur.pb;
    PG8_STAGE(PG8_SB(0, 0), cB, voffB); PG8_STAGE(PG8_SA(0, 0), cA, voffA); PG8_STAGE(PG8_SB(0, 1), cB + hstepB, voffB); PG8_STAGE(PG8_SA(0, 1), cA + hstepA, voffA);
    if (wr == 1) PG8_BAR;
    PG8_WAIT_V(4); PG8_BAR;
    PG8_STAGE(PG8_SB(1, 0), cB + kstep, voffB); PG8_STAGE(PG8_SA(1, 0), cA + kstep, voffA); PG8_STAGE(PG8_SB(1, 1), cB + hstepB + kstep, voffB);
    PG8_WAIT_V(6); PG8_BAR;
    for (;;) {
        const bool has_next = S.next(ui + 1, nxt);
        const char* nA = has_next ? nxt.pa : cA; const char* nB = has_next ? nxt.pb : cB;
        for (int t = 0; t < nt; t += 2) {
            const bool last = (t == nt - 2);
            const char* a1 = cA + (size_t)(t + 1) * kstep;
            const char* a2 = last ? nA : cA + (size_t)(t + 2) * kstep; const char* b2 = last ? nB : cB + (size_t)(t + 2) * kstep;
            const char* a3 = a2 + kstep; const char* b3 = b2 + kstep;
            PG8_LDB(B0, 0, 0); PG8_SCHED; PG8_LDA(At, 0, 0); PG8_STAGE(PG8_SA(1, 1), a1 + hstepA, voffA);
            PG8_WAIT_L(8); PG8_BAR; PG8_WAIT_L(0); PG8_MMA(0, 0, At, B0); PG8_BAR; PG8_SCHED;
            PG8_LDB(B1, 0, 1); PG8_STAGE(PG8_SB(0, 0), b2, voffB);
            PG8_BAR; PG8_WAIT_L(0); PG8_MMA(0, 1, At, B1); PG8_BAR;
            PG8_LDA(At, 0, 1); PG8_STAGE(PG8_SA(0, 0), a2, voffA);
            PG8_BAR; PG8_WAIT_L(0); PG8_MMA(1, 0, At, B0); PG8_BAR; PG8_SCHED;
            PG8_STAGE(PG8_SB(0, 1), b2 + hstepB, voffB);
            PG8_WAIT_V(6); PG8_BAR; PG8_MMA(1, 1, At, B1); PG8_BAR;
            PG8_LDB(B0, 1, 0); PG8_SCHED; PG8_LDA(At, 1, 0); PG8_STAGE(PG8_SA(0, 1), a2 + hstepA, voffA);
            PG8_WAIT_L(8); PG8_BAR; PG8_WAIT_L(0); PG8_MMA(0, 0, At, B0); PG8_BAR; PG8_SCHED;
            PG8_LDB(B1, 1, 1); PG8_STAGE(PG8_SB(1, 0), b3, voffB);
            PG8_BAR; PG8_WAIT_L(0); PG8_MMA(0, 1, At, B1); PG8_BAR;
            PG8_LDA(At, 1, 1); PG8_STAGE(PG8_SA(1, 0), a3, voffA);
            PG8_BAR; PG8_WAIT_L(0); PG8_MMA(1, 0, At, B0); PG8_BAR; PG8_SCHED;
            PG8_STAGE(PG8_SB(1, 1), b3 + hstepB, voffB);
            PG8_WAIT_V(6); PG8_BAR; PG8_MMA(1, 1, At, B1); PG8_BAR;
        }
        E(acc, cur, wr, wc, fr, fq);
        if (!has_next) break;
        if constexpr (!Epi::KEEP_ACC)
#pragma unroll
        for (int a = 0; a < 2; ++a)
#pragma unroll
            for (int b = 0; b < 2; ++b)
#pragma unroll
                for (int m = 0; m < 4; ++m)
#pragma unroll
                    for (int n = 0; n < 2; ++n) acc[a][b][m][n] = (f32x4){0.f, 0.f, 0.f, 0.f};
        cur = nxt; cA = nA; cB = nB; ++ui;
    }
    PG8_WAIT_V(0);
    if (wr == 0) PG8_BAR;
    PG8_BAR;
#undef PG8_SA
#undef PG8_SB
#undef PG8_STAGE
#undef PG8_LDA
#undef PG8_LDB
#undef PG8_MMA
#undef PG8_WAIT_V
#undef PG8_WAIT_L
#undef PG8_BAR
#undef PG8_SCHED
}

typedef f32x4 Acc[2][2][4][2];

struct EpiInproj {
    static constexpr bool PERM = true, KEEP_ACC = false;
    unsigned char* ws;
    __device__ __forceinline__ void operator()(Acc& acc, const Unit& u, int wr, int wc, int fr, int fq) const {
        int pn = u.pn, ld, colt; size_t off;
        if (pn < 7) { off = OFF_ZRW; ld = 1792; colt = pn * 256; }
        else if (pn < 12) { off = OFF_ZGLA; ld = 1280; colt = (pn - 7) * 256; }
        else if (pn < 16) { off = OFF_ZRET; ld = 1024; colt = (pn - 12) * 256; }
        else if (pn < 18) { off = OFF_ZLRU; ld = 512; colt = (pn - 16) * 256; }
        else { off = OFF_ZG; ld = 2048; colt = (pn - 18) * 256; }
        bf16_t* base = (bf16_t*)(ws + off);
        const int row0 = u.pm * BM + wr * 64 + fr, col0 = colt + wc * 32 + 8 * fq;
#pragma unroll
        for (int ai = 0; ai < 2; ++ai)
#pragma unroll
            for (int m = 0; m < 4; ++m) { bf16_t* rowp = base + (size_t)(row0 + ai * HALF + m * 16) * ld + col0;
#pragma unroll
                for (int bj = 0; bj < 2; ++bj) { const f32x4 v0 = acc[ai][bj][m][0], v1 = acc[ai][bj][m][1];
                    u32x4 w; w.x = cvt_pk_bf16(v0[0], v0[1]); w.y = cvt_pk_bf16(v0[2], v0[3]); w.z = cvt_pk_bf16(v1[0], v1[1]); w.w = cvt_pk_bf16(v1[2], v1[3]);
                    *(u32x4*)(rowp + bj * HALF) = w; } }
    }
};
template <int ACT> struct EpiBf16 {
    static constexpr bool PERM = true, KEEP_ACC = false;
    bf16_t* O; int ldc; float scale;
    __device__ __forceinline__ void operator()(Acc& acc, const Unit& u, int wr, int wc, int fr, int fq) const {
        const int row0 = u.pm * BM + wr * 64 + fr, col0 = u.pn * BM + wc * 32 + 8 * fq;
#pragma unroll
        for (int ai = 0; ai < 2; ++ai)
#pragma unroll
            for (int m = 0; m < 4; ++m) { bf16_t* rowp = O + (size_t)(row0 + ai * HALF + m * 16) * ldc + col0;
#pragma unroll
                for (int bj = 0; bj < 2; ++bj) { f32x4 v0 = acc[ai][bj][m][0], v1 = acc[ai][bj][m][1];
                    if (ACT == 1) {
#pragma unroll
                        for (int j = 0; j < 4; ++j) { v0[j] = sigmoidf_(v0[j]); v1[j] = sigmoidf_(v1[j]); } }
                    else { v0 = v0 * scale; v1 = v1 * scale; }
                    u32x4 w; w.x = cvt_pk_bf16(v0[0], v0[1]); w.y = cvt_pk_bf16(v0[2], v0[3]); w.z = cvt_pk_bf16(v1[0], v1[1]); w.w = cvt_pk_bf16(v1[2], v1[3]);
                    *(u32x4*)(rowp + bj * HALF) = w; } }
    }
};
struct EpiKV {
    static constexpr bool PERM = true, KEEP_ACC = false;
    bf16_t* KM; bf16_t* VT;
    __device__ __forceinline__ void operator()(Acc& acc, const Unit& u, int wr, int wc, int fr, int fq) const {
        const int row0 = u.pm * BM + wr * 64 + fr, col0 = u.pn * BM + wc * 32 + 8 * fq;
#pragma unroll
        for (int ai = 0; ai < 2; ++ai)
#pragma unroll
            for (int m = 0; m < 4; ++m) { const int row = row0 + ai * HALF + m * 16;
#pragma unroll
                for (int bj = 0; bj < 2; ++bj)
#pragma unroll
                    for (int n = 0; n < 2; ++n)
#pragma unroll
                        for (int j = 0; j < 4; ++j) { const int col = col0 + bj * HALF + 4 * n + j; const bf16_t v = f2bf(acc[ai][bj][m][n][j]);
                            if (col < 1024) KM[(size_t)row * 1024 + col] = v;
                            else VT[((size_t)(row >> 8) * 1024 + (col - 1024)) * 256 + (row & 255)] = v; } }
    }
};
struct EpiMerge {
    static constexpr bool PERM = true, KEEP_ACC = true;
    const bf16_t* G; bf16_t* MRG;
    __device__ __forceinline__ void operator()(Acc& acc, const Unit& u, int wr, int wc, int fr, int fq) const {
        const int row0 = u.pm * BM + wr * 64 + fr, col0 = u.pn * BM + wc * 32 + 8 * fq;
        const bool lastb = (u.aux == 3);
#pragma unroll
        for (int ai = 0; ai < 2; ++ai) {
            u32x4 gq[4][2], hq[4][2];
#pragma unroll
            for (int m = 0; m < 4; ++m)
#pragma unroll
                for (int bj = 0; bj < 2; ++bj) { const bf16_t* gp = G + (size_t)(row0 + ai * HALF + m * 16) * 4096 + u.aux * 1024 + col0 + bj * HALF;
                    gq[m][bj] = *(const u32x4*)gp; hq[m][bj] = (u32x4){0u, 0u, 0u, 0u};
                    if (!lastb) hq[m][bj] = *(const u32x4*)(gp + 1024); }
#pragma unroll
            for (int m = 0; m < 4; ++m)
#pragma unroll
                for (int bj = 0; bj < 2; ++bj) {
                    float f[8];
#pragma unroll
                    for (int e = 0; e < 4; ++e) {
                        const float g0 = fmaxf(__uint_as_float(gq[m][bj][e] << 16), 1e-30f), g1 = fmaxf(__uint_as_float(gq[m][bj][e] & 0xffff0000u), 1e-30f);
                        const float h0 = fmaxf(__uint_as_float(hq[m][bj][e] << 16), 1e-30f), h1 = fmaxf(__uint_as_float(hq[m][bj][e] & 0xffff0000u), 1e-30f);
                        f[2 * e] = lastb ? g0 : g0 * __builtin_amdgcn_rcpf(h0); f[2 * e + 1] = lastb ? g1 : g1 * __builtin_amdgcn_rcpf(h1); }
                    f32x4 v0 = acc[ai][bj][m][0], v1 = acc[ai][bj][m][1];
                    v0[0] *= f[0]; v0[1] *= f[1]; v0[2] *= f[2]; v0[3] *= f[3]; v1[0] *= f[4]; v1[1] *= f[5]; v1[2] *= f[6]; v1[3] *= f[7];
                    if (lastb) {
                        u32x4 w; w.x = cvt_pk_bf16(v0[0], v0[1]); w.y = cvt_pk_bf16(v0[2], v0[3]); w.z = cvt_pk_bf16(v1[0], v1[1]); w.w = cvt_pk_bf16(v1[2], v1[3]);
                        *(u32x4*)(MRG + (size_t)(row0 + ai * HALF + m * 16) * 1024 + col0 + bj * HALF) = w;
                        v0 = (f32x4){0.f, 0.f, 0.f, 0.f}; v1 = (f32x4){0.f, 0.f, 0.f, 0.f}; }
                    acc[ai][bj][m][0] = v0; acc[ai][bj][m][1] = v1; }
        }
    }
};
struct EpiResid {
    static constexpr bool PERM = false, KEEP_ACC = false;
    const float* hin; float* hout;
    __device__ __forceinline__ void operator()(Acc& acc, const Unit& u, int wr, int wc, int fr, int fq) const {
        const int row0 = u.pm * BM + wr * 64 + fr, col0 = u.pn * BM + wc * 32 + 4 * fq;
#pragma unroll
        for (int ai = 0; ai < 2; ++ai) {
            f32x4 r[4][2][2];
#pragma unroll
            for (int m = 0; m < 4; ++m) { const size_t ro = (size_t)(row0 + ai * HALF + m * 16) * 1024 + col0;
#pragma unroll
                for (int bj = 0; bj < 2; ++bj)
#pragma unroll
                    for (int n = 0; n < 2; ++n) r[m][bj][n] = *(const f32x4*)(hin + ro + bj * HALF + n * 16); }
#pragma unroll
            for (int m = 0; m < 4; ++m) { const size_t ro = (size_t)(row0 + ai * HALF + m * 16) * 1024 + col0;
#pragma unroll
                for (int bj = 0; bj < 2; ++bj)
#pragma unroll
                    for (int n = 0; n < 2; ++n) *(f32x4*)(hout + ro + bj * HALF + n * 16) = r[m][bj][n] + acc[ai][bj][m][n]; }
        }
    }
};
struct EpiSoftmax {
    static constexpr bool PERM = true, KEEP_ACC = false;
    bf16_t* P; LAS float* xs;
    __device__ __forceinline__ void operator()(Acc& acc, const Unit& u, int wr_, int wc_, int fr_, int fq_) const {
        const int tid2 = otid(), wid2 = tid2 >> 6, wr = wid2 >> 2, wc = wid2 & 3, fr = tid2 & 15, fq = (tid2 >> 4) & 3;
#pragma unroll
        for (int ai = 0; ai < 2; ++ai)
#pragma unroll
            for (int m = 0; m < 4; ++m) { float v = -3.0e38f;
#pragma unroll
                for (int bj = 0; bj < 2; ++bj)
#pragma unroll
                    for (int n = 0; n < 2; ++n)
#pragma unroll
                        for (int j = 0; j < 4; ++j) v = fmaxf(v, acc[ai][bj][m][n][j]);
                xs[(ai * HALF + wr * 64 + m * 16 + fr) * 16 + wc * 4 + fq] = v; }
        asm volatile("s_waitcnt lgkmcnt(0)\n\ts_barrier" ::: "memory");
        float sums[2][4];
#pragma unroll
        for (int ai = 0; ai < 2; ++ai)
#pragma unroll
            for (int m = 0; m < 4; ++m) { const int rl = ai * HALF + wr * 64 + m * 16 + fr;
                f32x4 q = *(const LAS f32x4*)(xs + rl * 16);
#pragma unroll
                for (int e = 1; e < 4; ++e) { const f32x4 q2 = *(const LAS f32x4*)(xs + rl * 16 + 4 * e); q[0] = fmaxf(q[0], q2[0]); q[1] = fmaxf(q[1], q2[1]); q[2] = fmaxf(q[2], q2[2]); q[3] = fmaxf(q[3], q2[3]); }
                const float M = fmaxf(fmaxf(q[0], q[1]), fmaxf(q[2], q[3]));
                float sv = 0.f;
#pragma unroll
                for (int bj = 0; bj < 2; ++bj)
#pragma unroll
                    for (int n = 0; n < 2; ++n)
#pragma unroll
                        for (int j = 0; j < 4; ++j) { const float e = __expf(acc[ai][bj][m][n][j] - M); acc[ai][bj][m][n][j] = e; sv += e; }
                sums[ai][m] = sv; }
        asm volatile("s_waitcnt lgkmcnt(0)\n\ts_barrier" ::: "memory");
#pragma unroll
        for (int ai = 0; ai < 2; ++ai)
#pragma unroll
            for (int m = 0; m < 4; ++m) xs[(ai * HALF + wr * 64 + m * 16 + fr) * 16 + wc * 4 + fq] = sums[ai][m];
        asm volatile("s_waitcnt lgkmcnt(0)\n\ts_barrier" ::: "memory");
        const int row0 = u.pm * BM + wr * 64 + fr, col0 = u.pn * BM + wc * 32 + 8 * fq;
#pragma unroll
        for (int ai = 0; ai < 2; ++ai)
#pragma unroll
            for (int m = 0; m < 4; ++m) { const int rl = ai * HALF + wr * 64 + m * 16 + fr;
                f32x4 q = *(const LAS f32x4*)(xs + rl * 16);
#pragma unroll
                for (int e = 1; e < 4; ++e) q += *(const LAS f32x4*)(xs + rl * 16 + 4 * e);
                const float inv = 1.0f / (q[0] + q[1] + q[2] + q[3]);
                bf16_t* rowp = P + (size_t)(row0 + ai * HALF + m * 16) * 1024 + col0;
#pragma unroll
                for (int bj = 0; bj < 2; ++bj) { const f32x4 v0 = acc[ai][bj][m][0] * inv, v1 = acc[ai][bj][m][1] * inv;
                    u32x4 w; w.x = cvt_pk_bf16(v0[0], v0[1]); w.y = cvt_pk_bf16(v0[2], v0[3]); w.z = cvt_pk_bf16(v1[0], v1[1]); w.w = cvt_pk_bf16(v1[2], v1[3]);
                    *(u32x4*)(rowp + bj * HALF) = w; } }
    }
};
}

__device__ __forceinline__ int win_map(int n) {
    if (n < 1792) return n < 1664 ? n : -1;
    n -= 1792; if (n < 1280) return n < 1040 ? 2176 + n : -1;
    n -= 1280; if (n < 1024) return 3728 + n;
    n -= 1024; if (n < 512) return 5264 + n;
    n -= 512;
    if (n < 512) return 1664 + n;
    if (n < 1024) return 3216 + (n - 512);
    if (n < 1536) return 4752 + (n - 1024);
    if (n < 2048) return 5776 + (n - 1536);
    n -= 2048; return 6288 + n;
}
template <bool WIN>
__device__ __forceinline__ void conv_t(bf16_t* dst, const float* src, int ND, int K, int NS) {
    const size_t total = (size_t)ND * (K / 8), stride = (size_t)gridDim.x * 512;
    for (size_t i0 = (size_t)obid() * 512 + otid(); i0 < total; i0 += 2 * stride) {
        float v[2][8]; int nn[2], kk[2];
#pragma unroll
        for (int q = 0; q < 2; ++q) { const size_t i = i0 + q * stride < total ? i0 + q * stride : i0;
            nn[q] = (int)(i % ND); kk[q] = (int)(i / ND);
            const int ms = WIN ? win_map(nn[q]) : nn[q];
#pragma unroll
            for (int e = 0; e < 8; ++e) v[q][e] = ms >= 0 ? src[(size_t)(kk[q] * 8 + e) * NS + ms] : 0.f; }
#pragma unroll
        for (int q = 0; q < 2; ++q) { if (q == 1 && i0 + stride >= total) break;
            u32x4 w; w.x = cvt_pk_bf16(v[q][0], v[q][1]); w.y = cvt_pk_bf16(v[q][2], v[q][3]); w.z = cvt_pk_bf16(v[q][4], v[q][5]); w.w = cvt_pk_bf16(v[q][6], v[q][7]);
            *(u32x4*)(dst + (size_t)nn[q] * K + kk[q] * 8) = w; }
    }
}
__device__ __forceinline__ void rmsnorm_bf16(const float* src, const float* g, bf16_t* dst, int rows) {
    const int lane = otid() & 63, gw = obid() * 8 + (otid() >> 6), nw = gridDim.x * 8;
    f32x4 gg[4];
#pragma unroll
    for (int i = 0; i < 4; ++i) gg[i] = *(const f32x4*)(g + i * 256 + lane * 4);
    for (int r0 = gw; r0 < rows; r0 += 4 * nw) {
        f32x4 v[4][4];
#pragma unroll
        for (int q = 0; q < 4; ++q) { const int r = r0 + q * nw < rows ? r0 + q * nw : r0; const float* p = src + (size_t)r * 1024;
#pragma unroll
            for (int i = 0; i < 4; ++i) v[q][i] = *(const f32x4*)(p + i * 256 + lane * 4); }
#pragma unroll
        for (int q = 0; q < 4; ++q) { const int r = r0 + q * nw; if (r >= rows) break;
            float ss = 0.f;
#pragma unroll
            for (int i = 0; i < 4; ++i) ss += v[q][i][0] * v[q][i][0] + v[q][i][1] * v[q][i][1] + v[q][i][2] * v[q][i][2] + v[q][i][3] * v[q][i][3];
            ss = wave_sum(ss, lane); const float rs = rsqrtf(ss * (1.0f / 1024.0f) + 1e-6f);
#pragma unroll
            for (int i = 0; i < 4; ++i) { u32x2 w; w.x = cvt_pk_bf16(v[q][i][0] * rs * gg[i][0], v[q][i][1] * rs * gg[i][1]); w.y = cvt_pk_bf16(v[q][i][2] * rs * gg[i][2], v[q][i][3] * rs * gg[i][3]);
                *(u32x2*)(dst + (size_t)r * 1024 + i * 256 + lane * 4) = w; } }
    }
}
__device__ __forceinline__ void rmsnorm_f32_inplace(float* buf, const float* g, int rows) {
    const int lane = otid() & 63, gw = obid() * 8 + (otid() >> 6), nw = gridDim.x * 8;
    f32x4 gg[4];
#pragma unroll
    for (int i = 0; i < 4; ++i) gg[i] = *(const f32x4*)(g + i * 256 + lane * 4);
    for (int r0 = gw; r0 < rows; r0 += 4 * nw) {
        f32x4 v[4][4];
#pragma unroll
        for (int q = 0; q < 4; ++q) { const int r = r0 + q * nw < rows ? r0 + q * nw : r0; const float* p = buf + (size_t)r * 1024;
#pragma unroll
            for (int i = 0; i < 4; ++i) v[q][i] = *(const f32x4*)(p + i * 256 + lane * 4); }
#pragma unroll
        for (int q = 0; q < 4; ++q) { const int r = r0 + q * nw; if (r >= rows) break;
            float ss = 0.f;
#pragma unroll
            for (int i = 0; i < 4; ++i) ss += v[q][i][0] * v[q][i][0] + v[q][i][1] * v[q][i][1] + v[q][i][2] * v[q][i][2] + v[q][i][3] * v[q][i][3];
            ss = wave_sum(ss, lane); const float rs = rsqrtf(ss * (1.0f / 1024.0f) + 1e-6f);
#pragma unroll
            for (int i = 0; i < 4; ++i) *(f32x4*)(buf + (size_t)r * 1024 + i * 256 + lane * 4) = v[q][i] * rs * gg[i]; }
    }
}

template <int CTRL, int RM> __device__ __forceinline__ float dppf(float x) { return __int_as_float(__builtin_amdgcn_update_dpp(0, __float_as_int(x), CTRL, RM, 0xf, false)); }
__device__ __forceinline__ float red8(float x) { x += dppf<0xB1, 0xf>(x); x += dppf<0x4E, 0xf>(x); x += dppf<0x141, 0xf>(x); return x; }
__device__ __forceinline__ float wave_total_from_groups(float x) {
    x += dppf<0x128, 0xf>(x);
    x += dppf<0x142, 0xa>(x);
    x += dppf<0x143, 0xc>(x);
    return rlane(x, 63); }
__device__ __forceinline__ float wave_sum_dpp(float x) { return wave_total_from_groups(red8(x)); }

__device__ __forceinline__ void rwkv_prep(KP P, int l, unsigned char* sm) {
    unsigned char* ws = P->ws;
    bf16_t* AW = (bf16_t*)sm; bf16_t* AA = (bf16_t*)(sm + 9216); float* OUTW = (float*)(sm + 18432); float* OUTA = (float*)(sm + 51200);
    const int c = otid(), lane = c & 63, h = c >> 6, lr = lane & 15, lq = lane >> 4, tt = c >> 3, jg = c & 7;
    const float* mu = (const float*)P->in[5] + (size_t)l * 1664;
    bf16x8 bw[4][2], ba[4][2];
#pragma unroll
    for (int nt = 0; nt < 4; ++nt)
#pragma unroll
        for (int ks = 0; ks < 2; ++ks) { const size_t o = (size_t)(h * 64 + nt * 16 + lr) * 64 + ks * 32 + lq * 8;
            bw[nt][ks] = *(const bf16x8*)((const bf16_t*)(ws + OFF_W2T) + o); ba[nt][ks] = *(const bf16x8*)((const bf16_t*)(ws + OFF_A2T) + o); }
    float muw[8], mua[8];
#pragma unroll
    for (int e = 0; e < 8; ++e) { muw[e] = mu[1536 + jg * 8 + e]; mua[e] = mu[1600 + jg * 8 + e]; }
    const float mu_r = mu[c], mu_k = mu[512 + c], mu_v = mu[1024 + c];
    const float w0c = ((const float*)P->in[6])[l * 512 + c], a0c = ((const float*)P->in[8])[l * 512 + c];
    const float kkc = ((const float*)P->in[10])[l * 512 + c], kac = ((const float*)P->in[11])[l * 512 + c], rkc = ((const float*)P->in[12])[l * 512 + c];
    const bf16_t* Z = (const bf16_t*)(ws + OFF_ZRW);
    float* PW = (float*)(ws + OFF_PW); bf16_t* PKK = (bf16_t*)(ws + OFF_PKK); bf16_t* PB = (bf16_t*)(ws + OFF_PB); bf16_t* PKM = (bf16_t*)(ws + OFF_PKM); bf16_t* PR = (bf16_t*)(ws + OFF_PR);
    bf16_t* PV = (bf16_t*)(ws + OFF_PV); float* BON = (float*)(ws + OFF_BON);
    for (int rng = obid(); rng < TB / 64; rng += gridDim.x) {
        const int t0 = rng * 64;
        {
            const bf16_t* zc = Z + (size_t)(t0 + tt) * 1792 + 1536 + jg * 8;
            const u32x4 cw = *(const u32x4*)zc, ca = *(const u32x4*)(zc + 64);
            u32x4 pw = {0u, 0u, 0u, 0u}, pa = {0u, 0u, 0u, 0u};
            if (t0 + tt > 0) { pw = *(const u32x4*)(zc - 1792); pa = *(const u32x4*)(zc - 1792 + 64); }
            u32x4 ow, oa;
#pragma unroll
            for (int e = 0; e < 4; ++e) {
                const float c0 = __uint_as_float(cw[e] << 16), c1 = __uint_as_float(cw[e] & 0xffff0000u), p0 = __uint_as_float(pw[e] << 16), p1 = __uint_as_float(pw[e] & 0xffff0000u);
                ow[e] = cvt_pk_bf16(tanhf_(c0 + (p0 - c0) * muw[2 * e]), tanhf_(c1 + (p1 - c1) * muw[2 * e + 1]));
                const float d0 = __uint_as_float(ca[e] << 16), d1 = __uint_as_float(ca[e] & 0xffff0000u), q0 = __uint_as_float(pa[e] << 16), q1 = __uint_as_float(pa[e] & 0xffff0000u);
                oa[e] = cvt_pk_bf16(d0 + (q0 - d0) * mua[2 * e], d1 + (q1 - d1) * mua[2 * e + 1]); }
            *(u32x4*)(AW + tt * 72 + jg * 8) = ow; *(u32x4*)(AA + tt * 72 + jg * 8) = oa;
        }
        __syncthreads();
        float pr = 0.f, pk = 0.f, pv = 0.f;
        if (t0 > 0) { const bf16_t* z = Z + (size_t)(t0 - 1) * 1792; pr = bf2f(z[c]); pk = bf2f(z[512 + c]); pv = bf2f(z[1024 + c]); }
        bf16_t zr[4], zk[4], zv[4], yr[4], yk[4], yv[4];
#pragma unroll
        for (int q = 0; q < 4; ++q) { const bf16_t* z = Z + (size_t)(t0 + q) * 1792; zr[q] = z[c]; zk[q] = z[512 + c]; zv[q] = z[1024 + c]; }
        for (int pass = 0; pass < 4; ++pass) {
            {
                f32x4 accw[4], acca[4];
#pragma unroll
                for (int nt = 0; nt < 4; ++nt) { accw[nt] = (f32x4){0.f, 0.f, 0.f, 0.f}; acca[nt] = (f32x4){0.f, 0.f, 0.f, 0.f}; }
#pragma unroll
                for (int ks = 0; ks < 2; ++ks) { const bf16x8 afw = *(const bf16x8*)(AW + (pass * 16 + lr) * 72 + ks * 32 + lq * 8), afa = *(const bf16x8*)(AA + (pass * 16 + lr) * 72 + ks * 32 + lq * 8);
#pragma unroll
                    for (int nt = 0; nt < 4; ++nt) { accw[nt] = __builtin_amdgcn_mfma_f32_16x16x32_bf16(afw, bw[nt][ks], accw[nt], 0, 0, 0); acca[nt] = __builtin_amdgcn_mfma_f32_16x16x32_bf16(afa, ba[nt][ks], acca[nt], 0, 0, 0); } }
#pragma unroll
                for (int nt = 0; nt < 4; ++nt)
#pragma unroll
                    for (int q = 0; q < 4; ++q) { OUTW[(lq * 4 + q) * 512 + h * 64 + nt * 16 + lr] = accw[nt][q]; OUTA[(lq * 4 + q) * 512 + h * 64 + nt * 16 + lr] = acca[nt][q]; }
            }
            __syncthreads();
            for (int g4 = 0; g4 < 4; ++g4) {
#pragma unroll
              for (int q = 0; q < 4; ++q) { const int tn = pass * 16 + g4 * 4 + 4 + q; const bf16_t* z = Z + (size_t)(t0 + (tn < 64 ? tn : 63)) * 1792; yr[q] = z[c]; yk[q] = z[512 + c]; yv[q] = z[1024 + c]; }
#pragma unroll
              for (int q4 = 0; q4 < 4; ++q4) {
                const int q = g4 * 4 + q4;
                const int t = t0 + pass * 16 + q;
                const float cr = bf2f(zr[q4]), ck = bf2f(zk[q4]), cv = bf2f(zv[q4]);
                const float rs = cr + (pr - cr) * mu_r, ks = ck + (pk - ck) * mu_k, vs = cv + (pv - cv) * mu_v;
                const float accw = w0c + OUTW[q * 512 + c], acca = a0c + OUTA[q * 512 + c];
                const float wdec = __expf(-0.60653065971f * sigmoidf_(accw));
                const float a = sigmoidf_(acca);
                const float kraw = ks * kkc;
                const float ss = wave_sum_dpp(kraw * kraw);
                const float kk = kraw * fminf(__builtin_amdgcn_rsqf(ss), 1e12f);
                const float km = ks * (1.0f + (a - 1.0f) * kac);
                const float bb = kk * a;
                const float bon = wave_sum_dpp(rs * km * rkc);
                const size_t o = (size_t)t * 512 + c;
                PW[o] = wdec; PKK[o] = f2bf(kk); PB[o] = f2bf(bb); PKM[o] = f2bf(km); PR[o] = f2bf(rs); PV[o] = f2bf(vs);
                if (lane == 0) BON[(size_t)t * 8 + h] = bon;
                pr = cr; pk = ck; pv = cv;
              }
#pragma unroll
              for (int q = 0; q < 4; ++q) { zr[q] = yr[q]; zk[q] = yk[q]; zv[q] = yv[q]; }
            }
            __syncthreads();
        }
    }
}
struct RwVec { f32x4 w[2]; u32x4 kk, b, km, r, v; };
template <bool NEED_KM, bool NEED_R>
__device__ __forceinline__ RwVec rw_load(const unsigned char* ws, size_t okv, size_t ov) {
    RwVec q;
    const float* PW = (const float*)(ws + OFF_PW) + okv;
    q.w[0] = *(const f32x4*)PW; q.w[1] = *(const f32x4*)(PW + 4);
    q.kk = *(const u32x4*)((const bf16_t*)(ws + OFF_PKK) + okv); q.b = *(const u32x4*)((const bf16_t*)(ws + OFF_PB) + okv);
    if (NEED_KM) { q.km = *(const u32x4*)((const bf16_t*)(ws + OFF_PKM) + okv); q.v = *(const u32x4*)((const bf16_t*)(ws + OFF_PV) + ov); }
    if (NEED_R) q.r = *(const u32x4*)((const bf16_t*)(ws + OFF_PR) + okv);
    return q;
}
#define RW_PAIR(vec, q) ((f32x2){(vec)[(q) >> 1][((q) & 1) * 2], (vec)[(q) >> 1][((q) & 1) * 2 + 1]})
#define RW_PAIRH(u, q) ((f32x2){__uint_as_float((u)[q] << 16), __uint_as_float((u)[q] & 0xffff0000u)})
template <int MODE>
__device__ __forceinline__ void rw_step(f32x2 (&s)[8][4], const RwVec& q) {
    float sa[8];
    { f32x2 kk2[4];
#pragma unroll
      for (int p = 0; p < 4; ++p) kk2[p] = RW_PAIRH(q.kk, p);
#pragma unroll
      for (int vi = 0; vi < 8; ++vi) { f32x2 a = s[vi][0] * kk2[0];
#pragma unroll
        for (int p = 1; p < 4; ++p) a += s[vi][p] * kk2[p];
        sa[vi] = -red8(a.x + a.y); } }
    f32x2 b2[4], km2[4];
#pragma unroll
    for (int p = 0; p < 4; ++p) { b2[p] = RW_PAIRH(q.b, p); km2[p] = MODE ? RW_PAIRH(q.km, p) : (f32x2){0.f, 0.f}; }
#pragma unroll
    for (int vi = 0; vi < 8; ++vi) {
        const float vv = MODE ? __uint_as_float((vi & 1) ? (q.v[vi >> 1] & 0xffff0000u) : (q.v[vi >> 1] << 16)) : 0.f;
        const f32x2 sa2 = {sa[vi], sa[vi]}, vv2 = {vv, vv};
#pragma unroll
        for (int p = 0; p < 4; ++p) { f32x2 t = sa2 * b2[p]; if (MODE) t += vv2 * km2[p];
            s[vi][p] = s[vi][p] * RW_PAIR(q.w, p) + t; } }
}
template <int MODE>
__device__ __forceinline__ void rwkv_pass1_part(const unsigned char* ws, int wv, int lane) {
    const int vg = lane >> 3, kg = lane & 7;
    for (int u = obid() * 4 + wv; u < 8 * NCH; u += gridDim.x * 4) {
        const int c = u >> 3, h = u & 7;
        f32x2 s[8][4];
#pragma unroll
        for (int vi = 0; vi < 8; ++vi)
#pragma unroll
            for (int p = 0; p < 4; ++p) { s[vi][p].x = (!MODE && vg == kg && vi == 2 * p) ? 1.f : 0.f; s[vi][p].y = (!MODE && vg == kg && vi == 2 * p + 1) ? 1.f : 0.f; }
        const size_t o0 = (size_t)c * LCH * 512 + h * 64, okv = o0 + kg * 8, ov = o0 + vg * 8;
        RwVec A = rw_load<MODE != 0, false>(ws, okv, ov), B = rw_load<MODE != 0, false>(ws, okv + 512, ov + 512), C;
        int i = 0;
        for (; i + 3 <= LCH; i += 3) {
            { const size_t d = (size_t)(i + 2 < LCH ? i + 2 : LCH - 1) * 512; C = rw_load<MODE != 0, false>(ws, okv + d, ov + d); }
            rw_step<MODE>(s, A);
            { const size_t d = (size_t)(i + 3 < LCH ? i + 3 : LCH - 1) * 512; A = rw_load<MODE != 0, false>(ws, okv + d, ov + d); }
            rw_step<MODE>(s, B);
            { const size_t d = (size_t)(i + 4 < LCH ? i + 4 : LCH - 1) * 512; B = rw_load<MODE != 0, false>(ws, okv + d, ov + d); }
            rw_step<MODE>(s, C);
        }
        if (i < LCH) rw_step<MODE>(s, A);
        if (i + 1 < LCH) rw_step<MODE>(s, B);
        if (!MODE) {
            bf16_t* pp = (bf16_t*)(const_cast<unsigned char*>(ws) + OFF_PP) + (size_t)(h * NCH + c) * 4096 + vg * 8;
#pragma unroll
            for (int ki = 0; ki < 8; ++ki) { u32x4 w4;
#pragma unroll
                for (int e = 0; e < 4; ++e) { const float lo = (ki & 1) ? s[2 * e][ki >> 1].y : s[2 * e][ki >> 1].x, hi = (ki & 1) ? s[2 * e + 1][ki >> 1].y : s[2 * e + 1][ki >> 1].x; w4[e] = cvt_pk_bf16(lo, hi); }
                *(u32x4*)(pp + (kg * 8 + ki) * 64) = w4; }
        } else {
            float* pl = (float*)(const_cast<unsigned char*>(ws) + OFF_PL) + (size_t)(h * NCH + c) * 4096 + kg * 8;
#pragma unroll
            for (int vi = 0; vi < 8; ++vi) { *(f32x4*)(pl + (vg * 8 + vi) * 64) = (f32x4){s[vi][0].x, s[vi][0].y, s[vi][1].x, s[vi][1].y}; *(f32x4*)(pl + (vg * 8 + vi) * 64 + 4) = (f32x4){s[vi][2].x, s[vi][2].y, s[vi][3].x, s[vi][3].y}; }
        }
    }
}
__device__ __forceinline__ void rwkv_pass1(KP P) {
    const unsigned char* ws = P->ws;
    const int wave = otid() >> 6, lane = otid() & 63;
    if (wave < 4) rwkv_pass1_part<0>(ws, wave, lane); else rwkv_pass1_part<1>(ws, wave - 4, lane);
}
__device__ __forceinline__ void rwkv_cscan(KP P, unsigned char* sm) {
    unsigned char* ws = P->ws;
    bf16_t* Sb = (bf16_t*)sm;
    const int tid = otid(), wave = tid >> 6, lane = tid & 63, nt = wave & 3, mt0 = (wave >> 2) * 2, lr = lane & 15, lq = lane >> 4;
    const bf16_t* PPT = (const bf16_t*)(ws + OFF_PP); float* PL = (float*)(ws + OFF_PL);
    for (int h = obid(); h < 8; h += gridDim.x) {
        for (int i = tid; i < 64 * 72 / 2; i += 512) ((unsigned*)Sb)[i] = 0u;
        f32x4 mine[2] = {(f32x4){0.f, 0.f, 0.f, 0.f}, (f32x4){0.f, 0.f, 0.f, 0.f}};
        bf16x8 bfr[8][2]; f32x4 lv[8][2];
#define CS_LOAD(dstb, dstl, cc) do { const size_t _b = (size_t)(h * NCH + (cc)) * 4096; \
            _Pragma("unroll") for (int ks = 0; ks < 2; ++ks) dstb[ks] = *(const bf16x8*)(PPT + _b + (nt * 16 + lr) * 64 + ks * 32 + lq * 8); \
            _Pragma("unroll") for (int i = 0; i < 2; ++i) _Pragma("unroll") for (int q = 0; q < 4; ++q) dstl[i][q] = PL[_b + ((mt0 + i) * 16 + lq * 4 + q) * 64 + nt * 16 + lr]; } while (0)
#pragma unroll
        for (int g = 0; g < 8; ++g) CS_LOAD(bfr[g], lv[g], g);
        __syncthreads();
        for (int c0 = 0; c0 < NCH; c0 += 8) {
#pragma unroll
            for (int g = 0; g < 8; ++g) {
                const size_t base = (size_t)(h * NCH + c0 + g) * 4096;
                f32x4 acc[2] = {lv[g][0], lv[g][1]};
#pragma unroll
                for (int ks = 0; ks < 2; ++ks)
#pragma unroll
                    for (int i = 0; i < 2; ++i) { const bf16x8 af = *(const bf16x8*)(Sb + ((mt0 + i) * 16 + lr) * 72 + ks * 32 + lq * 8);
                        acc[i] = __builtin_amdgcn_mfma_f32_16x16x32_bf16(af, bfr[g][ks], acc[i], 0, 0, 0); }
#pragma unroll
                for (int i = 0; i < 2; ++i)
#pragma unroll
                    for (int q = 0; q < 4; ++q) PL[base + ((mt0 + i) * 16 + lq * 4 + q) * 64 + nt * 16 + lr] = mine[i][q];
                mine[0] = acc[0]; mine[1] = acc[1];
                { const int cn = c0 + g + 8 < NCH ? c0 + g + 8 : NCH - 1; CS_LOAD(bfr[g], lv[g], cn); }
                asm volatile("s_waitcnt lgkmcnt(0)\n\ts_barrier" ::: "memory");
#pragma unroll
                for (int i = 0; i < 2; ++i)
#pragma unroll
                    for (int q = 0; q < 4; ++q) Sb[((mt0 + i) * 16 + lq * 4 + q) * 72 + nt * 16 + lr] = f2bf(acc[i][q]);
                asm volatile("s_waitcnt lgkmcnt(0)\n\ts_barrier" ::: "memory");
            }
        }
#undef CS_LOAD
    }
}
__device__ __forceinline__ void rw_out(f32x2 (&s)[8][4], const RwVec& q, int kg, float* yraw) {
    float yo = 0.f;
    f32x2 r2[4];
#pragma unroll
    for (int p = 0; p < 4; ++p) r2[p] = RW_PAIRH(q.r, p);
#pragma unroll
    for (int vi = 0; vi < 8; ++vi) { f32x2 a = s[vi][0] * r2[0];
#pragma unroll
        for (int p = 1; p < 4; ++p) a += s[vi][p] * r2[p];
        const float yv = red8(a.x + a.y); yo = (kg == vi) ? yv : yo; }
    *yraw = yo;
}
__device__ __forceinline__ void rwkv_pass2(KP P) {
    const unsigned char* ws = P->ws;
    const int wave = otid() >> 6, lane = otid() & 63, vg = lane >> 3, kg = lane & 7;
    if (wave >= 4) return;
    for (int u = obid() * 4 + wave; u < 8 * NCH; u += gridDim.x * 4) {
        const int c = u >> 3, h = u & 7;
        float* yr = (float*)(const_cast<unsigned char*>(ws) + OFF_ZRW) + (size_t)c * LCH * 512 + h * 64 + lane;
        f32x2 s[8][4];
        { const float* pl = (const float*)(ws + OFF_PL) + (size_t)(h * NCH + c) * 4096 + kg * 8;
#pragma unroll
          for (int vi = 0; vi < 8; ++vi) { const f32x4 a = *(const f32x4*)(pl + (vg * 8 + vi) * 64), b = *(const f32x4*)(pl + (vg * 8 + vi) * 64 + 4);
              s[vi][0] = (f32x2){a[0], a[1]}; s[vi][1] = (f32x2){a[2], a[3]}; s[vi][2] = (f32x2){b[0], b[1]}; s[vi][3] = (f32x2){b[2], b[3]}; } }
        const int t0 = c * LCH;
        const size_t o0 = (size_t)t0 * 512 + h * 64, okv = o0 + kg * 8, ov = o0 + vg * 8;
        RwVec A = rw_load<true, true>(ws, okv, ov), B = rw_load<true, true>(ws, okv + 512, ov + 512), C;
        int i = 0;
        for (; i + 3 <= LCH; i += 3) {
            { const size_t d = (size_t)(i + 2 < LCH ? i + 2 : LCH - 1) * 512; C = rw_load<true, true>(ws, okv + d, ov + d); }
            rw_step<1>(s, A); rw_out(s, A, kg, yr + (size_t)(i) * 512);
            { const size_t d = (size_t)(i + 3 < LCH ? i + 3 : LCH - 1) * 512; A = rw_load<true, true>(ws, okv + d, ov + d); }
            rw_step<1>(s, B); rw_out(s, B, kg, yr + (size_t)(i + 1) * 512);
            { const size_t d = (size_t)(i + 4 < LCH ? i + 4 : LCH - 1) * 512; B = rw_load<true, true>(ws, okv + d, ov + d); }
            rw_step<1>(s, C); rw_out(s, C, kg, yr + (size_t)(i + 2) * 512);
        }
        if (i < LCH) { rw_step<1>(s, A); rw_out(s, A, kg, yr + (size_t)(i) * 512); }
        if (i + 1 < LCH) { rw_step<1>(s, B); rw_out(s, B, kg, yr + (size_t)(i + 1) * 512); }
    }
}

__device__ __forceinline__ void rw_post(KP P, int l) {
    const unsigned char* ws = P->ws;
    const int lane = otid() & 63, gw = obid() * 8 + (otid() >> 6), nw = gridDim.x * 8;
    const float* YR = (const float*)(ws + OFF_ZRW); const bf16_t* PV = (const bf16_t*)(ws + OFF_PV); const float* BON = (const float*)(ws + OFF_BON);
    bf16_t* ZG = (bf16_t*)(const_cast<unsigned char*>(ws) + OFF_ZG);
    const float* lngp = (const float*)P->in[13] + l * 512; const float* lnbp = (const float*)P->in[14] + l * 512;
    for (int task0 = gw; task0 < TB * 8; task0 += 4 * nw) {
        float y[4], vv[4], bon[4], gg[4];
#pragma unroll
        for (int q = 0; q < 4; ++q) { const int task = task0 + q * nw; const int t = task >> 3, h = task & 7, col = h * 64 + lane;
            y[q] = YR[(size_t)t * 512 + col]; vv[q] = bf2f(PV[(size_t)t * 512 + col]); bon[q] = BON[(size_t)t * 8 + h]; gg[q] = bf2f(ZG[(size_t)t * 2048 + col]); }
#pragma unroll
        for (int q = 0; q < 4; ++q) { const int task = task0 + q * nw; const int t = task >> 3, h = task & 7, col = h * 64 + lane;
            const float mean = wave_total_from_groups(red8(y[q])) * (1.0f / 64.0f); const float d = y[q] - mean;
            const float var = wave_total_from_groups(red8(d * d)) * (1.0f / 64.0f);
            const float yn = d * rsqrtf(var + 64e-5f) * lngp[col] + lnbp[col] + bon[q] * vv[q];
            ZG[(size_t)t * 2048 + col] = f2bf(yn * siluf_(gg[q])); }
    }
}

__device__ __forceinline__ void rope_cs(int i, float posf, float& cs, float& sn) {
    const float inv = (float)exp2(-(double)i * (13.287712379549449 / 32.0));
    const float ang = posf * inv;
    const double a = (double)ang; const double kq = rint(a * 0.15915494309189535); const float r = (float)(a - kq * 6.283185307179586);
    cs = __cosf(r); sn = __sinf(r);
}
__device__ __forceinline__ void rope_table(KP P) {
    float* tab = (float*)(P->ws + OFF_ROPE); const int* pos = (const int*)P->in[2];
    for (int i = obid() * 512 + otid(); i < 2 * TB * 32; i += gridDim.x * 512) {
        float cs, sn; rope_cs(i & 31, (float)pos[i >> 5], cs, sn);
        *(f32x2*)(tab + (size_t)i * 2) = (f32x2){cs, sn}; }
}
struct GrRaw { u32x4 flo[2]; u32x4 qa, qb, ka, kb; f32x4 cs[4]; u32x4 v[2]; };
template <bool NEED_Q>
__device__ __forceinline__ GrRaw gr_load_raw(KP P, int b, int kind, int tg, int h, int dg) {
    GrRaw r;
    if (kind == 0) {
        const bf16_t* z = (const bf16_t*)(P->ws + OFF_ZGLA) + (size_t)tg * 1280;
        r.flo[0] = *(const u32x4*)(z + 1024); r.flo[1] = *(const u32x4*)(z + 1032);
        if (NEED_Q) r.qa = *(const u32x4*)(z + h * 64 + dg * 8);
        r.ka = *(const u32x4*)(z + 256 + h * 64 + dg * 8);
        r.v[0] = *(const u32x4*)(z + 512 + h * 128 + dg * 16); r.v[1] = *(const u32x4*)(z + 512 + h * 128 + dg * 16 + 8);
    } else {
        const bf16_t* z = (const bf16_t*)(P->ws + OFF_ZRET) + (size_t)tg * 1024; const int i0 = (dg & 3) * 8;
        if (NEED_Q) { r.qa = *(const u32x4*)(z + h * 64 + i0); r.qb = *(const u32x4*)(z + h * 64 + i0 + 32); }
        r.ka = *(const u32x4*)(z + 256 + h * 64 + i0); r.kb = *(const u32x4*)(z + 256 + h * 64 + i0 + 32);
        const float* tab = (const float*)(P->ws + OFF_ROPE) + (((size_t)b * TB + tg) * 32 + i0) * 2;
#pragma unroll
        for (int e = 0; e < 4; ++e) r.cs[e] = *(const f32x4*)(tab + 4 * e);
        r.v[0] = *(const u32x4*)(z + 512 + h * 128 + dg * 16); r.v[1] = *(const u32x4*)(z + 512 + h * 128 + dg * 16 + 8);
    }
    return r;
}
__device__ __forceinline__ float bfel(const u32x4& u, int dd) { return __uint_as_float((dd & 1) ? (u[dd >> 1] & 0xffff0000u) : (u[dd >> 1] << 16)); }
__device__ __forceinline__ float gr_val(const GrRaw& r, int kind, int dg, int dd, const u32x4& a, const u32x4& bq) {
    if (kind == 0) return bfel(a, dd);
    const float x1 = bfel(a, dd), x2 = bfel(bq, dd), cs = r.cs[dd >> 1][(dd & 1) * 2], sn = r.cs[dd >> 1][(dd & 1) * 2 + 1];
    return dg < 4 ? x1 * cs - x2 * sn : x1 * sn + x2 * cs;
}
__device__ __forceinline__ void gr_stage_b(KP P, int l, int kind, int h, const GrRaw& r, float* Bm) {
    const int tid = otid(), t = tid >> 3, dg = tid & 7;
    if (kind == 0) {
        float fl[16];
#pragma unroll
        for (int e = 0; e < 8; ++e) { fl[e] = bfel(r.flo[0], e); fl[8 + e] = bfel(r.flo[1], e); }
        const float* fup = (const float*)P->in[15] + (size_t)l * 16 * 256; const float* fb = (const float*)P->in[16] + (size_t)l * 256;
#pragma unroll
        for (int dd = 0; dd < 8; ++dd) { const int d = dg * 8 + dd; float x = fb[h * 64 + d];
#pragma unroll
            for (int j = 0; j < 16; ++j) x += fl[j] * fup[j * 256 + h * 64 + d];
            Bm[t * 64 + d] = -softplusf_(-x) * (1.0f / 16.0f); }
    } else {
        const float lg = __logf(1.0f - exp2f(-5.0f - (float)h)) * (float)(t + 1);
#pragma unroll
        for (int dd = 0; dd < 8; ++dd) Bm[t * 64 + dg * 8 + dd] = lg;
    }
    __syncthreads();
    if (kind == 0) {
        float* SEG = Bm + 64 * 64 + 25088;
        const int d = tid & 63, seg = tid >> 6;
        float run = 0.f;
#pragma unroll
        for (int q = 0; q < 8; ++q) { run += Bm[(seg * 8 + q) * 64 + d]; Bm[(seg * 8 + q) * 64 + d] = run; }
        SEG[seg * 64 + d] = run;
        __syncthreads();
        float off = 0.f;
#pragma unroll
        for (int q = 0; q < 7; ++q) off += (q < seg) ? SEG[q * 64 + d] : 0.f;
#pragma unroll
        for (int q = 0; q < 8; ++q) Bm[(seg * 8 + q) * 64 + d] += off;
        __syncthreads();
    }
}
__device__ __forceinline__ void gr_ds(KP P, int l, int b, unsigned char* sm, int bskip) {
    float* Bm = (float*)sm; bf16_t* KET = (bf16_t*)(sm + 16384); bf16_t* VT = (bf16_t*)(sm + 25600);
    const int tid = otid(), t = tid >> 3, dg = tid & 7, wave = tid >> 6, lane = tid & 63;
    float* DEC = (float*)(P->ws + OFF_DEC);
    for (int idx = obid() - bskip; idx < 2048; idx += gridDim.x - bskip) {
        const int kind = idx >> 10, n = (idx >> 2) & 255, h = idx & 3, tg = n * 64 + t;
        const GrRaw raw = gr_load_raw<false>(P, b, kind, tg, h, dg);
        gr_stage_b(P, l, kind, h, raw, Bm);
#pragma unroll
        for (int dd = 0; dd < 8; ++dd) { const int d = dg * 8 + dd; const float bl = Bm[63 * 64 + d], bt = Bm[t * 64 + d];
            float kv = gr_val(raw, kind, dg, dd, raw.ka, raw.kb); if (kind == 1) kv *= 0.125f;
            KET[d * 72 + t] = f2bf(kv * __expf(bl - bt));
            if (t == 63 && kind == 0) DEC[(size_t)(n * 4 + h) * 64 + d] = __expf(bl); }
#pragma unroll
        for (int e = 0; e < 16; ++e) VT[(dg * 16 + e) * 72 + (t ^ (dg << 3))] = (bf16_t)((e & 1) ? (raw.v[e >> 3][(e >> 1) & 3] >> 16) : (raw.v[e >> 3][(e >> 1) & 3] & 0xffffu));
        __syncthreads();
        f32x4 acc[4];
#pragma unroll
        for (int mt = 0; mt < 4; ++mt) acc[mt] = (f32x4){0.f, 0.f, 0.f, 0.f};
#pragma unroll
        for (int ks = 0; ks < 2; ++ks) { const bf16x8 bf = *(const bf16x8*)(VT + (wave * 16 + (lane & 15)) * 72 + ((ks * 32 + (lane >> 4) * 8) ^ (wave << 3)));
#pragma unroll
            for (int mt = 0; mt < 4; ++mt) { const bf16x8 af = *(const bf16x8*)(KET + (mt * 16 + (lane & 15)) * 72 + ks * 32 + (lane >> 4) * 8);
                acc[mt] = __builtin_amdgcn_mfma_f32_16x16x32_bf16(af, bf, acc[mt], 0, 0, 0); } }
        bf16_t* dsp = (bf16_t*)(P->ws + (kind ? OFF_DSG1 : OFF_DSG0)) + ((size_t)n * 4 + h) * 64 * 128;
#pragma unroll
        for (int mt = 0; mt < 4; ++mt)
#pragma unroll
            for (int j = 0; j < 4; ++j) dsp[(size_t)(mt * 16 + (lane >> 4) * 4 + j) * 128 + wave * 16 + (lane & 15)] = f2bf(acc[mt][j]);
        __syncthreads();
    }
}
__device__ __forceinline__ void gr_scan(KP P, int tid256  ) {
    const float* DEC = (const float*)(P->ws + OFF_DEC);
    for (int blk = obid(); blk < 258; blk += gridDim.x) {
        if (blk < 256) {
            const int gid = blk * 256 + tid256, kind = gid >> 15, e = gid & 32767, h = e >> 13, d = (e >> 7) & 63, vch = e & 127;
            bf16_t* DS = (bf16_t*)(P->ws + (kind ? OFF_DSG1 : OFF_DSG0));
            const float rdec = __expf(64.0f * __logf(1.0f - exp2f(-5.0f - (float)h)));
            float st = 0.f;
            for (int n0 = 0; n0 < 256; n0 += 16) {
                float dsv[16], dc[16];
#pragma unroll
                for (int q = 0; q < 16; ++q) { const int n = n0 + q; dsv[q] = bf2f(DS[(((size_t)n * 4 + h) * 64 + d) * 128 + vch]); dc[q] = kind == 0 ? DEC[(size_t)(n * 4 + h) * 64 + d] : rdec; }
#pragma unroll
                for (int q = 0; q < 16; ++q) { const int n = n0 + q; DS[(((size_t)n * 4 + h) * 64 + d) * 128 + vch] = f2bf(st); st = st * dc[q] + dsv[q]; }
            }
        } else {
            const float* AC = (const float*)(P->ws + OFF_AC); const float* HC = (const float*)(P->ws + OFF_HC); float* HIN = (float*)(P->ws + OFF_HIN);
            const int d = (blk - 256) * 256 + tid256; float hin = 0.f;
            for (int n0 = 0; n0 < 256; n0 += 32) {
                float av[32], hv[32];
#pragma unroll
                for (int q = 0; q < 32; ++q) { av[q] = AC[(n0 + q) * 512 + d]; hv[q] = HC[(n0 + q) * 512 + d]; }
#pragma unroll
                for (int q = 0; q < 32; ++q) { HIN[(n0 + q) * 512 + d] = hin; hin = av[q] * hin + hv[q]; }
            }
        }
    }
}
__device__ __forceinline__ void gr_out(KP P, int l, int b, unsigned char* sm, bf16_t* yout, int ystride) {
    float* Bm = (float*)sm; bf16_t* QD = (bf16_t*)(sm + 16384); bf16_t* KD = (bf16_t*)(sm + 25600); bf16_t* ATT = (bf16_t*)(sm + 34816);
    bf16_t* VT = (bf16_t*)(sm + 44032); bf16_t* ST = (bf16_t*)(sm + 62464); float* O = (float*)(sm + 80896);
    const int tid = otid(), t = tid >> 3, dg = tid & 7, wave = tid >> 6, lane = tid & 63;
    bf16_t* ZG = (bf16_t*)(P->ws + OFF_ZG);
    for (int idx = obid(); idx < 2048; idx += gridDim.x) {
        const int kind = idx >> 10, n = (idx >> 2) & 255, h = idx & 3, tg = n * 64 + t;
        const GrRaw raw = gr_load_raw<true>(P, b, kind, tg, h, dg);
        u32x4 stv[2];
        { const bf16_t* dsp = (const bf16_t*)(P->ws + (kind ? OFF_DSG1 : OFF_DSG0)) + ((size_t)n * 4 + h) * 64 * 128 + tid * 16;
          stv[0] = *(const u32x4*)dsp; stv[1] = *(const u32x4*)(dsp + 8); }
        bf16_t* gp = ZG + (size_t)tg * 2048 + (kind == 0 ? 512 : 1024) + h * 128 + dg * 16;
        const u32x4 g0 = *(const u32x4*)gp, g1 = *(const u32x4*)(gp + 8);
        gr_stage_b(P, l, kind, h, raw, Bm);
#pragma unroll
        for (int dd = 0; dd < 8; ++dd) { const int d = dg * 8 + dd; const float bt = Bm[t * 64 + d];
            float qv = gr_val(raw, kind, dg, dd, raw.qa, raw.qb), kv = gr_val(raw, kind, dg, dd, raw.ka, raw.kb);
            if (kind == 0) qv *= 0.125f; else kv *= 0.125f;
            QD[t * 72 + d] = f2bf(qv * __expf(bt)); KD[t * 72 + d] = f2bf(kv * __expf(-bt)); }
#pragma unroll
        for (int e = 0; e < 16; ++e) VT[(dg * 16 + e) * 72 + (t ^ (dg << 3))] = (bf16_t)((e & 1) ? (raw.v[e >> 3][(e >> 1) & 3] >> 16) : (raw.v[e >> 3][(e >> 1) & 3] & 0xffffu));
#pragma unroll
        for (int e = 0; e < 16; ++e) ST[(dg * 16 + e) * 72 + (t ^ (dg << 3))] = (bf16_t)((e & 1) ? (stv[e >> 3][(e >> 1) & 3] >> 16) : (stv[e >> 3][(e >> 1) & 3] & 0xffffu));
        __syncthreads();
        {
            const int nt = wave & 3, mt0 = (wave >> 2) * 2;
            f32x4 a2[2] = {(f32x4){0.f, 0.f, 0.f, 0.f}, (f32x4){0.f, 0.f, 0.f, 0.f}};
#pragma unroll
            for (int ks = 0; ks < 2; ++ks) { const bf16x8 bf = *(const bf16x8*)(KD + (nt * 16 + (lane & 15)) * 72 + ks * 32 + (lane >> 4) * 8);
#pragma unroll
                for (int i = 0; i < 2; ++i) { const bf16x8 af = *(const bf16x8*)(QD + ((mt0 + i) * 16 + (lane & 15)) * 72 + ks * 32 + (lane >> 4) * 8);
                    a2[i] = __builtin_amdgcn_mfma_f32_16x16x32_bf16(af, bf, a2[i], 0, 0, 0); } }
#pragma unroll
            for (int i = 0; i < 2; ++i)
#pragma unroll
                for (int j = 0; j < 4; ++j) { const int tt = (mt0 + i) * 16 + (lane >> 4) * 4 + j, ss = nt * 16 + (lane & 15);
                    ATT[tt * 72 + ss] = f2bf(ss <= tt ? a2[i][j] : 0.f); }
        }
        __syncthreads();
        {
            f32x4 acc[4];
#pragma unroll
            for (int mt = 0; mt < 4; ++mt) acc[mt] = (f32x4){0.f, 0.f, 0.f, 0.f};
#pragma unroll
            for (int ks = 0; ks < 2; ++ks) {
                const bf16x8 b1 = *(const bf16x8*)(VT + (wave * 16 + (lane & 15)) * 72 + ((ks * 32 + (lane >> 4) * 8) ^ (wave << 3)));
                const bf16x8 b2 = *(const bf16x8*)(ST + (wave * 16 + (lane & 15)) * 72 + ((ks * 32 + (lane >> 4) * 8) ^ (wave << 3)));
#pragma unroll
                for (int mt = 0; mt < 4; ++mt) {
                    const bf16x8 a1 = *(const bf16x8*)(ATT + (mt * 16 + (lane & 15)) * 72 + ks * 32 + (lane >> 4) * 8);
                    const bf16x8 aq = *(const bf16x8*)(QD + (mt * 16 + (lane & 15)) * 72 + ks * 32 + (lane >> 4) * 8);
                    acc[mt] = __builtin_amdgcn_mfma_f32_16x16x32_bf16(a1, b1, acc[mt], 0, 0, 0);
                    acc[mt] = __builtin_amdgcn_mfma_f32_16x16x32_bf16(aq, b2, acc[mt], 0, 0, 0); } }
#pragma unroll
            for (int mt = 0; mt < 4; ++mt)
#pragma unroll
                for (int j = 0; j < 4; ++j) O[(mt * 16 + (lane >> 4) * 4 + j) * 132 + wave * 16 + (lane & 15)] = acc[mt][j];
        }
        __syncthreads();
        {
            float v[16]; float s1 = 0.f, s2 = 0.f;
#pragma unroll
            for (int e = 0; e < 16; ++e) { v[e] = O[t * 132 + dg * 16 + e]; s1 += v[e]; s2 += v[e] * v[e]; }
#pragma unroll
            for (int o = 1; o <= 4; o <<= 1) { s1 += shx(s1, lane, o); s2 += shx(s2, lane, o); }
            float mean = 0.f, rs;
            if (kind == 0) rs = rsqrtf(s2 * (1.0f / 128.0f) + 1e-6f);
            else { mean = s1 * (1.0f / 128.0f); const float var = fmaxf(s2 * (1.0f / 128.0f) - mean * mean, 0.f); rs = rsqrtf(var + 1e-6f); }
            const float* gn = (kind == 0 ? (const float*)P->in[17] : (const float*)P->in[18]) + (size_t)l * 512 + h * 128 + dg * 16;
            float gv[16];
#pragma unroll
            for (int e = 0; e < 4; ++e) { gv[2 * e] = __uint_as_float(g0[e] << 16); gv[2 * e + 1] = __uint_as_float(g0[e] & 0xffff0000u); gv[8 + 2 * e] = __uint_as_float(g1[e] << 16); gv[8 + 2 * e + 1] = __uint_as_float(g1[e] & 0xffff0000u); }
            float r[16];
#pragma unroll
            for (int e = 0; e < 16; ++e) r[e] = (v[e] - mean) * rs * gn[e] * siluf_(gv[e]);
            u32x4 w0, w1;
            w0.x = cvt_pk_bf16(r[0], r[1]); w0.y = cvt_pk_bf16(r[2], r[3]); w0.z = cvt_pk_bf16(r[4], r[5]); w0.w = cvt_pk_bf16(r[6], r[7]);
            w1.x = cvt_pk_bf16(r[8], r[9]); w1.y = cvt_pk_bf16(r[10], r[11]); w1.z = cvt_pk_bf16(r[12], r[13]); w1.w = cvt_pk_bf16(r[14], r[15]);
            { bf16_t* op = yout + (size_t)tg * ystride + (kind == 0 ? 512 : 1024) + h * 128 + dg * 16; *(u32x4*)op = w0; *(u32x4*)(op + 8) = w1; }
        }
        __syncthreads();
    }
}

__device__ __forceinline__ void lru_conv_w(KP P, int l) {
    bf16_t* WAT = (bf16_t*)(P->ws + OFF_WAT); bf16_t* WXT = (bf16_t*)(P->ws + OFF_WXT);
    const float* wa = (const float*)P->in[21] + (size_t)l * 8 * 4096; const float* wx = (const float*)P->in[23] + (size_t)l * 8 * 4096;
    for (int idx = obid() * 512 + otid(); idx < 8 * 4096; idx += gridDim.x * 512) {
        const int n = idx >> 12, dd = (idx >> 6) & 63, c = idx & 63;
        WAT[idx] = f2bf(wa[(n * 64 + c) * 64 + dd]); WXT[idx] = f2bf(wx[(n * 64 + c) * 64 + dd]); }
}
__device__ __forceinline__ void lru_p1(KP P, int l, int n_first, int n_step, int n_end, unsigned char* sm) {
    unsigned char* ws = P->ws;
    bf16_t* XC = (bf16_t*)sm; float* OUTA = (float*)(sm + 16640); float* OUTX = (float*)(sm + 49408);
    const int d = otid(), lane = d & 63, blk = d >> 6, lr = lane & 15, lq = lane >> 4;
    const bf16_t* wat = (const bf16_t*)(ws + OFF_WAT) + (size_t)(blk * 64 + lr) * 64 + lq * 8; const bf16_t* wxt = (const bf16_t*)(ws + OFF_WXT) + (size_t)(blk * 64 + lr) * 64 + lq * 8;
    const float* cwp = (const float*)P->in[19] + (size_t)l * 4 * 512;
    const float cw0 = cwp[d], cw1 = cwp[512 + d], cw2 = cwp[1024 + d], cw3 = cwp[1536 + d], cb = ((const float*)P->in[20])[l * 512 + d];
    const float ba = ((const float*)P->in[22])[l * 512 + d], bx = ((const float*)P->in[24])[l * 512 + d];
    const float sp = softplusf_(-((const float*)P->in[25])[l * 512 + d]);
    const bf16_t* X = (const bf16_t*)(ws + OFF_ZLRU);
    bf16_t* HL = (bf16_t*)(ws + OFF_HL); bf16_t* CA = (bf16_t*)(ws + OFF_CA); float* AC = (float*)(ws + OFF_AC); float* HC = (float*)(ws + OFF_HC);
    for (int n = n_first; n < n_end; n += n_step) {
        const int t0 = n * 64;
        float x1 = 0.f, x2 = 0.f, x3 = 0.f;
        if (t0 > 0) { x1 = bf2f(X[(size_t)(t0 - 1) * 512 + d]); x2 = bf2f(X[(size_t)(t0 - 2) * 512 + d]); x3 = bf2f(X[(size_t)(t0 - 3) * 512 + d]); }
        float hloc = 0.f, cum = 1.f;
        bf16_t xa[16], xb[16];
#pragma unroll
        for (int q = 0; q < 16; ++q) xa[q] = X[(size_t)(t0 + q) * 512 + d];
        for (int tg = 0; tg < 4; ++tg) {
#pragma unroll
          for (int q = 0; q < 16; ++q) xb[q] = X[(size_t)(t0 + (tg < 3 ? tg + 1 : tg) * 16 + q) * 512 + d];
          const float h1 = x1, h2 = x2, h3 = x3;
#pragma unroll
          for (int q = 0; q < 16; ++q) { const float x0 = bf2f(xa[q]); XC[q * 520 + d] = f2bf(x3 * cw0 + x2 * cw1 + x1 * cw2 + x0 * cw3 + cb); x3 = x2; x2 = x1; x1 = x0; }
          __syncthreads();
          { const bf16x8 af0 = *(const bf16x8*)(XC + lr * 520 + blk * 64 + lq * 8), af1 = *(const bf16x8*)(XC + lr * 520 + blk * 64 + 32 + lq * 8);
#pragma unroll
            for (int nt = 0; nt < 4; ++nt) { f32x4 aa = {0.f, 0.f, 0.f, 0.f};
                aa = __builtin_amdgcn_mfma_f32_16x16x32_bf16(af0, *(const bf16x8*)(wat + nt * 1024), aa, 0, 0, 0); aa = __builtin_amdgcn_mfma_f32_16x16x32_bf16(af1, *(const bf16x8*)(wat + nt * 1024 + 32), aa, 0, 0, 0);
#pragma unroll
                for (int q = 0; q < 4; ++q) OUTA[(lq * 4 + q) * 512 + blk * 64 + nt * 16 + lr] = aa[q]; }
#pragma unroll
            for (int nt = 0; nt < 4; ++nt) { f32x4 ax = {0.f, 0.f, 0.f, 0.f};
                ax = __builtin_amdgcn_mfma_f32_16x16x32_bf16(af0, *(const bf16x8*)(wxt + nt * 1024), ax, 0, 0, 0); ax = __builtin_amdgcn_mfma_f32_16x16x32_bf16(af1, *(const bf16x8*)(wxt + nt * 1024 + 32), ax, 0, 0, 0);
#pragma unroll
                for (int q = 0; q < 4; ++q) OUTX[(lq * 4 + q) * 512 + blk * 64 + nt * 16 + lr] = ax[q]; } }
          __syncthreads();
          float g1 = h1, g2 = h2, g3 = h3;
#pragma unroll 4
          for (int q = 0; q < 16; ++q) {
            const int t = t0 + tg * 16 + q;
            const float ra = ba + OUTA[q * 512 + d], ri = bx + OUTX[q * 512 + d];
            const float r = sigmoidf_(ra), ig = sigmoidf_(ri);
            const float la = -8.0f * r * sp; const float a = __expf(la);
            const float x2l = 2.0f * la;
            const float om = x2l > -0.02f ? -(x2l * (1.0f + x2l * (0.5f + x2l * (1.0f / 6.0f)))) : 1.0f - a * a;
            const float x0 = bf2f(xa[q]); const float xcq = g3 * cw0 + g2 * cw1 + g1 * cw2 + x0 * cw3 + cb; g3 = g2; g2 = g1; g1 = x0;
            const float uu = __builtin_amdgcn_sqrtf(fmaxf(om, 0.f)) * (ig * xcq);
            hloc = a * hloc + uu; cum *= a;
            HL[(size_t)t * 512 + d] = f2bf(hloc); CA[(size_t)t * 512 + d] = f2bf(cum);
          }
          __syncthreads();
#pragma unroll
          for (int q = 0; q < 16; ++q) xa[q] = xb[q];
        }
        AC[n * 512 + d] = cum; HC[n * 512 + d] = hloc;
    }
}
__device__ __forceinline__ void lru_p3(KP P, bf16_t* yout, int ystride) {
    unsigned char* ws = P->ws;
    const bf16_t* HL = (const bf16_t*)(ws + OFF_HL); const bf16_t* CA = (const bf16_t*)(ws + OFF_CA); const float* HIN = (const float*)(ws + OFF_HIN);
    bf16_t* ZG = (bf16_t*)(ws + OFF_ZG);
    const int total = TB * 128, stride = (int)gridDim.x * 512;
    for (int i0 = obid() * 512 + otid(); i0 < total; i0 += 4 * stride) {
        u32x2 hq[4], cq[4], gq[4]; f32x4 hi[4];
#pragma unroll
        for (int q = 0; q < 4; ++q) { const int i = i0 + q * stride; const int t = i >> 7, d4 = (i & 127) * 4;
            hq[q] = *(const u32x2*)(HL + (size_t)t * 512 + d4); cq[q] = *(const u32x2*)(CA + (size_t)t * 512 + d4); hi[q] = *(const f32x4*)(HIN + (size_t)(t >> 6) * 512 + d4);
            gq[q] = *(const u32x2*)(ZG + (size_t)t * 2048 + 1536 + d4); }
#pragma unroll
        for (int q = 0; q < 4; ++q) { const int i = i0 + q * stride; const int t = i >> 7, d4 = (i & 127) * 4;
            const f32x4 hl = {__uint_as_float(hq[q].x << 16), __uint_as_float(hq[q].x & 0xffff0000u), __uint_as_float(hq[q].y << 16), __uint_as_float(hq[q].y & 0xffff0000u)};
            const f32x4 ca = {__uint_as_float(cq[q].x << 16), __uint_as_float(cq[q].x & 0xffff0000u), __uint_as_float(cq[q].y << 16), __uint_as_float(cq[q].y & 0xffff0000u)};
            const float g0 = __uint_as_float(gq[q].x << 16), g1 = __uint_as_float(gq[q].x & 0xffff0000u), g2 = __uint_as_float(gq[q].y << 16), g3 = __uint_as_float(gq[q].y & 0xffff0000u);
            u32x2 w; w.x = cvt_pk_bf16((hl[0] + ca[0] * hi[q][0]) * siluf_(g0), (hl[1] + ca[1] * hi[q][1]) * siluf_(g1));
            w.y = cvt_pk_bf16((hl[2] + ca[2] * hi[q][2]) * siluf_(g2), (hl[3] + ca[3] * hi[q][3]) * siluf_(g3));
            *(u32x2*)(yout + (size_t)t * ystride + 1536 + d4) = w; }
    }
}

#define XB_TMO      128
#define XB_XCNT(j)  (256  + 64 * (j))
#define XB_XSUB(j)  (1280 + 64 * (j))
#define XB_XGEN(j)  (2304 + 64 * (j))
#define XB_TOP      3328
#define XB_TOPGEN   3392
#define XCD_BAR_WORDS 3456
#define XB_SPIN_CAP (1u << 22)
__device__ __forceinline__ unsigned xb_ld(unsigned* p)              { return __hip_atomic_load(p, __ATOMIC_RELAXED, __HIP_MEMORY_SCOPE_AGENT); }
__device__ __forceinline__ unsigned xb_add(unsigned* p, unsigned v) { return __hip_atomic_fetch_add(p, v, __ATOMIC_RELAXED, __HIP_MEMORY_SCOPE_AGENT); }
__device__ __forceinline__ unsigned xb_xcc_id() { return (unsigned)__builtin_amdgcn_s_getreg((3 << 11) | 20) & 0xFu; }
#define XB_SPIN(cond, bar) do { unsigned _sp = 0; while (cond) { __builtin_amdgcn_s_sleep(1); \
    if ((++_sp & 255u) == 0u) { if (xb_ld(&(bar)[XB_TMO])) break; if (_sp > XB_SPIN_CAP) { atomicAdd(&(bar)[XB_TMO], 1u); break; } } } } while (0)
struct XcdBarrier { unsigned* bar; unsigned x; volatile LAS unsigned* st; };
__device__ __forceinline__ XcdBarrier xcd_barrier_post(unsigned* bar, volatile LAS unsigned* st) {
    XcdBarrier b; b.bar = bar; b.x = xb_xcc_id(); b.st = st;
    if (threadIdx.x == 0) (void)xb_add(&bar[XB_XCNT(b.x)], 1u);
    return b;
}
__device__ __forceinline__ void xcd_barrier_complete(unsigned* bar, unsigned x, unsigned& nloc, unsigned& nx) {
    const unsigned G = gridDim.x * gridDim.y * gridDim.z;
    unsigned sum, cnt, mine, sp = 0u;
    for (;;) {
        sum = 0u; cnt = 0u; mine = 0u;
#pragma unroll
        for (unsigned j = 0; j < 16; ++j) { const unsigned c = xb_ld(&bar[XB_XCNT(j)]); sum += c; cnt += (c > 0u) ? 1u : 0u; mine = (j == x) ? c : mine; }
        if (sum == G) break;
        __builtin_amdgcn_s_sleep(1);
        if ((++sp & 255u) == 0u) { if (xb_ld(&bar[XB_TMO])) break; if (sp > XB_SPIN_CAP) { atomicAdd(&bar[XB_TMO], 1u); break; } }
    }
    nloc = mine > 0u ? mine : 1u; nx = cnt > 0u ? cnt : 1u;
}
__device__ __forceinline__ void xcd_barrier(const XcdBarrier& b) {
    asm volatile("s_waitcnt vmcnt(0)" ::: "memory");
    __syncthreads();
    if (threadIdx.x == 0) {
        unsigned* bar = b.bar;
        __builtin_amdgcn_s_waitcnt(0);
        unsigned nloc = b.st[0], nx = b.st[1];
        if (nloc == 0u) { xcd_barrier_complete(bar, b.x, nloc, nx); b.st[0] = nloc; b.st[1] = nx; }
        const unsigned old = xb_add(&bar[XB_XSUB(b.x)], 1u);
        const unsigned gen = old / nloc;
        if (old + 1u == (gen + 1u) * nloc) {
            __builtin_amdgcn_fence(__ATOMIC_RELEASE, "agent");
            asm volatile("s_waitcnt vmcnt(0)" ::: "memory");
            const unsigned og = xb_add(&bar[XB_TOP], 1u);
            const unsigned tg = og / nx;
            if (og + 1u == (tg + 1u) * nx) xb_add(&bar[XB_TOPGEN], 1u);
            else XB_SPIN(xb_ld(&bar[XB_TOPGEN]) == tg, bar);
            __builtin_amdgcn_fence(__ATOMIC_ACQUIRE, "agent");
            xb_add(&bar[XB_XGEN(b.x)], 1u);
            asm volatile("s_waitcnt vmcnt(0)" ::: "memory");
        } else {
            XB_SPIN(xb_ld(&bar[XB_XGEN(b.x)]) == gen, bar);
            __builtin_amdgcn_fence(__ATOMIC_ACQUIRE, "agent");
            asm volatile("s_waitcnt vmcnt(0)" ::: "memory");
        }
    }
    __syncthreads();
}

__global__ void __launch_bounds__(512) fwd_megakernel(Params Parg) {
    extern __shared__ __attribute__((aligned(16))) unsigned char shm[];
    cg::grid_group grid = cg::this_grid();
    LAS unsigned char* lds = (LAS unsigned char*)shm;
    using namespace pg8;
    if (threadIdx.x < 4) ((volatile LAS unsigned*)(lds + STAGE_BYTES + 16384))[threadIdx.x] = 0u;
    __syncthreads();
    if (obid() == 0) { KP Pb = kparams(); u32x4* bw = (u32x4*)(Pb->ws + OFF_BAR); const int ti = otid(); bw[ti] = (u32x4){0u, 0u, 0u, 0u}; bw[ti + 512] = (u32x4){0u, 0u, 0u, 0u}; __threadfence(); }
    rope_table(kparams());
    grid.sync();
    { KP Pb = kparams(); (void)xcd_barrier_post((unsigned*)(Pb->ws + OFF_BAR), (volatile LAS unsigned*)(lds + STAGE_BYTES + 16384)); }
#ifndef DUP_GEMM
#define DUP_GEMM 1
#endif
#ifndef DUP_PREP
#define DUP_PREP 1
#endif
#ifndef DUP_P1
#define DUP_P1 1
#endif
#ifndef DUP_P2
#define DUP_P2 1
#endif
#ifndef DUP_GO
#define DUP_GO 1
#endif
#ifndef DUP_GR
#define DUP_GR 1
#endif
#ifndef DUP_MISC
#define DUP_MISC 1
#endif
#ifndef NSYNC
#define NSYNC 1
#endif
#define REP(n) _Pragma("nounroll") for (int _d = 0; _d < (n); ++_d)
#ifndef TP1
#define TP1 -1
#endif
#ifndef TP2
#define TP2 -1
#endif
    volatile LAS unsigned* tacc = (volatile LAS unsigned*)(lds + STAGE_BYTES + 16384 + 64);
    unsigned long long tlast = 0; int tslot = 0;
    if (TP1 >= 0) { if (threadIdx.x < 32) tacc[threadIdx.x] = 0u; __syncthreads(); tlast = wall_clock64(); }
#define TSTAMP() do { if (TP1 >= 0) { const unsigned long long _n = wall_clock64(); if (threadIdx.x == 0) tacc[tslot] += (unsigned)(_n - tlast); tlast = _n; ++tslot; } } while (0)
#ifndef SPIN_MASK
#define SPIN_MASK 0
#endif
    unsigned long long tphase = 0;
    if (SPIN_MASK) tphase = wall_clock64();
#define SPIN_BEFORE() do { if (SPIN_MASK) { if (((SPIN_MASK >> tslot) & 1) && threadIdx.x == 448) { const unsigned long long _t = wall_clock64(), _d = _t - tphase; while (wall_clock64() - _t < _d) __builtin_amdgcn_s_sleep(8); } } } while (0)
#define SPIN_AFTER() do { if (SPIN_MASK) { tphase = wall_clock64(); ++tslot; } } while (0)
#define GSYNC() do { SPIN_BEFORE(); REP(NSYNC) { KP Pb = kparams(); XcdBarrier xb_; xb_.bar = (unsigned*)(Pb->ws + OFF_BAR); xb_.x = xb_xcc_id(); xb_.st = (volatile LAS unsigned*)(lds + STAGE_BYTES + 16384); xcd_barrier(xb_); } TSTAMP(); SPIN_AFTER(); } while (0)
    for (int l = 0; l < 2; ++l) {
        { KP P = kparams(); unsigned char* ws = P->ws;
          conv_t<true>((bf16_t*)(ws + OFF_WIN), (const float*)P->in[4] + (size_t)l * 1024 * NIN, 10752, 1024, NIN); }
        for (int n = 0; n < 4; ++n) { KP P = kparams(); unsigned char* ws = P->ws;
          conv_t<false>((bf16_t*)(ws + OFF_WB) + (size_t)n * 1024 * 512, (const float*)P->in[26] + ((size_t)l * 4 + n) * 512 * 1024, 1024, 512, 1024); }
        { KP P = kparams(); unsigned char* ws = P->ws; conv_t<false>((bf16_t*)(ws + OFF_WOUT), (const float*)P->in[27] + (size_t)l * 1024 * 1024, 1024, 1024, 1024); }
        { KP P = kparams(); unsigned char* ws = P->ws; conv_t<false>((bf16_t*)(ws + OFF_WQ), (const float*)P->in[30] + (size_t)l * 1024 * 1024, 1024, 1024, 1024); }
        { KP P = kparams(); unsigned char* ws = P->ws; conv_t<false>((bf16_t*)(ws + OFF_WKV), (const float*)P->in[31] + (size_t)l * 1024 * 2048, 2048, 1024, 2048); }
        { KP P = kparams(); unsigned char* ws = P->ws; conv_t<false>((bf16_t*)(ws + OFF_WO), (const float*)P->in[32] + (size_t)l * 1024 * 1024, 1024, 1024, 1024); }
        { KP P = kparams(); unsigned char* ws = P->ws; conv_t<false>((bf16_t*)(ws + OFF_W2T), (const float*)P->in[7] + (size_t)l * 64 * 512, 512, 64, 512); }
        { KP P = kparams(); unsigned char* ws = P->ws; conv_t<false>((bf16_t*)(ws + OFF_A2T), (const float*)P->in[9] + (size_t)l * 64 * 512, 512, 64, 512); }
        lru_conv_w(kparams(), l);
        { KP P = kparams(); unsigned char* ws = P->ws; rmsnorm_bf16((const float*)P->in[1], (const float*)P->in[29] + l * 1024, (bf16_t*)(ws + OFF_MN), 512); }
        for (int b = 0; b < 2; ++b) {
            tslot = 0;
            { KP P = kparams(); unsigned char* ws = P->ws;
              const float* hin = (l == 0 ? (const float*)P->in[0] : (const float*)P->out) + (size_t)b * TB * DM;
              rmsnorm_bf16(hin, (const float*)P->in[3] + l * 1024, (bf16_t*)(ws + OFF_UN), TB); }
            GSYNC();
            if (b == 0) { KP P = kparams(); unsigned char* ws = P->ws;
                Order S; S.init(2, 8, 1, ws + OFF_MN, ws + OFF_WKV, 256L * 1024 * 2, 256L * 1024 * 2, 0, 0, 0);
                EpiKV E{(bf16_t*)(ws + OFF_KM), (bf16_t*)(ws + OFF_VT)}; gemm_phase(lds, Gemm{1024, 1024, 1024}, S, E); }
            REP(DUP_GEMM) { KP P = kparams(); unsigned char* ws = P->ws;
                Order S; S.init(64, 26, 1, ws + OFF_UN, ws + OFF_WIN, 256L * 1024 * 2, 256L * 1024 * 2, 0, 0, 0);
                EpiInproj E{ws}; gemm_phase(lds, Gemm{1024, 1024, 1024}, S, E); }
            GSYNC();
            REP(DUP_PREP) rwkv_prep(kparams(), l, shm);
            GSYNC();
            REP(DUP_P1) rwkv_pass1(kparams());
            GSYNC();
            if (blockIdx.x < 8) { rwkv_cscan(kparams(), shm); lru_p1(kparams(), l, (int)gridDim.x - 8 + obid(), 1 << 30, 256, shm); }
            else { lru_p1(kparams(), l, obid() - 8, (int)gridDim.x - 8, (int)gridDim.x - 8, shm); REP(DUP_GR) gr_ds(kparams(), l, b, shm, 8); }
            GSYNC();
            if (threadIdx.x < 256) rwkv_pass2(kparams());
            else gr_scan(kparams(), otid() - 256);
            GSYNC();
            { KP Pq = kparams(); gr_out(Pq, l, b, shm, (bf16_t*)(Pq->ws + OFF_ZG), 2048); }
            { KP Pq = kparams(); lru_p3(Pq, (bf16_t*)(Pq->ws + OFF_ZG), 2048); }
            rw_post(kparams(), l);
            GSYNC();
            REP(DUP_GEMM) { KP P = kparams(); unsigned char* ws = P->ws;
                Order S; S.init(64, 16, 1, ws + OFF_UN, ws + OFF_WIN + (size_t)6656 * 1024 * 2, 256L * 1024 * 2, 256L * 1024 * 2, 0, 0, 0);
                EpiBf16<1> E{(bf16_t*)(ws + OFF_G), 4096, 1.0f}; gemm_phase(lds, Gemm{1024, 1024, 1024}, S, E); }
            GSYNC();
            REP(DUP_GEMM) { KP P = kparams(); unsigned char* ws = P->ws;
                Order S; S.init(64, 4, 4, ws + OFF_ZG, ws + OFF_WB, 256L * 2048 * 2, 256L * 512 * 2, 0, 512L * 2, 1024L * 512 * 2);
                EpiMerge E{(const bf16_t*)(ws + OFF_G), (bf16_t*)(ws + OFF_MRG)}; gemm_phase(lds, Gemm{2048, 512, 512}, S, E); }
            GSYNC();
            { KP P = kparams(); unsigned char* ws = P->ws;
                const float* hin = (l == 0 ? (const float*)P->in[0] : (const float*)P->out) + (size_t)b * TB * DM; float* hout = P->out + (size_t)b * TB * DM;
                Order S; S.init(64, 4, 1, ws + OFF_MRG, ws + OFF_WOUT, 256L * 1024 * 2, 256L * 1024 * 2, 0, 0, 0);
                EpiResid E{hin, hout}; gemm_phase(lds, Gemm{1024, 1024, 1024}, S, E); }
            GSYNC();
            { KP P = kparams(); unsigned char* ws = P->ws; const float* hout = P->out + (size_t)b * TB * DM;
              rmsnorm_bf16(hout, (const float*)P->in[28] + l * 1024, (bf16_t*)(ws + OFF_UN), TB); }
            GSYNC();
            REP(DUP_GEMM) { KP P = kparams(); unsigned char* ws = P->ws;
                Order S; S.init(64, 4, 1, ws + OFF_UN, ws + OFF_WQ, 256L * 1024 * 2, 256L * 1024 * 2, 0, 0, 0);
                EpiBf16<0> E{(bf16_t*)(ws + OFF_Q), 1024, 0.0625f}; gemm_phase(lds, Gemm{1024, 1024, 1024}, S, E); }
            GSYNC();
            REP(DUP_GEMM) { KP P = kparams(); unsigned char* ws = P->ws;
                Order S; S.init(64, 4, 1, ws + OFF_Q, ws + OFF_KM + (size_t)b * 256 * 1024 * 2, 256L * 1024 * 2, 256L * 2, 256L * 2, 0, 0);
                EpiSoftmax E{(bf16_t*)(ws + OFF_P), (LAS float*)(lds + STAGE_BYTES)}; gemm_phase(lds, Gemm{1024, 1024, 256}, S, E); }
            GSYNC();
            REP(DUP_GEMM) { KP P = kparams(); unsigned char* ws = P->ws;
                Order S; S.init(64, 4, 1, ws + OFF_P, ws + OFF_VT + (size_t)b * 1024 * 256 * 2, 256L * 1024 * 2, 256L * 256 * 2, 256L * 2, 0, 0);
                EpiBf16<0> E{(bf16_t*)(ws + OFF_O), 1024, 1.0f}; gemm_phase(lds, Gemm{1024, 256, 256}, S, E); }
            GSYNC();
            { KP P = kparams(); unsigned char* ws = P->ws; float* hout = P->out + (size_t)b * TB * DM;
                Order S; S.init(64, 4, 1, ws + OFF_O, ws + OFF_WO, 256L * 1024 * 2, 256L * 1024 * 2, 0, 0, 0);
                EpiResid E{hout, hout}; gemm_phase(lds, Gemm{1024, 1024, 1024}, S, E); }
            GSYNC();
        }
    }
    { KP P = kparams(); rmsnorm_f32_inplace(P->out, (const float*)P->in[33], 2 * TB); }
    if (TP1 >= 0) {
        GSYNC();
        if (blockIdx.x == 0) { KP P = kparams(); __syncthreads();
            const float t1 = (float)tacc[TP1 >= 0 ? TP1 : 0] * 0.01f, t2 = (float)tacc[TP2 >= 0 ? TP2 : 0] * 0.01f;
            if (threadIdx.x == 0) P->out[0] = 100.0f * t1;
            if (TP2 >= 0) for (int i = threadIdx.x; i < 65536; i += 512) P->out[65536 + i] = t2; }
    }
}

extern "C" void kernel_launch(void* const* d_in, const int* in_sizes, int n_in, void* d_out, int out_size, void* d_ws, size_t ws_size, hipStream_t stream) {
    constexpr size_t kDynLds = pg8::STAGE_BYTES + 16384 + 64 + 256;
    static int grid_blocks = 0;
    if (!grid_blocks) {
        int dev = 0, cus = 0, per_cu = 0;
        hipGetDevice(&dev);
        hipDeviceGetAttribute(&cus, hipDeviceAttributeMultiprocessorCount, dev);
        hipFuncSetAttribute((const void*)fwd_megakernel, hipFuncAttributeMaxDynamicSharedMemorySize, (int)kDynLds);
        hipOccupancyMaxActiveBlocksPerMultiprocessor(&per_cu, (const void*)fwd_megakernel, 512, kDynLds);
        if (per_cu < 1) { fprintf(stderr, "occupancy query returned %d\n", per_cu); per_cu = 1; }
        grid_blocks = cus * per_cu;
        if (ws_size < OFF_END) fprintf(stderr, "workspace too small: %zu < %zu\n", ws_size, (size_t)OFF_END);
    }
    Params p{};
    for (int i = 0; i < 34; ++i) p.in[i] = d_in[i];
    p.out = (float*)d_out; p.ws = (unsigned char*)d_ws;
    void* args[] = {&p};
    hipError_t e = hipLaunchCooperativeKernel((const void*)fwd_megakernel, dim3(grid_blocks), dim3(512), args, kDynLds, stream);
    if (e != hipSuccess) fprintf(stderr, "cooperative launch failed: %s (grid %d)\n", hipGetErrorString(e), grid_blocks);
}
```

```cpp
#include <hip/hip_runtime.h>
#include <hip/hip_cooperative_groups.h>
#include <cstdio>
namespace cg = cooperative_groups;

typedef unsigned short bf16_t;
typedef short bf16x8 __attribute__((ext_vector_type(8)));
typedef float f32x4 __attribute__((ext_vector_type(4)));
typedef float f32x2 __attribute__((ext_vector_type(2)));
typedef unsigned u32x4 __attribute__((ext_vector_type(4)));
typedef unsigned u32x2 __attribute__((ext_vector_type(2)));
#define LAS __attribute__((address_space(3)))

constexpr int TB = 16384;
constexpr int DM = 1024;
constexpr int NIN = 10384;
constexpr int NCH = 128, LCH = 128;

constexpr size_t SZ_WIN = (size_t)10752 * 1024 * 2;
constexpr size_t OFF_WIN = 0;
constexpr size_t OFF_WB = OFF_WIN + SZ_WIN;
constexpr size_t OFF_WOUT = OFF_WB + (size_t)4 * 1024 * 512 * 2;
constexpr size_t OFF_WQ = OFF_WOUT + (size_t)1024 * 1024 * 2;
constexpr size_t OFF_WKV = OFF_WQ + (size_t)1024 * 1024 * 2;
constexpr size_t OFF_WO = OFF_WKV + (size_t)2048 * 1024 * 2;
constexpr size_t OFF_UN = OFF_WO + (size_t)1024 * 1024 * 2;
constexpr size_t OFF_MN = OFF_UN + (size_t)TB * 1024 * 2;
constexpr size_t OFF_KM = OFF_MN + (size_t)512 * 1024 * 2;
constexpr size_t OFF_VT = OFF_KM + (size_t)512 * 1024 * 2;
constexpr size_t OFF_ZRW = OFF_VT + (size_t)512 * 1024 * 2;
constexpr size_t OFF_ZGLA = OFF_ZRW + (size_t)TB * 1792 * 2;
constexpr size_t OFF_ZRET = OFF_ZGLA + (size_t)TB * 1280 * 2;
constexpr size_t OFF_ZLRU = OFF_ZRET + (size_t)TB * 1024 * 2;
constexpr size_t OFF_ZG = OFF_ZLRU + (size_t)TB * 512 * 2;
constexpr size_t OFF_MRG = OFF_ZG + (size_t)TB * 2048 * 2;
constexpr size_t OFF_PREP = OFF_MRG + (size_t)TB * 1024 * 2;
constexpr size_t SZ_F = (size_t)TB * 512 * 4;
constexpr size_t OFF_PW = OFF_PREP, OFF_PKK = OFF_PW + SZ_F, OFF_PB = OFF_PKK + SZ_F, OFF_PKM = OFF_PB + SZ_F, OFF_PR = OFF_PKM + SZ_F;
constexpr size_t OFF_PV = OFF_PR + SZ_F;
constexpr size_t OFF_BON = OFF_PV + (size_t)TB * 512 * 2;
constexpr size_t OFF_BAR = OFF_BON + (size_t)TB * 8 * 4;
constexpr size_t OFF_ROPE = OFF_BAR + 16384;
constexpr size_t OFF_DSG0 = OFF_PKK + SZ_F / 2;
constexpr size_t OFF_DSG1 = OFF_PB + SZ_F / 2;
constexpr size_t OFF_HL = OFF_PKM + SZ_F / 2;
constexpr size_t OFF_CA = OFF_PR + SZ_F / 2;
constexpr size_t OFF_DEC = OFF_ROPE + (size_t)2 * TB * 32 * 8;
constexpr size_t OFF_AC = OFF_DEC + (size_t)256 * 4 * 64 * 4;
constexpr size_t OFF_HC = OFF_AC + (size_t)256 * 512 * 4;
constexpr size_t OFF_HIN = OFF_HC + (size_t)256 * 512 * 4;
constexpr size_t OFF_W2T = OFF_HIN + (size_t)256 * 512 * 4;
constexpr size_t OFF_A2T = OFF_W2T + (size_t)512 * 64 * 2;
constexpr size_t OFF_WAT = OFF_A2T + (size_t)512 * 64 * 2;
constexpr size_t OFF_WXT = OFF_WAT + (size_t)8 * 64 * 64 * 2;
constexpr size_t OFF_END = OFF_WXT + (size_t)8 * 64 * 64 * 2;
constexpr size_t OFF_G = OFF_ZRW;
constexpr size_t OFF_Q = OFF_ZRW;
constexpr size_t OFF_P = OFF_Q + (size_t)TB * 1024 * 2;
constexpr size_t OFF_O = OFF_P + (size_t)TB * 1024 * 2;
constexpr size_t OFF_PP = OFF_MRG;
constexpr size_t OFF_PL = OFF_MRG + (size_t)8 * NCH * 4096 * 4;
struct Params { const void* in[34]; float* out; unsigned char* ws; };
typedef const Params __attribute__((address_space(4)))* KP;
__device__ __forceinline__ KP kparams() { KP p = (KP)__builtin_amdgcn_kernarg_segment_ptr(); asm volatile("" : "+s"(p)); return p; }

__device__ __forceinline__ float bf2f(bf16_t v) { return __uint_as_float(((unsigned)v) << 16); }
__device__ __forceinline__ bf16_t f2bf(float f) { const __bf16 b = (__bf16)f; return __builtin_bit_cast(bf16_t, b); }
typedef __bf16 bf16x2_t __attribute__((ext_vector_type(2)));
__device__ __forceinline__ unsigned cvt_pk_bf16(float lo, float hi) { const f32x2 v = {lo, hi}; const bf16x2_t b = __builtin_convertvector(v, bf16x2_t); return __builtin_bit_cast(unsigned, b); }
__device__ __forceinline__ float shx(float v, int lane, int o) { return __int_as_float(__builtin_amdgcn_ds_bpermute((lane ^ o) << 2, __float_as_int(v))); }
__device__ __forceinline__ float wave_sum(float v, int lane) {
#pragma unroll
    for (int o = 32; o >= 1; o >>= 1) v += shx(v, lane, o);
    return v; }
__device__ __forceinline__ float rlane(float v, int k) { return __int_as_float(__builtin_amdgcn_readlane(__float_as_int(v), k)); }
__device__ __forceinline__ float sigmoidf_(float x) { return __builtin_amdgcn_rcpf(1.0f + __expf(-x)); }
__device__ __forceinline__ float siluf_(float x) { return x * __builtin_amdgcn_rcpf(1.0f + __expf(-x)); }
__device__ __forceinline__ float softplusf_(float y) { return fmaxf(y, 0.f) + __logf(1.0f + __expf(-fabsf(y))); }
__device__ __forceinline__ float tanhf_(float x) { float e = __expf(2.0f * x); return 1.0f - 2.0f * __builtin_amdgcn_rcpf(e + 1.0f); }

__device__ __forceinline__ int otid() { int t = threadIdx.x; asm volatile("" : "+v"(t)); return t; }
__device__ __forceinline__ int obid() { int t = blockIdx.x; asm volatile("" : "+s"(t)); return t; }

namespace pg8 {
constexpr int BM = 256, BK = 64, HALF = 128, HTB = HALF * BK * 2, STAGE_BYTES = 8 * HTB, NXCD = 8, WGM = 8;
__device__ __forceinline__ int lds_byte(int r, int c) { const int st = (r >> 4) * 2 + (c >> 5), rr = r & 15, cc = c & 31, ob = rr * 64 + cc * 2; return st * 1024 + (ob ^ (((ob >> 9) & 1) << 5)); }
__device__ __forceinline__ void stage_rc(int b, int& R, int& C) { const int st = b / 1024, sb = b % 1024, swz = sb ^ (((sb >> 9) & 1) << 5); R = (st >> 1) * 16 + swz / 64; C = (st & 1) * 32 + (swz % 64) / 2; }
__device__ __forceinline__ int perm32(int rho) { const int n = rho >> 4, i = rho & 15; return 8 * (i >> 2) + 4 * n + (i & 3); }

struct Unit { int pm, pn, aux; const char* pa; const char* pb; };
struct Gemm { int lda, ldb, K; };

struct Order {
    int nM, nN, nwg, G, c, rep;
    const char* A; const char* B;
    long tA, tB, aPn, aRep, bRep;
    __device__ void init(int nM_, int nN_, int rep_, const void* A_, const void* B_, long tA_, long tB_, long aPn_, long aRep_, long bRep_) {
        nM = nM_; nN = nN_; nwg = nM * nN; G = gridDim.x; c = obid(); rep = rep_; A = (const char*)A_; B = (const char*)B_; tA = tA_; tB = tB_; aPn = aPn_; aRep = aRep_; bRep = bRep_; }
    __device__ bool next(int i, Unit& u) const {
        const int ti = i / rep, r = i - ti * rep;
        const long L = (long)ti * G + c; if (L >= nwg) return false;
        int wgid = (int)L; { const int q = nwg / NXCD, rr = nwg % NXCD, xcd = wgid % NXCD, off = wgid / NXCD; wgid = (xcd < rr ? xcd * (q + 1) : rr * (q + 1) + (xcd - rr) * q) + off; }
        const int nig = WGM * nN, gid = wgid / nig, fm = gid * WGM, gsz = (nM - fm) < WGM ? (nM - fm) : WGM;
        u.pm = fm + ((wgid % nig) % gsz); u.pn = (wgid % nig) / gsz; u.aux = r;
        u.pa = A + (long)u.pm * tA + (long)u.pn * aPn + (long)r * aRep;
        u.pb = B + (long)u.pn * tB + (long)r * bRep;
        return true; }
};

template <class Epi>
__device__ __forceinline__ void gemm_phase(LAS unsigned char* lds, const Gemm g, const Order& S, const Epi& E) {
    const int tid = otid(), wid = __builtin_amdgcn_readfirstlane(tid >> 6), lane = tid & 63, wr = wid >> 2, wc = wid & 3, fr = lane & 15, fq = lane >> 4;
    const int K = g.K, nt = K / BK;
    unsigned voffA[2], voffB[2];
#pragma unroll
    for (int i = 0; i < 2; ++i) { int R, C; stage_rc(tid * 16 + i * 8192, R, C); const int Rb = Epi::PERM ? ((R & ~31) + perm32(R & 31)) : R;
        voffA[i] = (unsigned)(R * g.lda + C) * 2u; voffB[i] = (unsigned)(Rb * g.ldb + C) * 2u; }
    const size_t kstep = (size_t)(BK * 2);
    const size_t hstepA = (size_t)HALF * g.lda * 2, hstepB = (size_t)HALF * g.ldb * 2;
    const unsigned ldsw = (unsigned)wid * 1024u;
    const int aoff = lds_byte(wr * 64 + fr, fq * 8), boff = lds_byte(wc * 32 + fr, fq * 8);
#define PG8_SA(b, h) (((b) * 2 + (h)) * HTB)
#define PG8_SB(b, h) ((4 + (b) * 2 + (h)) * HTB)
#define PG8_STAGE(bufoff, gbase, voff) do { _Pragma("unroll") for (int _i = 0; _i < 2; ++_i) \
        __builtin_amdgcn_global_load_lds((const unsigned*)((const char*)(gbase) + (voff)[_i]), (LAS unsigned*)(lds + (bufoff) + ldsw + _i * 8192), 16, 0, 0); } while (0)
#define PG8_LDA(dst, b, h) do { _Pragma("unroll") for (int m = 0; m < 4; ++m) _Pragma("unroll") for (int k = 0; k < 2; ++k) dst[m][k] = *(const LAS bf16x8*)(lds + PG8_SA(b, h) + aoff + m * 2048 + k * 1024); } while (0)
#define PG8_LDB(dst, b, h) do { _Pragma("unroll") for (int n = 0; n < 2; ++n) _Pragma("unroll") for (int k = 0; k < 2; ++k) dst[n][k] = *(const LAS bf16x8*)(lds + PG8_SB(b, h) + boff + n * 2048 + k * 1024); } while (0)
#define PG8_MMA(ai, bj, At, Bt) do { __builtin_amdgcn_s_setprio(1); _Pragma("unroll") for (int m = 0; m < 4; ++m) _Pragma("unroll") for (int n = 0; n < 2; ++n) _Pragma("unroll") for (int k = 0; k < 2; ++k) \
        acc[ai][bj][m][n] = __builtin_amdgcn_mfma_f32_16x16x32_bf16(Bt[n][k], At[m][k], acc[ai][bj][m][n], 0, 0, 0); __builtin_amdgcn_s_setprio(0); } while (0)
#define PG8_WAIT_V(n) asm volatile("s_waitcnt vmcnt(" #n ")" ::: "memory")
#define PG8_WAIT_L(n) asm volatile("s_waitcnt lgkmcnt(" #n ")" ::: "memory")
#define PG8_BAR __builtin_amdgcn_s_barrier()
#define PG8_SCHED __builtin_amdgcn_sched_barrier(0)
    Unit cur, nxt; int ui = 0;
    if (!S.next(0, cur)) return;
    f32x4 acc[2][2][4][2];
#pragma unroll
    for (int a = 0; a < 2; ++a)
#pragma unroll
        for (int b = 0; b < 2; ++b)
#pragma unroll
            for (int m = 0; m < 4; ++m)
#pragma unroll
                for (int n = 0; n < 2; ++n) acc[a][b][m][n] = (f32x4){0.f, 0.f, 0.f, 0.f};
    bf16x8 At[4][2], B0[2][2], B1[2][2];
    const char* cA = cur.pa; const char* cB = cur.pb;
    PG8_STAGE(PG8_SB(0, 0), cB, voffB); PG8_STAGE(PG8_SA(0, 0), cA, voffA); PG8_STAGE(PG8_SB(0, 1), cB + hstepB, voffB); PG8_STAGE(PG8_SA(0, 1), cA + hstepA, voffA);
    if (wr == 1) PG8_BAR;
    PG8_WAIT_V(4); PG8_BAR;
    PG8_STAGE(PG8_SB(1, 0), cB + kstep, voffB); PG8_STAGE(PG8_SA(1, 0), cA + kstep, voffA); PG8_STAGE(PG8_SB(1, 1), cB + hstepB + kstep, voffB);
    PG8_WAIT_V(6); PG8_BAR;
    for (;;) {
        const bool has_next = S.next(ui + 1, nxt);
        const char* nA = has_next ? nxt.pa : cA; const char* nB = has_next ? nxt.pb : cB;
        for (int t = 0; t < nt; t += 2) {
            const bool last = (t == nt - 2);
            const char* a1 = cA + (size_t)(t + 1) * kstep;
            const char* a2 = last ? nA : cA + (size_t)(t + 2) * kstep; const char* b2 = last ? nB : cB + (size_t)(t + 2) * kstep;
            const char* a3 = a2 + kstep; const char* b3 = b2 + kstep;
            PG8_LDB(B0, 0, 0); PG8_SCHED; PG8_LDA(At, 0, 0); PG8_STAGE(PG8_SA(1, 1), a1 + hstepA, voffA);
            PG8_WAIT_L(8); PG8_BAR; PG8_WAIT_L(0); PG8_MMA(0, 0, At, B0); PG8_BAR; PG8_SCHED;
            PG8_LDB(B1, 0, 1); PG8_STAGE(PG8_SB(0, 0), b2, voffB);
            PG8_BAR; PG8_WAIT_L(0); PG8_MMA(0, 1, At, B1); PG8_BAR;
            PG8_LDA(At, 0, 1); PG8_STAGE(PG8_SA(0, 0), a2, voffA);
            PG8_BAR; PG8_WAIT_L(0); PG8_MMA(1, 0, At, B0); PG8_BAR; PG8_SCHED;
            PG8_STAGE(PG8_SB(0, 1), b2 + hstepB, voffB);
            PG8_WAIT_V(6); PG8_BAR; PG8_MMA(1, 1, At, B1); PG8_BAR;
            PG8_LDB(B0, 1, 0); PG8_SCHED; PG8_LDA(At, 1, 0); PG8_STAGE(PG8_SA(0, 1), a2 + hstepA, voffA);
            PG8_WAIT_L(8); PG8_BAR; PG8_WAIT_L(0); PG8_MMA(0, 0, At, B0); PG8_BAR; PG8_SCHED;
            PG8_LDB(B1, 1, 1); PG8_STAGE(PG8_SB(1, 0), b3, voffB);
            PG8_BAR; PG8_WAIT_L(0); PG8_MMA(0, 1, At, B1); PG8_BAR;
            PG8_LDA(At, 1, 1); PG8_STAGE(PG8_SA(1, 0), a3, voffA);
            PG8_BAR; PG8_WAIT_L(0); PG8_MMA(1, 0, At, B0); PG8_BAR; PG8_SCHED;
            PG8_STAGE(PG8_SB(1, 1), b3 + hstepB, voffB);
            PG8_WAIT_V(6); PG8_BAR; PG8_MMA(1, 1, At, B1); PG8_BAR;
        }
        E(acc, cur, wr, wc, fr, fq);
        if (!has_next) break;
        if constexpr (!Epi::KEEP_ACC)
#pragma unroll
        for (int a = 0; a < 2; ++a)
#pragma unroll
            for (int b = 0; b < 2; ++b)
#pragma unroll
                for (int m = 0; m < 4; ++m)
#pragma unroll
                    for (int n = 0; n < 2; ++n) acc[a][b][m][n] = (f32x4){0.f, 0.f, 0.f, 0.f};
        cur = nxt; cA = nA; cB = nB; ++ui;
    }
    PG8_WAIT_V(0);
    if (wr == 0) PG8_BAR;
    PG8_BAR;
#undef PG8_SA
#undef PG8_SB
#undef PG8_STAGE
#undef PG8_LDA
#undef PG8_LDB
#undef PG8_MMA
#undef PG8_WAIT_V
#undef PG8_WAIT_L
#undef PG8_BAR
#undef PG8_SCHED
}

typedef f32x4 Acc[2][2][4][2];

struct EpiInproj {
    static constexpr bool PERM = true, KEEP_ACC = false;
    unsigned char* ws;
    __device__ __forceinline__ void operator()(Acc& acc, const Unit& u, int wr, int wc, int fr, int fq) const {
        int pn = u.pn, ld, colt; size_t off;
        if (pn < 7) { off = OFF_ZRW; ld = 1792; colt = pn * 256; }
        else if (pn < 12) { off = OFF_ZGLA; ld = 1280; colt = (pn - 7) * 256; }
        else if (pn < 16) { off = OFF_ZRET; ld = 1024; colt = (pn - 12) * 256; }
        else if (pn < 18) { off = OFF_ZLRU; ld = 512; colt = (pn - 16) * 256; }
        else { off = OFF_ZG; ld = 2048; colt = (pn - 18) * 256; }
        bf16_t* base = (bf16_t*)(ws + off);
        const int row0 = u.pm * BM + wr * 64 + fr, col0 = colt + wc * 32 + 8 * fq;
#pragma unroll
        for (int ai = 0; ai < 2; ++ai)
#pragma unroll
            for (int m = 0; m < 4; ++m) { bf16_t* rowp = base + (size_t)(row0 + ai * HALF + m * 16) * ld + col0;
#pragma unroll
                for (int bj = 0; bj < 2; ++bj) { const f32x4 v0 = acc[ai][bj][m][0], v1 = acc[ai][bj][m][1];
                    u32x4 w; w.x = cvt_pk_bf16(v0[0], v0[1]); w.y = cvt_pk_bf16(v0[2], v0[3]); w.z = cvt_pk_bf16(v1[0], v1[1]); w.w = cvt_pk_bf16(v1[2], v1[3]);
                    *(u32x4*)(rowp + bj * HALF) = w; } }
    }
};
template <int ACT> struct EpiBf16 {
    static constexpr bool PERM = true, KEEP_ACC = false;
    bf16_t* O; int ldc; float scale;
    __device__ __forceinline__ void operator()(Acc& acc, const Unit& u, int wr, int wc, int fr, int fq) const {
        const int row0 = u.pm * BM + wr * 64 + fr, col0 = u.pn * BM + wc * 32 + 8 * fq;
#pragma unroll
        for (int ai = 0; ai < 2; ++ai)
#pragma unroll
            for (int m = 0; m < 4; ++m) { bf16_t* rowp = O + (size_t)(row0 + ai * HALF + m * 16) * ldc + col0;
#pragma unroll
                for (int bj = 0; bj < 2; ++bj) { f32x4 v0 = acc[ai][bj][m][0], v1 = acc[ai][bj][m][1];
                    if (ACT == 1) {
#pragma unroll
                        for (int j = 0; j < 4; ++j) { v0[j] = sigmoidf_(v0[j]); v1[j] = sigmoidf_(v1[j]); } }
                    else { v0 = v0 * scale; v1 = v1 * scale; }
                    u32x4 w; w.x = cvt_pk_bf16(v0[0], v0[1]); w.y = cvt_pk_bf16(v0[2], v0[3]); w.z = cvt_pk_bf16(v1[0], v1[1]); w.w = cvt_pk_bf16(v1[2], v1[3]);
                    *(u32x4*)(rowp + bj * HALF) = w; } }
    }
};
struct EpiKV {
    static constexpr bool PERM = true, KEEP_ACC = false;
    bf16_t* KM; bf16_t* VT;
    __device__ __forceinline__ void operator()(Acc& acc, const Unit& u, int wr, int wc, int fr, int fq) const {
        const int row0 = u.pm * BM + wr * 64 + fr, col0 = u.pn * BM + wc * 32 + 8 * fq;
#pragma unroll
        for (int ai = 0; ai < 2; ++ai)
#pragma unroll
            for (int m = 0; m < 4; ++m) { const int row = row0 + ai * HALF + m * 16;
#pragma unroll
                for (int bj = 0; bj < 2; ++bj)
#pragma unroll
                    for (int n = 0; n < 2; ++n)
#pragma unroll
                        for (int j = 0; j < 4; ++j) { const int col = col0 + bj * HALF + 4 * n + j; const bf16_t v = f2bf(acc[ai][bj][m][n][j]);
                            if (col < 1024) KM[(size_t)row * 1024 + col] = v;
                            else VT[((size_t)(row >> 8) * 1024 + (col - 1024)) * 256 + (row & 255)] = v; } }
    }
};
struct EpiMerge {
    static constexpr bool PERM = true, KEEP_ACC = true;
    const bf16_t* G; bf16_t* MRG;
    __device__ __forceinline__ void operator()(Acc& acc, const Unit& u, int wr, int wc, int fr, int fq) const {
        const int row0 = u.pm * BM + wr * 64 + fr, col0 = u.pn * BM + wc * 32 + 8 * fq;
        const bool lastb = (u.aux == 3);
#pragma unroll
        for (int ai = 0; ai < 2; ++ai) {
            u32x4 gq[4][2], hq[4][2];
#pragma unroll
            for (int m = 0; m < 4; ++m)
#pragma unroll
                for (int bj = 0; bj < 2; ++bj) { const bf16_t* gp = G + (size_t)(row0 + ai * HALF + m * 16) * 4096 + u.aux * 1024 + col0 + bj * HALF;
                    gq[m][bj] = *(const u32x4*)gp; hq[m][bj] = (u32x4){0u, 0u, 0u, 0u};
                    if (!lastb) hq[m][bj] = *(const u32x4*)(gp + 1024); }
#pragma unroll
            for (int m = 0; m < 4; ++m)
#pragma unroll
                for (int bj = 0; bj < 2; ++bj) {
                    float f[8];
#pragma unroll
                    for (int e = 0; e < 4; ++e) {
                        const float g0 = fmaxf(__uint_as_float(gq[m][bj][e] << 16), 1e-30f), g1 = fmaxf(__uint_as_float(gq[m][bj][e] & 0xffff0000u), 1e-30f);
                        const float h0 = fmaxf(__uint_as_float(hq[m][bj][e] << 16), 1e-30f), h1 = fmaxf(__uint_as_float(hq[m][bj][e] & 0xffff0000u), 1e-30f);
                        f[2 * e] = lastb ? g0 : g0 * __builtin_amdgcn_rcpf(h0); f[2 * e + 1] = lastb ? g1 : g1 * __builtin_amdgcn_rcpf(h1); }
                    f32x4 v0 = acc[ai][bj][m][0], v1 = acc[ai][bj][m][1];
                    v0[0] *= f[0]; v0[1] *= f[1]; v0[2] *= f[2]; v0[3] *= f[3]; v1[0] *= f[4]; v1[1] *= f[5]; v1[2] *= f[6]; v1[3] *= f[7];
                    if (lastb) {
                        u32x4 w; w.x = cvt_pk_bf16(v0[0], v0[1]); w.y = cvt_pk_bf16(v0[2], v0[3]); w.z = cvt_pk_bf16(v1[0], v1[1]); w.w = cvt_pk_bf16(v1[2], v1[3]);
                        *(u32x4*)(MRG + (size_t)(row0 + ai * HALF + m * 16) * 1024 + col0 + bj * HALF) = w;
                        v0 = (f32x4){0.f, 0.f, 0.f, 0.f}; v1 = (f32x4){0.f, 0.f, 0.f, 0.f}; }
                    acc[ai][bj][m][0] = v0; acc[ai][bj][m][1] = v1; }
        }
    }
};
struct EpiResid {
    static constexpr bool PERM = false, KEEP_ACC = false;
    const float* hin; float* hout;
    __device__ __forceinline__ void operator()(Acc& acc, const Unit& u, int wr, int wc, int fr, int fq) const {
        const int row0 = u.pm * BM + wr * 64 + fr, col0 = u.pn * BM + wc * 32 + 4 * fq;
#pragma unroll
        for (int ai = 0; ai < 2; ++ai) {
            f32x4 r[4][2][2];
#pragma unroll
            for (int m = 0; m < 4; ++m) { const size_t ro = (size_t)(row0 + ai * HALF + m * 16) * 1024 + col0;
#pragma unroll
                for (int bj = 0; bj < 2; ++bj)
#pragma unroll
                    for (int n = 0; n < 2; ++n) r[m][bj][n] = *(const f32x4*)(hin + ro + bj * HALF + n * 16); }
#pragma unroll
            for (int m = 0; m < 4; ++m) { const size_t ro = (size_t)(row0 + ai * HALF + m * 16) * 1024 + col0;
#pragma unroll
                for (int bj = 0; bj < 2; ++bj)
#pragma unroll
                    for (int n = 0; n < 2; ++n) *(f32x4*)(hout + ro + bj * HALF + n * 16) = r[m][bj][n] + acc[ai][bj][m][n]; }
        }
    }
};
struct EpiSoftmax {
    static constexpr bool PERM = true, KEEP_ACC = false;
    bf16_t* P; LAS float* xs;
    __device__ __forceinline__ void operator()(Acc& acc, const Unit& u, int wr_, int wc_, int fr_, int fq_) const {
        const int tid2 = otid(), wid2 = tid2 >> 6, wr = wid2 >> 2, wc = wid2 & 3, fr = tid2 & 15, fq = (tid2 >> 4) & 3;
#pragma unroll
        for (int ai = 0; ai < 2; ++ai)
#pragma unroll
            for (int m = 0; m < 4; ++m) { float v = -3.0e38f;
#pragma unroll
                for (int bj = 0; bj < 2; ++bj)
#pragma unroll
                    for (int n = 0; n < 2; ++n)
#pragma unroll
                        for (int j = 0; j < 4; ++j) v = fmaxf(v, acc[ai][bj][m][n][j]);
                xs[(ai * HALF + wr * 64 + m * 16 + fr) * 16 + wc * 4 + fq] = v; }
        asm volatile("s_waitcnt lgkmcnt(0)\n\ts_barrier" ::: "memory");
        float sums[2][4];
#pragma unroll
        for (int ai = 0; ai < 2; ++ai)
#pragma unroll
            for (int m = 0; m < 4; ++m) { const int rl = ai * HALF + wr * 64 + m * 16 + fr;
                f32x4 q = *(const LAS f32x4*)(xs + rl * 16);
#pragma unroll
                for (int e = 1; e < 4; ++e) { const f32x4 q2 = *(const LAS f32x4*)(xs + rl * 16 + 4 * e); q[0] = fmaxf(q[0], q2[0]); q[1] = fmaxf(q[1], q2[1]); q[2] = fmaxf(q[2], q2[2]); q[3] = fmaxf(q[3], q2[3]); }
                const float M = fmaxf(fmaxf(q[0], q[1]), fmaxf(q[2], q[3]));
                float sv = 0.f;
#pragma unroll
                for (int bj = 0; bj < 2; ++bj)
#pragma unroll
                    for (int n = 0; n < 2; ++n)
#pragma unroll
                        for (int j = 0; j < 4; ++j) { const float e = __expf(acc[ai][bj][m][n][j] - M); acc[ai][bj][m][n][j] = e; sv += e; }
                sums[ai][m] = sv; }
        asm volatile("s_waitcnt lgkmcnt(0)\n\ts_barrier" ::: "memory");
#pragma unroll
        for (int ai = 0; ai < 2; ++ai)
#pragma unroll
            for (int m = 0; m < 4; ++m) xs[(ai * HALF + wr * 64 + m * 16 + fr) * 16 + wc * 4 + fq] = sums[ai][m];
        asm volatile("s_waitcnt lgkmcnt(0)\n\ts_barrier" ::: "memory");
        const int row0 = u.pm * BM + wr * 64 + fr, col0 = u.pn * BM + wc * 32 + 8 * fq;
#pragma unroll
        for (int ai = 0; ai < 2; ++ai)
#pragma unroll
            for (int m = 0; m < 4; ++m) { const int rl = ai * HALF + wr * 64 + m * 16 + fr;
                f32x4 q = *(const LAS f32x4*)(xs + rl * 16);
#pragma unroll
                for (int e = 1; e < 4; ++e) q += *(const LAS f32x4*)(xs + rl * 16 + 4 * e);
                const float inv = __builtin_amdgcn_rcpf(q[0] + q[1] + q[2] + q[3]);
                bf16_t* rowp = P + (size_t)(row0 + ai * HALF + m * 16) * 1024 + col0;
#pragma unroll
                for (int bj = 0; bj < 2; ++bj) { const f32x4 v0 = acc[ai][bj][m][0] * inv, v1 = acc[ai][bj][m][1] * inv;
                    u32x4 w; w.x = cvt_pk_bf16(v0[0], v0[1]); w.y = cvt_pk_bf16(v0[2], v0[3]); w.z = cvt_pk_bf16(v1[0], v1[1]); w.w = cvt_pk_bf16(v1[2], v1[3]);
                    *(u32x4*)(rowp + bj * HALF) = w; } }
    }
};
}

__device__ __forceinline__ int win_map(int n) {
    if (n < 1792) return n < 1664 ? n : -1;
    n -= 1792; if (n < 1280) return n < 1040 ? 2176 + n : -1;
    n -= 1280; if (n < 1024) return 3728 + n;
    n -= 1024; if (n < 512) return 5264 + n;
    n -= 512;
    if (n < 512) return 1664 + n;
    if (n < 1024) return 3216 + (n - 512);
    if (n < 1536) return 4752 + (n - 1024);
    if (n < 2048) return 5776 + (n - 1536);
    n -= 2048; return 6288 + n;
}
template <bool WIN>
__device__ __forceinline__ void conv_t(bf16_t* dst, const float* src, int ND, int K, int NS) {
    const size_t total = (size_t)ND * (K / 8);
    for (size_t i = (size_t)obid() * 512 + otid(); i < total; i += (size_t)gridDim.x * 512) {
        const int n = (int)(i % ND), ko = (int)(i / ND);
        const int ms = WIN ? win_map(n) : n;
        float v[8];
#pragma unroll
        for (int j = 0; j < 8; ++j) v[j] = ms >= 0 ? src[(size_t)(ko * 8 + j) * NS + ms] : 0.f;
        u32x4 w; w.x = cvt_pk_bf16(v[0], v[1]); w.y = cvt_pk_bf16(v[2], v[3]); w.z = cvt_pk_bf16(v[4], v[5]); w.w = cvt_pk_bf16(v[6], v[7]);
        *(u32x4*)(dst + (size_t)n * K + ko * 8) = w;
    }
}
__device__ __forceinline__ void rmsnorm_bf16(const float* src, const float* g, bf16_t* dst, int rows) {
    const int lane = otid() & 63, gw = obid() * 8 + (otid() >> 6), nw = gridDim.x * 8;
    f32x4 gg[4];
#pragma unroll
    for (int i = 0; i < 4; ++i) gg[i] = *(const f32x4*)(g + i * 256 + lane * 4);
    for (int r0 = gw; r0 < rows; r0 += 4 * nw) {
        f32x4 v[4][4];
#pragma unroll
        for (int q = 0; q < 4; ++q) { const int r = r0 + q * nw < rows ? r0 + q * nw : r0; const float* p = src + (size_t)r * 1024;
#pragma unroll
            for (int i = 0; i < 4; ++i) v[q][i] = *(const f32x4*)(p + i * 256 + lane * 4); }
#pragma unroll
        for (int q = 0; q < 4; ++q) { const int r = r0 + q * nw; if (r >= rows) break;
            float ss = 0.f;
#pragma unroll
            for (int i = 0; i < 4; ++i) ss += v[q][i][0] * v[q][i][0] + v[q][i][1] * v[q][i][1] + v[q][i][2] * v[q][i][2] + v[q][i][3] * v[q][i][3];
            ss = wave_sum(ss, lane); const float rs = rsqrtf(ss * (1.0f / 1024.0f) + 1e-6f);
#pragma unroll
            for (int i = 0; i < 4; ++i) { u32x2 w; w.x = cvt_pk_bf16(v[q][i][0] * rs * gg[i][0], v[q][i][1] * rs * gg[i][1]); w.y = cvt_pk_bf16(v[q][i][2] * rs * gg[i][2], v[q][i][3] * rs * gg[i][3]);
                *(u32x2*)(dst + (size_t)r * 1024 + i * 256 + lane * 4) = w; } }
    }
}
__device__ __forceinline__ void rmsnorm_f32_inplace(float* buf, const float* g, int rows) {
    const int lane = otid() & 63, gw = obid() * 8 + (otid() >> 6), nw = gridDim.x * 8;
    f32x4 gg[4];
#pragma unroll
    for (int i = 0; i < 4; ++i) gg[i] = *(const f32x4*)(g + i * 256 + lane * 4);
    for (int r0 = gw; r0 < rows; r0 += 4 * nw) {
        f32x4 v[4][4];
#pragma unroll
        for (int q = 0; q < 4; ++q) { const int r = r0 + q * nw < rows ? r0 + q * nw : r0; const float* p = buf + (size_t)r * 1024;
#pragma unroll
            for (int i = 0; i < 4; ++i) v[q][i] = *(const f32x4*)(p + i * 256 + lane * 4); }
#pragma unroll
        for (int q = 0; q < 4; ++q) { const int r = r0 + q * nw; if (r >= rows) break;
            float ss = 0.f;
#pragma unroll
            for (int i = 0; i < 4; ++i) ss += v[q][i][0] * v[q][i][0] + v[q][i][1] * v[q][i][1] + v[q][i][2] * v[q][i][2] + v[q][i][3] * v[q][i][3];
            ss = wave_sum(ss, lane); const float rs = rsqrtf(ss * (1.0f / 1024.0f) + 1e-6f);
#pragma unroll
            for (int i = 0; i < 4; ++i) *(f32x4*)(buf + (size_t)r * 1024 + i * 256 + lane * 4) = v[q][i] * rs * gg[i]; }
    }
}

template <int CTRL, int RM> __device__ __forceinline__ float dppf(float x) { return __int_as_float(__builtin_amdgcn_update_dpp(0, __float_as_int(x), CTRL, RM, 0xf, false)); }
__device__ __forceinline__ float red8(float x) { x += dppf<0xB1, 0xf>(x); x += dppf<0x4E, 0xf>(x); x += dppf<0x141, 0xf>(x); return x; }
__device__ __forceinline__ float wave_total_from_groups(float x) {
    x += dppf<0x128, 0xf>(x);
    x += dppf<0x142, 0xa>(x);
    x += dppf<0x143, 0xc>(x);
    return rlane(x, 63); }
__device__ __forceinline__ float wave_sum_dpp(float x) { return wave_total_from_groups(red8(x)); }

__device__ __forceinline__ void rwkv_prep(KP P, int l, unsigned char* sm) {
    unsigned char* ws = P->ws;
    bf16_t* AW = (bf16_t*)sm; bf16_t* AA = (bf16_t*)(sm + 9216); float* OUTW = (float*)(sm + 18432); float* OUTA = (float*)(sm + 51200);
    const int c = otid(), lane = c & 63, h = c >> 6, lr = lane & 15, lq = lane >> 4, tt = c >> 3, jg = c & 7;
    const float* mu = (const float*)P->in[5] + (size_t)l * 1664;
    bf16x8 bw[4][2], ba[4][2];
#pragma unroll
    for (int nt = 0; nt < 4; ++nt)
#pragma unroll
        for (int ks = 0; ks < 2; ++ks) { const size_t o = (size_t)(h * 64 + nt * 16 + lr) * 64 + ks * 32 + lq * 8;
            bw[nt][ks] = *(const bf16x8*)((const bf16_t*)(ws + OFF_W2T) + o); ba[nt][ks] = *(const bf16x8*)((const bf16_t*)(ws + OFF_A2T) + o); }
    float muw[8], mua[8];
#pragma unroll
    for (int e = 0; e < 8; ++e) { muw[e] = mu[1536 + jg * 8 + e]; mua[e] = mu[1600 + jg * 8 + e]; }
    const float mu_r = mu[c], mu_k = mu[512 + c], mu_v = mu[1024 + c];
    const float w0c = ((const float*)P->in[6])[l * 512 + c], a0c = ((const float*)P->in[8])[l * 512 + c];
    const float kkc = ((const float*)P->in[10])[l * 512 + c], kac = ((const float*)P->in[11])[l * 512 + c], rkc = ((const float*)P->in[12])[l * 512 + c];
    const bf16_t* Z = (const bf16_t*)(ws + OFF_ZRW);
    float* PW = (float*)(ws + OFF_PW); bf16_t* PKK = (bf16_t*)(ws + OFF_PKK); bf16_t* PB = (bf16_t*)(ws + OFF_PB); bf16_t* PKM = (bf16_t*)(ws + OFF_PKM); bf16_t* PR = (bf16_t*)(ws + OFF_PR);
    bf16_t* PV = (bf16_t*)(ws + OFF_PV); float* BON = (float*)(ws + OFF_BON);
    for (int rng = obid(); rng < TB / 64; rng += gridDim.x) {
        const int t0 = rng * 64;
        {
            const bf16_t* zc = Z + (size_t)(t0 + tt) * 1792 + 1536 + jg * 8;
            const u32x4 cw = *(const u32x4*)zc, ca = *(const u32x4*)(zc + 64);
            u32x4 pw = {0u, 0u, 0u, 0u}, pa = {0u, 0u, 0u, 0u};
            if (t0 + tt > 0) { pw = *(const u32x4*)(zc - 1792); pa = *(const u32x4*)(zc - 1792 + 64); }
            u32x4 ow, oa;
#pragma unroll
            for (int e = 0; e < 4; ++e) {
                const float c0 = __uint_as_float(cw[e] << 16), c1 = __uint_as_float(cw[e] & 0xffff0000u), p0 = __uint_as_float(pw[e] << 16), p1 = __uint_as_float(pw[e] & 0xffff0000u);
                ow[e] = cvt_pk_bf16(tanhf_(c0 + (p0 - c0) * muw[2 * e]), tanhf_(c1 + (p1 - c1) * muw[2 * e + 1]));
                const float d0 = __uint_as_float(ca[e] << 16), d1 = __uint_as_float(ca[e] & 0xffff0000u), q0 = __uint_as_float(pa[e] << 16), q1 = __uint_as_float(pa[e] & 0xffff0000u);
                oa[e] = cvt_pk_bf16(d0 + (q0 - d0) * mua[2 * e], d1 + (q1 - d1) * mua[2 * e + 1]); }
            *(u32x4*)(AW + tt * 72 + jg * 8) = ow; *(u32x4*)(AA + tt * 72 + jg * 8) = oa;
        }
        __syncthreads();
        float pr = 0.f, pk = 0.f, pv = 0.f;
        if (t0 > 0) { const bf16_t* z = Z + (size_t)(t0 - 1) * 1792; pr = bf2f(z[c]); pk = bf2f(z[512 + c]); pv = bf2f(z[1024 + c]); }
        bf16_t zr[4], zk[4], zv[4], yr[4], yk[4], yv[4];
#pragma unroll
        for (int q = 0; q < 4; ++q) { const bf16_t* z = Z + (size_t)(t0 + q) * 1792; zr[q] = z[c]; zk[q] = z[512 + c]; zv[q] = z[1024 + c]; }
        for (int pass = 0; pass < 4; ++pass) {
            {
                f32x4 accw[4], acca[4];
#pragma unroll
                for (int nt = 0; nt < 4; ++nt) { accw[nt] = (f32x4){0.f, 0.f, 0.f, 0.f}; acca[nt] = (f32x4){0.f, 0.f, 0.f, 0.f}; }
#pragma unroll
                for (int ks = 0; ks < 2; ++ks) { const bf16x8 afw = *(const bf16x8*)(AW + (pass * 16 + lr) * 72 + ks * 32 + lq * 8), afa = *(const bf16x8*)(AA + (pass * 16 + lr) * 72 + ks * 32 + lq * 8);
#pragma unroll
                    for (int nt = 0; nt < 4; ++nt) { accw[nt] = __builtin_amdgcn_mfma_f32_16x16x32_bf16(afw, bw[nt][ks], accw[nt], 0, 0, 0); acca[nt] = __builtin_amdgcn_mfma_f32_16x16x32_bf16(afa, ba[nt][ks], acca[nt], 0, 0, 0); } }
#pragma unroll
                for (int nt = 0; nt < 4; ++nt)
#pragma unroll
                    for (int q = 0; q < 4; ++q) { OUTW[(lq * 4 + q) * 512 + h * 64 + nt * 16 + lr] = accw[nt][q]; OUTA[(lq * 4 + q) * 512 + h * 64 + nt * 16 + lr] = acca[nt][q]; }
            }
            __syncthreads();
            for (int g4 = 0; g4 < 4; ++g4) {
#pragma unroll
              for (int q = 0; q < 4; ++q) { const int tn = pass * 16 + g4 * 4 + 4 + q; const bf16_t* z = Z + (size_t)(t0 + (tn < 64 ? tn : 63)) * 1792; yr[q] = z[c]; yk[q] = z[512 + c]; yv[q] = z[1024 + c]; }
#pragma unroll
              for (int q4 = 0; q4 < 4; ++q4) {
                const int q = g4 * 4 + q4;
                const int t = t0 + pass * 16 + q;
                const float cr = bf2f(zr[q4]), ck = bf2f(zk[q4]), cv = bf2f(zv[q4]);
                const float rs = cr + (pr - cr) * mu_r, ks = ck + (pk - ck) * mu_k, vs = cv + (pv - cv) * mu_v;
                const float accw = w0c + OUTW[q * 512 + c], acca = a0c + OUTA[q * 512 + c];
                const float wdec = __expf(-0.60653065971f * sigmoidf_(accw));
                const float a = sigmoidf_(acca);
                const float kraw = ks * kkc;
                const float ss = wave_sum_dpp(kraw * kraw);
                const float kk = kraw * fminf(__builtin_amdgcn_rsqf(ss), 1e12f);
                const float km = ks * (1.0f + (a - 1.0f) * kac);
                const float bb = kk * a;
                const float bon = wave_sum_dpp(rs * km * rkc);
                const size_t o = (size_t)t * 512 + c;
                PW[o] = wdec; PKK[o] = f2bf(kk); PB[o] = f2bf(bb); PKM[o] = f2bf(km); PR[o] = f2bf(rs); PV[o] = f2bf(vs);
                if (lane == 0) BON[(size_t)t * 8 + h] = bon;
                pr = cr; pk = ck; pv = cv;
              }
#pragma unroll
              for (int q = 0; q < 4; ++q) { zr[q] = yr[q]; zk[q] = yk[q]; zv[q] = yv[q]; }
            }
            __syncthreads();
        }
    }
}
struct RwVec { f32x4 w[2]; u32x4 kk, b, km, r, v; };
template <bool NEED_KM, bool NEED_R>
__device__ __forceinline__ RwVec rw_load(const unsigned char* ws, size_t okv, size_t ov) {
    RwVec q;
    const float* PW = (const float*)(ws + OFF_PW) + okv;
    q.w[0] = *(const f32x4*)PW; q.w[1] = *(const f32x4*)(PW + 4);
    q.kk = *(const u32x4*)((const bf16_t*)(ws + OFF_PKK) + okv); q.b = *(const u32x4*)((const bf16_t*)(ws + OFF_PB) + okv);
    if (NEED_KM) { q.km = *(const u32x4*)((const bf16_t*)(ws + OFF_PKM) + okv); q.v = *(const u32x4*)((const bf16_t*)(ws + OFF_PV) + ov); }
    if (NEED_R) q.r = *(const u32x4*)((const bf16_t*)(ws + OFF_PR) + okv);
    return q;
}
#define RW_PAIR(vec, q) ((f32x2){(vec)[(q) >> 1][((q) & 1) * 2], (vec)[(q) >> 1][((q) & 1) * 2 + 1]})
#define RW_PAIRH(u, q) ((f32x2){__uint_as_float((u)[q] << 16), __uint_as_float((u)[q] & 0xffff0000u)})
template <int MODE>
__device__ __forceinline__ void rw_step(f32x2 (&s)[8][4], const RwVec& q) {
    float sa[8];
    { f32x2 kk2[4];
#pragma unroll
      for (int p = 0; p < 4; ++p) kk2[p] = RW_PAIRH(q.kk, p);
#pragma unroll
      for (int vi = 0; vi < 8; ++vi) { f32x2 a = s[vi][0] * kk2[0];
#pragma unroll
        for (int p = 1; p < 4; ++p) a += s[vi][p] * kk2[p];
        sa[vi] = -red8(a.x + a.y); } }
    f32x2 b2[4], km2[4];
#pragma unroll
    for (int p = 0; p < 4; ++p) { b2[p] = RW_PAIRH(q.b, p); km2[p] = MODE ? RW_PAIRH(q.km, p) : (f32x2){0.f, 0.f}; }
#pragma unroll
    for (int vi = 0; vi < 8; ++vi) {
        const float vv = MODE ? __uint_as_float((vi & 1) ? (q.v[vi >> 1] & 0xffff0000u) : (q.v[vi >> 1] << 16)) : 0.f;
        const f32x2 sa2 = {sa[vi], sa[vi]}, vv2 = {vv, vv};
#pragma unroll
        for (int p = 0; p < 4; ++p) { f32x2 t = sa2 * b2[p]; if (MODE) t += vv2 * km2[p];
            s[vi][p] = s[vi][p] * RW_PAIR(q.w, p) + t; } }
}
template <int MODE>
__device__ __forceinline__ void rwkv_pass1_part(const unsigned char* ws, int wv, int lane) {
    const int vg = lane >> 3, kg = lane & 7;
    for (int u = obid() * 4 + wv; u < 8 * NCH; u += gridDim.x * 4) {
        const int c = u >> 3, h = u & 7;
        f32x2 s[8][4];
#pragma unroll
        for (int vi = 0; vi < 8; ++vi)
#pragma unroll
            for (int p = 0; p < 4; ++p) { s[vi][p].x = (!MODE && vg == kg && vi == 2 * p) ? 1.f : 0.f; s[vi][p].y = (!MODE && vg == kg && vi == 2 * p + 1) ? 1.f : 0.f; }
        const size_t o0 = (size_t)c * LCH * 512 + h * 64, okv = o0 + kg * 8, ov = o0 + vg * 8;
        RwVec A = rw_load<MODE != 0, false>(ws, okv, ov), B = rw_load<MODE != 0, false>(ws, okv + 512, ov + 512), C;
        int i = 0;
        for (; i + 3 <= LCH; i += 3) {
            { const size_t d = (size_t)(i + 2 < LCH ? i + 2 : LCH - 1) * 512; C = rw_load<MODE != 0, false>(ws, okv + d, ov + d); }
            rw_step<MODE>(s, A);
            { const size_t d = (size_t)(i + 3 < LCH ? i + 3 : LCH - 1) * 512; A = rw_load<MODE != 0, false>(ws, okv + d, ov + d); }
            rw_step<MODE>(s, B);
            { const size_t d = (size_t)(i + 4 < LCH ? i + 4 : LCH - 1) * 512; B = rw_load<MODE != 0, false>(ws, okv + d, ov + d); }
            rw_step<MODE>(s, C);
        }
        if (i < LCH) rw_step<MODE>(s, A);
        if (i + 1 < LCH) rw_step<MODE>(s, B);
        if (!MODE) {
            bf16_t* pp = (bf16_t*)(const_cast<unsigned char*>(ws) + OFF_PP) + (size_t)(h * NCH + c) * 4096 + vg * 8;
#pragma unroll
            for (int ki = 0; ki < 8; ++ki) { u32x4 w4;
#pragma unroll
                for (int e = 0; e < 4; ++e) { const float lo = (ki & 1) ? s[2 * e][ki >> 1].y : s[2 * e][ki >> 1].x, hi = (ki & 1) ? s[2 * e + 1][ki >> 1].y : s[2 * e + 1][ki >> 1].x; w4[e] = cvt_pk_bf16(lo, hi); }
                *(u32x4*)(pp + (kg * 8 + ki) * 64) = w4; }
        } else {
            float* pl = (float*)(const_cast<unsigned char*>(ws) + OFF_PL) + (size_t)(h * NCH + c) * 4096 + kg * 8;
#pragma unroll
            for (int vi = 0; vi < 8; ++vi) { *(f32x4*)(pl + (vg * 8 + vi) * 64) = (f32x4){s[vi][0].x, s[vi][0].y, s[vi][1].x, s[vi][1].y}; *(f32x4*)(pl + (vg * 8 + vi) * 64 + 4) = (f32x4){s[vi][2].x, s[vi][2].y, s[vi][3].x, s[vi][3].y}; }
        }
    }
}
__device__ __forceinline__ void rwkv_pass1(KP P) {
    const unsigned char* ws = P->ws;
    const int wave = otid() >> 6, lane = otid() & 63;
    if (wave < 4) rwkv_pass1_part<0>(ws, wave, lane); else rwkv_pass1_part<1>(ws, wave - 4, lane);
}
__device__ __forceinline__ void rwkv_cscan(KP P, unsigned char* sm) {
    unsigned char* ws = P->ws;
    bf16_t* Sb = (bf16_t*)sm;
    const int tid = otid(), wave = tid >> 6, lane = tid & 63, nt = wave & 3, mt0 = (wave >> 2) * 2, lr = lane & 15, lq = lane >> 4;
    const bf16_t* PPT = (const bf16_t*)(ws + OFF_PP); float* PL = (float*)(ws + OFF_PL);
    for (int h = obid(); h < 8; h += gridDim.x) {
        for (int i = tid; i < 64 * 72 / 2; i += 512) ((unsigned*)Sb)[i] = 0u;
        f32x4 mine[2] = {(f32x4){0.f, 0.f, 0.f, 0.f}, (f32x4){0.f, 0.f, 0.f, 0.f}};
        bf16x8 bfr[8][2]; f32x4 lv[8][2];
#define CS_LOAD(dstb, dstl, cc) do { const size_t _b = (size_t)(h * NCH + (cc)) * 4096; \
            _Pragma("unroll") for (int ks = 0; ks < 2; ++ks) dstb[ks] = *(const bf16x8*)(PPT + _b + (nt * 16 + lr) * 64 + ks * 32 + lq * 8); \
            _Pragma("unroll") for (int i = 0; i < 2; ++i) _Pragma("unroll") for (int q = 0; q < 4; ++q) dstl[i][q] = PL[_b + ((mt0 + i) * 16 + lq * 4 + q) * 64 + nt * 16 + lr]; } while (0)
#pragma unroll
        for (int g = 0; g < 8; ++g) CS_LOAD(bfr[g], lv[g], g);
        __syncthreads();
        for (int c0 = 0; c0 < NCH; c0 += 8) {
#pragma unroll
            for (int g = 0; g < 8; ++g) {
                const size_t base = (size_t)(h * NCH + c0 + g) * 4096;
                f32x4 acc[2] = {lv[g][0], lv[g][1]};
#pragma unroll
                for (int ks = 0; ks < 2; ++ks)
#pragma unroll
                    for (int i = 0; i < 2; ++i) { const bf16x8 af = *(const bf16x8*)(Sb + ((mt0 + i) * 16 + lr) * 72 + ks * 32 + lq * 8);
                        acc[i] = __builtin_amdgcn_mfma_f32_16x16x32_bf16(af, bfr[g][ks], acc[i], 0, 0, 0); }
#pragma unroll
                for (int i = 0; i < 2; ++i)
#pragma unroll
                    for (int q = 0; q < 4; ++q) PL[base + ((mt0 + i) * 16 + lq * 4 + q) * 64 + nt * 16 + lr] = mine[i][q];
                mine[0] = acc[0]; mine[1] = acc[1];
                { const int cn = c0 + g + 8 < NCH ? c0 + g + 8 : NCH - 1; CS_LOAD(bfr[g], lv[g], cn); }
                asm volatile("s_waitcnt lgkmcnt(0)\n\ts_barrier" ::: "memory");
#pragma unroll
                for (int i = 0; i < 2; ++i)
#pragma unroll
                    for (int q = 0; q < 4; ++q) Sb[((mt0 + i) * 16 + lq * 4 + q) * 72 + nt * 16 + lr] = f2bf(acc[i][q]);
                asm volatile("s_waitcnt lgkmcnt(0)\n\ts_barrier" ::: "memory");
            }
        }
#undef CS_LOAD
    }
}
__device__ __forceinline__ void rw_out(f32x2 (&s)[8][4], const RwVec& q, int kg, float* yraw) {
    float yo = 0.f;
    f32x2 r2[4];
#pragma unroll
    for (int p = 0; p < 4; ++p) r2[p] = RW_PAIRH(q.r, p);
#pragma unroll
    for (int vi = 0; vi < 8; ++vi) { f32x2 a = s[vi][0] * r2[0];
#pragma unroll
        for (int p = 1; p < 4; ++p) a += s[vi][p] * r2[p];
        const float yv = red8(a.x + a.y); yo = (kg == vi) ? yv : yo; }
    *yraw = yo;
}
__device__ __forceinline__ void rwkv_pass2(KP P) {
    const unsigned char* ws = P->ws;
    const int wave = otid() >> 6, lane = otid() & 63, vg = lane >> 3, kg = lane & 7;
    if (wave >= 4) return;
    for (int u = obid() * 4 + wave; u < 8 * NCH; u += gridDim.x * 4) {
        const int c = u >> 3, h = u & 7;
        float* yr = (float*)(const_cast<unsigned char*>(ws) + OFF_ZRW) + (size_t)c * LCH * 512 + h * 64 + lane;
        f32x2 s[8][4];
        { const float* pl = (const float*)(ws + OFF_PL) + (size_t)(h * NCH + c) * 4096 + kg * 8;
#pragma unroll
          for (int vi = 0; vi < 8; ++vi) { const f32x4 a = *(const f32x4*)(pl + (vg * 8 + vi) * 64), b = *(const f32x4*)(pl + (vg * 8 + vi) * 64 + 4);
              s[vi][0] = (f32x2){a[0], a[1]}; s[vi][1] = (f32x2){a[2], a[3]}; s[vi][2] = (f32x2){b[0], b[1]}; s[vi][3] = (f32x2){b[2], b[3]}; } }
        const int t0 = c * LCH;
        const size_t o0 = (size_t)t0 * 512 + h * 64, okv = o0 + kg * 8, ov = o0 + vg * 8;
        RwVec A = rw_load<true, true>(ws, okv, ov), B = rw_load<true, true>(ws, okv + 512, ov + 512), C;
        int i = 0;
        for (; i + 3 <= LCH; i += 3) {
            { const size_t d = (size_t)(i + 2 < LCH ? i + 2 : LCH - 1) * 512; C = rw_load<true, true>(ws, okv + d, ov + d); }
            rw_step<1>(s, A); rw_out(s, A, kg, yr + (size_t)(i) * 512);
            { const size_t d = (size_t)(i + 3 < LCH ? i + 3 : LCH - 1) * 512; A = rw_load<true, true>(ws, okv + d, ov + d); }
            rw_step<1>(s, B); rw_out(s, B, kg, yr + (size_t)(i + 1) * 512);
            { const size_t d = (size_t)(i + 4 < LCH ? i + 4 : LCH - 1) * 512; B = rw_load<true, true>(ws, okv + d, ov + d); }
            rw_step<1>(s, C); rw_out(s, C, kg, yr + (size_t)(i + 2) * 512);
        }
        if (i < LCH) { rw_step<1>(s, A); rw_out(s, A, kg, yr + (size_t)(i) * 512); }
        if (i + 1 < LCH) { rw_step<1>(s, B); rw_out(s, B, kg, yr + (size_t)(i + 1) * 512); }
    }
}

__device__ __forceinline__ void rw_post(KP P, int l) {
    const unsigned char* ws = P->ws;
    const int lane = otid() & 63, gw = obid() * 8 + (otid() >> 6), nw = gridDim.x * 8;
    const float* YR = (const float*)(ws + OFF_ZRW); const bf16_t* PV = (const bf16_t*)(ws + OFF_PV); const float* BON = (const float*)(ws + OFF_BON);
    bf16_t* ZG = (bf16_t*)(const_cast<unsigned char*>(ws) + OFF_ZG);
    const float* lngp = (const float*)P->in[13] + l * 512; const float* lnbp = (const float*)P->in[14] + l * 512;
    for (int task0 = gw; task0 < TB * 8; task0 += 4 * nw) {
        float y[4], vv[4], bon[4], gg[4];
#pragma unroll
        for (int q = 0; q < 4; ++q) { const int task = task0 + q * nw; const int t = task >> 3, h = task & 7, col = h * 64 + lane;
            y[q] = YR[(size_t)t * 512 + col]; vv[q] = bf2f(PV[(size_t)t * 512 + col]); bon[q] = BON[(size_t)t * 8 + h]; gg[q] = bf2f(ZG[(size_t)t * 2048 + col]); }
#pragma unroll
        for (int q = 0; q < 4; ++q) { const int task = task0 + q * nw; const int t = task >> 3, h = task & 7, col = h * 64 + lane;
            const float mean = wave_total_from_groups(red8(y[q])) * (1.0f / 64.0f); const float d = y[q] - mean;
            const float var = wave_total_from_groups(red8(d * d)) * (1.0f / 64.0f);
            const float yn = d * rsqrtf(var + 64e-5f) * lngp[col] + lnbp[col] + bon[q] * vv[q];
            ZG[(size_t)t * 2048 + col] = f2bf(yn * siluf_(gg[q])); }
    }
}

__device__ __forceinline__ void rope_cs(int i, float posf, float& cs, float& sn) {
    const float inv = (float)exp2(-(double)i * (13.287712379549449 / 32.0));
    const float ang = posf * inv;
    const double a = (double)ang; const double kq = rint(a * 0.15915494309189535); const float r = (float)(a - kq * 6.283185307179586);
    cs = __cosf(r); sn = __sinf(r);
}
__device__ __forceinline__ void rope_table(KP P) {
    float* tab = (float*)(P->ws + OFF_ROPE); const int* pos = (const int*)P->in[2];
    for (int i = obid() * 512 + otid(); i < 2 * TB * 32; i += gridDim.x * 512) {
        float cs, sn; rope_cs(i & 31, (float)pos[i >> 5], cs, sn);
        *(f32x2*)(tab + (size_t)i * 2) = (f32x2){cs, sn}; }
}
struct GrRaw { u32x4 flo[2]; u32x4 qa, qb, ka, kb; f32x4 cs[4]; u32x4 v[2]; };
template <bool NEED_Q>
__device__ __forceinline__ GrRaw gr_load_raw(KP P, int b, int kind, int tg, int h, int dg) {
    GrRaw r;
    if (kind == 0) {
        const bf16_t* z = (const bf16_t*)(P->ws + OFF_ZGLA) + (size_t)tg * 1280;
        r.flo[0] = *(const u32x4*)(z + 1024); r.flo[1] = *(const u32x4*)(z + 1032);
        if (NEED_Q) r.qa = *(const u32x4*)(z + h * 64 + dg * 8);
        r.ka = *(const u32x4*)(z + 256 + h * 64 + dg * 8);
        r.v[0] = *(const u32x4*)(z + 512 + h * 128 + dg * 16); r.v[1] = *(const u32x4*)(z + 512 + h * 128 + dg * 16 + 8);
    } else {
        const bf16_t* z = (const bf16_t*)(P->ws + OFF_ZRET) + (size_t)tg * 1024; const int i0 = (dg & 3) * 8;
        if (NEED_Q) { r.qa = *(const u32x4*)(z + h * 64 + i0); r.qb = *(const u32x4*)(z + h * 64 + i0 + 32); }
        r.ka = *(const u32x4*)(z + 256 + h * 64 + i0); r.kb = *(const u32x4*)(z + 256 + h * 64 + i0 + 32);
        const float* tab = (const float*)(P->ws + OFF_ROPE) + (((size_t)b * TB + tg) * 32 + i0) * 2;
#pragma unroll
        for (int e = 0; e < 4; ++e) r.cs[e] = *(const f32x4*)(tab + 4 * e);
        r.v[0] = *(const u32x4*)(z + 512 + h * 128 + dg * 16); r.v[1] = *(const u32x4*)(z + 512 + h * 128 + dg * 16 + 8);
    }
    return r;
}
__device__ __forceinline__ float bfel(const u32x4& u, int dd) { return __uint_as_float((dd & 1) ? (u[dd >> 1] & 0xffff0000u) : (u[dd >> 1] << 16)); }
__device__ __forceinline__ float gr_val(const GrRaw& r, int kind, int dg, int dd, const u32x4& a, const u32x4& bq) {
    if (kind == 0) return bfel(a, dd);
    const float x1 = bfel(a, dd), x2 = bfel(bq, dd), cs = r.cs[dd >> 1][(dd & 1) * 2], sn = r.cs[dd >> 1][(dd & 1) * 2 + 1];
    return dg < 4 ? x1 * cs - x2 * sn : x1 * sn + x2 * cs;
}
__device__ __forceinline__ void gr_stage_b(KP P, int l, int kind, int h, const GrRaw& r, float* Bm) {
    const int tid = otid(), t = tid >> 3, dg = tid & 7;
    if (kind == 0) {
        float fl[16];
#pragma unroll
        for (int e = 0; e < 8; ++e) { fl[e] = bfel(r.flo[0], e); fl[8 + e] = bfel(r.flo[1], e); }
        const float* fup = (const float*)P->in[15] + (size_t)l * 16 * 256; const float* fb = (const float*)P->in[16] + (size_t)l * 256;
#pragma unroll
        for (int dd = 0; dd < 8; ++dd) { const int d = dg * 8 + dd; float x = fb[h * 64 + d];
#pragma unroll
            for (int j = 0; j < 16; ++j) x += fl[j] * fup[j * 256 + h * 64 + d];
            Bm[t * 64 + d] = -softplusf_(-x) * (1.0f / 16.0f); }
    } else {
        const float lg = __logf(1.0f - exp2f(-5.0f - (float)h)) * (float)(t + 1);
#pragma unroll
        for (int dd = 0; dd < 8; ++dd) Bm[t * 64 + dg * 8 + dd] = lg;
    }
    __syncthreads();
    if (kind == 0) {
        float* SEG = Bm + 64 * 64 + 25088;
        const int d = tid & 63, seg = tid >> 6;
        float run = 0.f;
#pragma unroll
        for (int q = 0; q < 8; ++q) { run += Bm[(seg * 8 + q) * 64 + d]; Bm[(seg * 8 + q) * 64 + d] = run; }
        SEG[seg * 64 + d] = run;
        __syncthreads();
        float off = 0.f;
#pragma unroll
        for (int q = 0; q < 7; ++q) off += (q < seg) ? SEG[q * 64 + d] : 0.f;
#pragma unroll
        for (int q = 0; q < 8; ++q) Bm[(seg * 8 + q) * 64 + d] += off;
        __syncthreads();
    }
}
__device__ __forceinline__ void gr_ds(KP P, int l, int b, unsigned char* sm, int bskip) {
    float* Bm = (float*)sm; bf16_t* KET = (bf16_t*)(sm + 16384); bf16_t* VT = (bf16_t*)(sm + 25600);
    const int tid = otid(), t = tid >> 3, dg = tid & 7, wave = tid >> 6, lane = tid & 63;
    float* DEC = (float*)(P->ws + OFF_DEC);
    for (int idx = obid() - bskip; idx < 2048; idx += gridDim.x - bskip) {
        const int kind = idx >> 10, n = (idx >> 2) & 255, h = idx & 3, tg = n * 64 + t;
        const GrRaw raw = gr_load_raw<false>(P, b, kind, tg, h, dg);
        gr_stage_b(P, l, kind, h, raw, Bm);
#pragma unroll
        for (int dd = 0; dd < 8; ++dd) { const int d = dg * 8 + dd; const float bl = Bm[63 * 64 + d], bt = Bm[t * 64 + d];
            float kv = gr_val(raw, kind, dg, dd, raw.ka, raw.kb); if (kind == 1) kv *= 0.125f;
            KET[d * 72 + t] = f2bf(kv * __expf(bl - bt));
            if (t == 63 && kind == 0) DEC[(size_t)(n * 4 + h) * 64 + d] = __expf(bl); }
#pragma unroll
        for (int e = 0; e < 16; ++e) VT[(dg * 16 + e) * 72 + (t ^ (dg << 3))] = (bf16_t)((e & 1) ? (raw.v[e >> 3][(e >> 1) & 3] >> 16) : (raw.v[e >> 3][(e >> 1) & 3] & 0xffffu));
        __syncthreads();
        f32x4 acc[4];
#pragma unroll
        for (int mt = 0; mt < 4; ++mt) acc[mt] = (f32x4){0.f, 0.f, 0.f, 0.f};
#pragma unroll
        for (int ks = 0; ks < 2; ++ks) { const bf16x8 bf = *(const bf16x8*)(VT + (wave * 16 + (lane & 15)) * 72 + ((ks * 32 + (lane >> 4) * 8) ^ (wave << 3)));
#pragma unroll
            for (int mt = 0; mt < 4; ++mt) { const bf16x8 af = *(const bf16x8*)(KET + (mt * 16 + (lane & 15)) * 72 + ks * 32 + (lane >> 4) * 8);
                acc[mt] = __builtin_amdgcn_mfma_f32_16x16x32_bf16(af, bf, acc[mt], 0, 0, 0); } }
        bf16_t* dsp = (bf16_t*)(P->ws + (kind ? OFF_DSG1 : OFF_DSG0)) + ((size_t)n * 4 + h) * 64 * 128;
#pragma unroll
        for (int mt = 0; mt < 4; ++mt)
#pragma unroll
            for (int j = 0; j < 4; ++j) dsp[(size_t)(mt * 16 + (lane >> 4) * 4 + j) * 128 + wave * 16 + (lane & 15)] = f2bf(acc[mt][j]);
        __syncthreads();
    }
}
__device__ __forceinline__ void gr_scan(KP P, int tid256  ) {
    const float* DEC = (const float*)(P->ws + OFF_DEC);
    for (int blk = obid(); blk < 258; blk += gridDim.x) {
        if (blk < 256) {
            const int gid = blk * 256 + tid256, kind = gid >> 15, e = gid & 32767, h = e >> 13, d = (e >> 7) & 63, vch = e & 127;
            bf16_t* DS = (bf16_t*)(P->ws + (kind ? OFF_DSG1 : OFF_DSG0));
            const float rdec = __expf(64.0f * __logf(1.0f - exp2f(-5.0f - (float)h)));
            float st = 0.f;
            for (int n0 = 0; n0 < 256; n0 += 16) {
                float dsv[16], dc[16];
#pragma unroll
                for (int q = 0; q < 16; ++q) { const int n = n0 + q; dsv[q] = bf2f(DS[(((size_t)n * 4 + h) * 64 + d) * 128 + vch]); dc[q] = kind == 0 ? DEC[(size_t)(n * 4 + h) * 64 + d] : rdec; }
#pragma unroll
                for (int q = 0; q < 16; ++q) { const int n = n0 + q; DS[(((size_t)n * 4 + h) * 64 + d) * 128 + vch] = f2bf(st); st = st * dc[q] + dsv[q]; }
            }
        } else {
            const float* AC = (const float*)(P->ws + OFF_AC); const float* HC = (const float*)(P->ws + OFF_HC); float* HIN = (float*)(P->ws + OFF_HIN);
            const int d = (blk - 256) * 256 + tid256; float hin = 0.f;
            for (int n0 = 0; n0 < 256; n0 += 32) {
                float av[32], hv[32];
#pragma unroll
                for (int q = 0; q < 32; ++q) { av[q] = AC[(n0 + q) * 512 + d]; hv[q] = HC[(n0 + q) * 512 + d]; }
#pragma unroll
                for (int q = 0; q < 32; ++q) { HIN[(n0 + q) * 512 + d] = hin; hin = av[q] * hin + hv[q]; }
            }
        }
    }
}
__device__ __forceinline__ void gr_out(KP P, int l, int b, unsigned char* sm, bf16_t* yout, int ystride) {
    float* Bm = (float*)sm; bf16_t* QD = (bf16_t*)(sm + 16384); bf16_t* KD = (bf16_t*)(sm + 25600); bf16_t* ATT = (bf16_t*)(sm + 34816);
    bf16_t* VT = (bf16_t*)(sm + 44032); bf16_t* ST = (bf16_t*)(sm + 62464); float* O = (float*)(sm + 80896);
    const int tid = otid(), t = tid >> 3, dg = tid & 7, wave = tid >> 6, lane = tid & 63;
    bf16_t* ZG = (bf16_t*)(P->ws + OFF_ZG);
    for (int idx = obid(); idx < 2048; idx += gridDim.x) {
        const int kind = idx >> 10, n = (idx >> 2) & 255, h = idx & 3, tg = n * 64 + t;
        const GrRaw raw = gr_load_raw<true>(P, b, kind, tg, h, dg);
        u32x4 stv[2];
        { const bf16_t* dsp = (const bf16_t*)(P->ws + (kind ? OFF_DSG1 : OFF_DSG0)) + ((size_t)n * 4 + h) * 64 * 128 + tid * 16;
          stv[0] = *(const u32x4*)dsp; stv[1] = *(const u32x4*)(dsp + 8); }
        bf16_t* gp = ZG + (size_t)tg * 2048 + (kind == 0 ? 512 : 1024) + h * 128 + dg * 16;
        const u32x4 g0 = *(const u32x4*)gp, g1 = *(const u32x4*)(gp + 8);
        gr_stage_b(P, l, kind, h, raw, Bm);
#pragma unroll
        for (int dd = 0; dd < 8; ++dd) { const int d = dg * 8 + dd; const float bt = Bm[t * 64 + d];
            float qv = gr_val(raw, kind, dg, dd, raw.qa, raw.qb), kv = gr_val(raw, kind, dg, dd, raw.ka, raw.kb);
            if (kind == 0) qv *= 0.125f; else kv *= 0.125f;
            const float eb = __expf(bt); QD[t * 72 + d] = f2bf(qv * eb); KD[t * 72 + d] = f2bf(kv * __builtin_amdgcn_rcpf(eb)); }
#pragma unroll
        for (int e = 0; e < 16; ++e) VT[(dg * 16 + e) * 72 + (t ^ (dg << 3))] = (bf16_t)((e & 1) ? (raw.v[e >> 3][(e >> 1) & 3] >> 16) : (raw.v[e >> 3][(e >> 1) & 3] & 0xffffu));
#pragma unroll
        for (int e = 0; e < 16; ++e) ST[(dg * 16 + e) * 72 + (t ^ (dg << 3))] = (bf16_t)((e & 1) ? (stv[e >> 3][(e >> 1) & 3] >> 16) : (stv[e >> 3][(e >> 1) & 3] & 0xffffu));
        __syncthreads();
        {
            const int nt = wave & 3, mt0 = (wave >> 2) * 2;
            f32x4 a2[2] = {(f32x4){0.f, 0.f, 0.f, 0.f}, (f32x4){0.f, 0.f, 0.f, 0.f}};
#pragma unroll
            for (int ks = 0; ks < 2; ++ks) { const bf16x8 bf = *(const bf16x8*)(KD + (nt * 16 + (lane & 15)) * 72 + ks * 32 + (lane >> 4) * 8);
#pragma unroll
                for (int i = 0; i < 2; ++i) { const bf16x8 af = *(const bf16x8*)(QD + ((mt0 + i) * 16 + (lane & 15)) * 72 + ks * 32 + (lane >> 4) * 8);
                    a2[i] = __builtin_amdgcn_mfma_f32_16x16x32_bf16(af, bf, a2[i], 0, 0, 0); } }
#pragma unroll
            for (int i = 0; i < 2; ++i)
#pragma unroll
                for (int j = 0; j < 4; ++j) { const int tt = (mt0 + i) * 16 + (lane >> 4) * 4 + j, ss = nt * 16 + (lane & 15);
                    ATT[tt * 72 + ss] = f2bf(ss <= tt ? a2[i][j] : 0.f); }
        }
        __syncthreads();
        {
            f32x4 acc[4];
#pragma unroll
            for (int mt = 0; mt < 4; ++mt) acc[mt] = (f32x4){0.f, 0.f, 0.f, 0.f};
#pragma unroll
            for (int ks = 0; ks < 2; ++ks) {
                const bf16x8 b1 = *(const bf16x8*)(VT + (wave * 16 + (lane & 15)) * 72 + ((ks * 32 + (lane >> 4) * 8) ^ (wave << 3)));
                const bf16x8 b2 = *(const bf16x8*)(ST + (wave * 16 + (lane & 15)) * 72 + ((ks * 32 + (lane >> 4) * 8) ^ (wave << 3)));
#pragma unroll
                for (int mt = 0; mt < 4; ++mt) {
                    const bf16x8 a1 = *(const bf16x8*)(ATT + (mt * 16 + (lane & 15)) * 72 + ks * 32 + (lane >> 4) * 8);
                    const bf16x8 aq = *(const bf16x8*)(QD + (mt * 16 + (lane & 15)) * 72 + ks * 32 + (lane >> 4) * 8);
                    acc[mt] = __builtin_amdgcn_mfma_f32_16x16x32_bf16(a1, b1, acc[mt], 0, 0, 0);
                    acc[mt] = __builtin_amdgcn_mfma_f32_16x16x32_bf16(aq, b2, acc[mt], 0, 0, 0); } }
#pragma unroll
            for (int mt = 0; mt < 4; ++mt)
#pragma unroll
                for (int j = 0; j < 4; ++j) O[(mt * 16 + (lane >> 4) * 4 + j) * 132 + wave * 16 + (lane & 15)] = acc[mt][j];
        }
        __syncthreads();
        {
            float v[16]; float s1 = 0.f, s2 = 0.f;
#pragma unroll
            for (int e = 0; e < 16; ++e) { v[e] = O[t * 132 + dg * 16 + e]; s1 += v[e]; s2 += v[e] * v[e]; }
#pragma unroll
            for (int o = 1; o <= 4; o <<= 1) { s1 += shx(s1, lane, o); s2 += shx(s2, lane, o); }
            float mean = 0.f, rs;
            if (kind == 0) rs = rsqrtf(s2 * (1.0f / 128.0f) + 1e-6f);
            else { mean = s1 * (1.0f / 128.0f); const float var = fmaxf(s2 * (1.0f / 128.0f) - mean * mean, 0.f); rs = rsqrtf(var + 1e-6f); }
            const float* gn = (kind == 0 ? (const float*)P->in[17] : (const float*)P->in[18]) + (size_t)l * 512 + h * 128 + dg * 16;
            float gv[16];
#pragma unroll
            for (int e = 0; e < 4; ++e) { gv[2 * e] = __uint_as_float(g0[e] << 16); gv[2 * e + 1] = __uint_as_float(g0[e] & 0xffff0000u); gv[8 + 2 * e] = __uint_as_float(g1[e] << 16); gv[8 + 2 * e + 1] = __uint_as_float(g1[e] & 0xffff0000u); }
            float r[16];
#pragma unroll
            for (int e = 0; e < 16; ++e) r[e] = (v[e] - mean) * rs * gn[e] * siluf_(gv[e]);
            u32x4 w0, w1;
            w0.x = cvt_pk_bf16(r[0], r[1]); w0.y = cvt_pk_bf16(r[2], r[3]); w0.z = cvt_pk_bf16(r[4], r[5]); w0.w = cvt_pk_bf16(r[6], r[7]);
            w1.x = cvt_pk_bf16(r[8], r[9]); w1.y = cvt_pk_bf16(r[10], r[11]); w1.z = cvt_pk_bf16(r[12], r[13]); w1.w = cvt_pk_bf16(r[14], r[15]);
            { bf16_t* op = yout + (size_t)tg * ystride + (kind == 0 ? 512 : 1024) + h * 128 + dg * 16; *(u32x4*)op = w0; *(u32x4*)(op + 8) = w1; }
        }
        __syncthreads();
    }
}

__device__ __forceinline__ void lru_conv_w(KP P, int l) {
    bf16_t* WAT = (bf16_t*)(P->ws + OFF_WAT); bf16_t* WXT = (bf16_t*)(P->ws + OFF_WXT);
    const float* wa = (const float*)P->in[21] + (size_t)l * 8 * 4096; const float* wx = (const float*)P->in[23] + (size_t)l * 8 * 4096;
    for (int idx = obid() * 512 + otid(); idx < 8 * 4096; idx += gridDim.x * 512) {
        const int n = idx >> 12, dd = (idx >> 6) & 63, c = idx & 63;
        WAT[idx] = f2bf(wa[(n * 64 + c) * 64 + dd]); WXT[idx] = f2bf(wx[(n * 64 + c) * 64 + dd]); }
}
__device__ __forceinline__ void lru_p1(KP P, int l, int n_first, int n_step, int n_end, unsigned char* sm) {
    unsigned char* ws = P->ws;
    bf16_t* XC = (bf16_t*)sm; float* OUTA = (float*)(sm + 16640); float* OUTX = (float*)(sm + 49408);
    const int d = otid(), lane = d & 63, blk = d >> 6, lr = lane & 15, lq = lane >> 4;
    const bf16_t* wat = (const bf16_t*)(ws + OFF_WAT) + (size_t)(blk * 64 + lr) * 64 + lq * 8; const bf16_t* wxt = (const bf16_t*)(ws + OFF_WXT) + (size_t)(blk * 64 + lr) * 64 + lq * 8;
    const float* cwp = (const float*)P->in[19] + (size_t)l * 4 * 512;
    const float cw0 = cwp[d], cw1 = cwp[512 + d], cw2 = cwp[1024 + d], cw3 = cwp[1536 + d], cb = ((const float*)P->in[20])[l * 512 + d];
    const float ba = ((const float*)P->in[22])[l * 512 + d], bx = ((const float*)P->in[24])[l * 512 + d];
    const float sp = softplusf_(-((const float*)P->in[25])[l * 512 + d]);
    const bf16_t* X = (const bf16_t*)(ws + OFF_ZLRU);
    bf16_t* HL = (bf16_t*)(ws + OFF_HL); bf16_t* CA = (bf16_t*)(ws + OFF_CA); float* AC = (float*)(ws + OFF_AC); float* HC = (float*)(ws + OFF_HC);
    for (int n = n_first; n < n_end; n += n_step) {
        const int t0 = n * 64;
        float x1 = 0.f, x2 = 0.f, x3 = 0.f;
        if (t0 > 0) { x1 = bf2f(X[(size_t)(t0 - 1) * 512 + d]); x2 = bf2f(X[(size_t)(t0 - 2) * 512 + d]); x3 = bf2f(X[(size_t)(t0 - 3) * 512 + d]); }
        float hloc = 0.f, cum = 1.f;
        bf16_t xa[16], xb[16];
#pragma unroll
        for (int q = 0; q < 16; ++q) xa[q] = X[(size_t)(t0 + q) * 512 + d];
        for (int tg = 0; tg < 4; ++tg) {
#pragma unroll
          for (int q = 0; q < 16; ++q) xb[q] = X[(size_t)(t0 + (tg < 3 ? tg + 1 : tg) * 16 + q) * 512 + d];
          const float h1 = x1, h2 = x2, h3 = x3;
#pragma unroll
          for (int q = 0; q < 16; ++q) { const float x0 = bf2f(xa[q]); XC[q * 520 + d] = f2bf(x3 * cw0 + x2 * cw1 + x1 * cw2 + x0 * cw3 + cb); x3 = x2; x2 = x1; x1 = x0; }
          __syncthreads();
          { const bf16x8 af0 = *(const bf16x8*)(XC + lr * 520 + blk * 64 + lq * 8), af1 = *(const bf16x8*)(XC + lr * 520 + blk * 64 + 32 + lq * 8);
#pragma unroll
            for (int nt = 0; nt < 4; ++nt) { f32x4 aa = {0.f, 0.f, 0.f, 0.f};
                aa = __builtin_amdgcn_mfma_f32_16x16x32_bf16(af0, *(const bf16x8*)(wat + nt * 1024), aa, 0, 0, 0); aa = __builtin_amdgcn_mfma_f32_16x16x32_bf16(af1, *(const bf16x8*)(wat + nt * 1024 + 32), aa, 0, 0, 0);
#pragma unroll
                for (int q = 0; q < 4; ++q) OUTA[(lq * 4 + q) * 512 + blk * 64 + nt * 16 + lr] = aa[q]; }
#pragma unroll
            for (int nt = 0; nt < 4; ++nt) { f32x4 ax = {0.f, 0.f, 0.f, 0.f};
                ax = __builtin_amdgcn_mfma_f32_16x16x32_bf16(af0, *(const bf16x8*)(wxt + nt * 1024), ax, 0, 0, 0); ax = __builtin_amdgcn_mfma_f32_16x16x32_bf16(af1, *(const bf16x8*)(wxt + nt * 1024 + 32), ax, 0, 0, 0);
#pragma unroll
                for (int q = 0; q < 4; ++q) OUTX[(lq * 4 + q) * 512 + blk * 64 + nt * 16 + lr] = ax[q]; } }
          __syncthreads();
          float g1 = h1, g2 = h2, g3 = h3;
#pragma unroll 4
          for (int q = 0; q < 16; ++q) {
            const int t = t0 + tg * 16 + q;
            const float ra = ba + OUTA[q * 512 + d], ri = bx + OUTX[q * 512 + d];
            const float r = sigmoidf_(ra), ig = sigmoidf_(ri);
            const float la = -8.0f * r * sp; const float a = __expf(la);
            const float x2l = 2.0f * la;
            const float om = x2l > -0.02f ? -(x2l * (1.0f + x2l * (0.5f + x2l * (1.0f / 6.0f)))) : 1.0f - a * a;
            const float x0 = bf2f(xa[q]); const float xcq = g3 * cw0 + g2 * cw1 + g1 * cw2 + x0 * cw3 + cb; g3 = g2; g2 = g1; g1 = x0;
            const float uu = __builtin_amdgcn_sqrtf(fmaxf(om, 0.f)) * (ig * xcq);
            hloc = a * hloc + uu; cum *= a;
            HL[(size_t)t * 512 + d] = f2bf(hloc); CA[(size_t)t * 512 + d] = f2bf(cum);
          }
          __syncthreads();
#pragma unroll
          for (int q = 0; q < 16; ++q) xa[q] = xb[q];
        }
        AC[n * 512 + d] = cum; HC[n * 512 + d] = hloc;
    }
}
__device__ __forceinline__ void lru_p3(KP P, bf16_t* yout, int ystride) {
    unsigned char* ws = P->ws;
    const bf16_t* HL = (const bf16_t*)(ws + OFF_HL); const bf16_t* CA = (const bf16_t*)(ws + OFF_CA); const float* HIN = (const float*)(ws + OFF_HIN);
    bf16_t* ZG = (bf16_t*)(ws + OFF_ZG);
    const int total = TB * 128, stride = (int)gridDim.x * 512;
    for (int i0 = obid() * 512 + otid(); i0 < total; i0 += 4 * stride) {
        u32x2 hq[4], cq[4], gq[4]; f32x4 hi[4];
#pragma unroll
        for (int q = 0; q < 4; ++q) { const int i = i0 + q * stride; const int t = i >> 7, d4 = (i & 127) * 4;
            hq[q] = *(const u32x2*)(HL + (size_t)t * 512 + d4); cq[q] = *(const u32x2*)(CA + (size_t)t * 512 + d4); hi[q] = *(const f32x4*)(HIN + (size_t)(t >> 6) * 512 + d4);
            gq[q] = *(const u32x2*)(ZG + (size_t)t * 2048 + 1536 + d4); }
#pragma unroll
        for (int q = 0; q < 4; ++q) { const int i = i0 + q * stride; const int t = i >> 7, d4 = (i & 127) * 4;
            const f32x4 hl = {__uint_as_float(hq[q].x << 16), __uint_as_float(hq[q].x & 0xffff0000u), __uint_as_float(hq[q].y << 16), __uint_as_float(hq[q].y & 0xffff0000u)};
            const f32x4 ca = {__uint_as_float(cq[q].x << 16), __uint_as_float(cq[q].x & 0xffff0000u), __uint_as_float(cq[q].y << 16), __uint_as_float(cq[q].y & 0xffff0000u)};
            const float g0 = __uint_as_float(gq[q].x << 16), g1 = __uint_as_float(gq[q].x & 0xffff0000u), g2 = __uint_as_float(gq[q].y << 16), g3 = __uint_as_float(gq[q].y & 0xffff0000u);
            u32x2 w; w.x = cvt_pk_bf16((hl[0] + ca[0] * hi[q][0]) * siluf_(g0), (hl[1] + ca[1] * hi[q][1]) * siluf_(g1));
            w.y = cvt_pk_bf16((hl[2] + ca[2] * hi[q][2]) * siluf_(g2), (hl[3] + ca[3] * hi[q][3]) * siluf_(g3));
            *(u32x2*)(yout + (size_t)t * ystride + 1536 + d4) = w; }
    }
}

#define XB_TMO      128
#define XB_XCNT(j)  (256  + 64 * (j))
#define XB_XSUB(j)  (1280 + 64 * (j))
#define XB_XGEN(j)  (2304 + 64 * (j))
#define XB_TOP      3328
#define XB_TOPGEN   3392
#define XCD_BAR_WORDS 3456
#define XB_SPIN_CAP (1u << 22)
__device__ __forceinline__ unsigned xb_ld(unsigned* p)              { return __hip_atomic_load(p, __ATOMIC_RELAXED, __HIP_MEMORY_SCOPE_AGENT); }
__device__ __forceinline__ unsigned xb_add(unsigned* p, unsigned v) { return __hip_atomic_fetch_add(p, v, __ATOMIC_RELAXED, __HIP_MEMORY_SCOPE_AGENT); }
__device__ __forceinline__ unsigned xb_xcc_id() { return (unsigned)__builtin_amdgcn_s_getreg((3 << 11) | 20) & 0xFu; }
#define XB_SPIN(cond, bar) do { unsigned _sp = 0; while (cond) { __builtin_amdgcn_s_sleep(1); \
    if ((++_sp & 255u) == 0u) { if (xb_ld(&(bar)[XB_TMO])) break; if (_sp > XB_SPIN_CAP) { atomicAdd(&(bar)[XB_TMO], 1u); break; } } } } while (0)
struct XcdBarrier { unsigned* bar; unsigned x; volatile LAS unsigned* st; };
__device__ __forceinline__ XcdBarrier xcd_barrier_post(unsigned* bar, volatile LAS unsigned* st) {
    XcdBarrier b; b.bar = bar; b.x = xb_xcc_id(); b.st = st;
    if (threadIdx.x == 0) (void)xb_add(&bar[XB_XCNT(b.x)], 1u);
    return b;
}
__device__ __forceinline__ void xcd_barrier_complete(unsigned* bar, unsigned x, unsigned& nloc, unsigned& nx) {
    const unsigned G = gridDim.x * gridDim.y * gridDim.z;
    unsigned sum, cnt, mine, sp = 0u;
    for (;;) {
        sum = 0u; cnt = 0u; mine = 0u;
#pragma unroll
        for (unsigned j = 0; j < 16; ++j) { const unsigned c = xb_ld(&bar[XB_XCNT(j)]); sum += c; cnt += (c > 0u) ? 1u : 0u; mine = (j == x) ? c : mine; }
        if (sum == G) break;
        __builtin_amdgcn_s_sleep(1);
        if ((++sp & 255u) == 0u) { if (xb_ld(&bar[XB_TMO])) break; if (sp > XB_SPIN_CAP) { atomicAdd(&bar[XB_TMO], 1u); break; } }
    }
    nloc = mine > 0u ? mine : 1u; nx = cnt > 0u ? cnt : 1u;
}
__device__ __forceinline__ void xcd_barrier(const XcdBarrier& b) {
    asm volatile("s_waitcnt vmcnt(0)" ::: "memory");
    __syncthreads();
    if (threadIdx.x == 0) {
        unsigned* bar = b.bar;
        __builtin_amdgcn_s_waitcnt(0);
        unsigned nloc = b.st[0], nx = b.st[1];
        if (nloc == 0u) { xcd_barrier_complete(bar, b.x, nloc, nx); b.st[0] = nloc; b.st[1] = nx; }
        const unsigned old = xb_add(&bar[XB_XSUB(b.x)], 1u);
        const unsigned gen = old / nloc;
        if (old + 1u == (gen + 1u) * nloc) {
            __builtin_amdgcn_fence(__ATOMIC_RELEASE, "agent");
            asm volatile("s_waitcnt vmcnt(0)" ::: "memory");
            const unsigned og = xb_add(&bar[XB_TOP], 1u);
            const unsigned tg = og / nx;
            if (og + 1u == (tg + 1u) * nx) xb_add(&bar[XB_TOPGEN], 1u);
            else XB_SPIN(xb_ld(&bar[XB_TOPGEN]) == tg, bar);
            __builtin_amdgcn_fence(__ATOMIC_ACQUIRE, "agent");
            xb_add(&bar[XB_XGEN(b.x)], 1u);
            asm volatile("s_waitcnt vmcnt(0)" ::: "memory");
        } else {
            XB_SPIN(xb_ld(&bar[XB_XGEN(b.x)]) == gen, bar);
            __builtin_amdgcn_fence(__ATOMIC_ACQUIRE, "agent");
            asm volatile("s_waitcnt vmcnt(0)" ::: "memory");
        }
    }
    __syncthreads();
}

__global__ void __launch_bounds__(512) fwd_megakernel(Params Parg) {
    extern __shared__ __attribute__((aligned(16))) unsigned char shm[];
    cg::grid_group grid = cg::this_grid();
    LAS unsigned char* lds = (LAS unsigned char*)shm;
    using namespace pg8;
    if (threadIdx.x < 4) ((volatile LAS unsigned*)(lds + STAGE_BYTES + 16384))[threadIdx.x] = 0u;
    __syncthreads();
    if (obid() == 0) { KP Pb = kparams(); u32x4* bw = (u32x4*)(Pb->ws + OFF_BAR); const int ti = otid(); bw[ti] = (u32x4){0u, 0u, 0u, 0u}; bw[ti + 512] = (u32x4){0u, 0u, 0u, 0u}; __threadfence(); }
    rope_table(kparams());
    grid.sync();
    { KP Pb = kparams(); (void)xcd_barrier_post((unsigned*)(Pb->ws + OFF_BAR), (volatile LAS unsigned*)(lds + STAGE_BYTES + 16384)); }
#ifndef DUP_GEMM
#define DUP_GEMM 1
#endif
#ifndef DUP_PREP
#define DUP_PREP 1
#endif
#ifndef DUP_P1
#define DUP_P1 1
#endif
#ifndef DUP_P2
#define DUP_P2 1
#endif
#ifndef DUP_GO
#define DUP_GO 1
#endif
#ifndef DUP_GR
#define DUP_GR 1
#endif
#ifndef DUP_MISC
#define DUP_MISC 1
#endif
#ifndef NSYNC
#define NSYNC 1
#endif
#define REP(n) _Pragma("nounroll") for (int _d = 0; _d < (n); ++_d)
#ifndef TP1
#define TP1 -1
#endif
#ifndef TP2
#define TP2 -1
#endif
    volatile LAS unsigned* tacc = (volatile LAS unsigned*)(lds + STAGE_BYTES + 16384 + 64);
    unsigned long long tlast = 0; int tslot = 0;
    if (TP1 >= 0) { if (threadIdx.x < 32) tacc[threadIdx.x] = 0u; __syncthreads(); tlast = wall_clock64(); }
#define TSTAMP() do { if (TP1 >= 0) { const unsigned long long _n = wall_clock64(); if (threadIdx.x == 0) tacc[tslot] += (unsigned)(_n - tlast); tlast = _n; ++tslot; } } while (0)
#ifndef SPIN_MASK
#define SPIN_MASK 0
#endif
    unsigned long long tphase = 0;
    if (SPIN_MASK) tphase = wall_clock64();
#define SPIN_BEFORE() do { if (SPIN_MASK) { if (((SPIN_MASK >> tslot) & 1) && threadIdx.x == 448) { const unsigned long long _t = wall_clock64(), _d = _t - tphase; while (wall_clock64() - _t < _d) __builtin_amdgcn_s_sleep(8); } } } while (0)
#define SPIN_AFTER() do { if (SPIN_MASK) { tphase = wall_clock64(); ++tslot; } } while (0)
#define GSYNC() do { SPIN_BEFORE(); REP(NSYNC) { KP Pb = kparams(); XcdBarrier xb_; xb_.bar = (unsigned*)(Pb->ws + OFF_BAR); xb_.x = xb_xcc_id(); xb_.st = (volatile LAS unsigned*)(lds + STAGE_BYTES + 16384); xcd_barrier(xb_); } TSTAMP(); SPIN_AFTER(); } while (0)
    for (int l = 0; l < 2; ++l) {
        { KP P = kparams(); unsigned char* ws = P->ws;
          conv_t<true>((bf16_t*)(ws + OFF_WIN), (const float*)P->in[4] + (size_t)l * 1024 * NIN, 10752, 1024, NIN); }
        for (int n = 0; n < 4; ++n) { KP P = kparams(); unsigned char* ws = P->ws;
          conv_t<false>((bf16_t*)(ws + OFF_WB) + (size_t)n * 1024 * 512, (const float*)P->in[26] + ((size_t)l * 4 + n) * 512 * 1024, 1024, 512, 1024); }
        { KP P = kparams(); unsigned char* ws = P->ws; conv_t<false>((bf16_t*)(ws + OFF_WOUT), (const float*)P->in[27] + (size_t)l * 1024 * 1024, 1024, 1024, 1024); }
        { KP P = kparams(); unsigned char* ws = P->ws; conv_t<false>((bf16_t*)(ws + OFF_WQ), (const float*)P->in[30] + (size_t)l * 1024 * 1024, 1024, 1024, 1024); }
        { KP P = kparams(); unsigned char* ws = P->ws; conv_t<false>((bf16_t*)(ws + OFF_WKV), (const float*)P->in[31] + (size_t)l * 1024 * 2048, 2048, 1024, 2048); }
        { KP P = kparams(); unsigned char* ws = P->ws; conv_t<false>((bf16_t*)(ws + OFF_WO), (const float*)P->in[32] + (size_t)l * 1024 * 1024, 1024, 1024, 1024); }
        { KP P = kparams(); unsigned char* ws = P->ws; conv_t<false>((bf16_t*)(ws + OFF_W2T), (const float*)P->in[7] + (size_t)l * 64 * 512, 512, 64, 512); }
        { KP P = kparams(); unsigned char* ws = P->ws; conv_t<false>((bf16_t*)(ws + OFF_A2T), (const float*)P->in[9] + (size_t)l * 64 * 512, 512, 64, 512); }
        lru_conv_w(kparams(), l);
        { KP P = kparams(); unsigned char* ws = P->ws; rmsnorm_bf16((const float*)P->in[1], (const float*)P->in[29] + l * 1024, (bf16_t*)(ws + OFF_MN), 512); }
        for (int b = 0; b < 2; ++b) {
            tslot = 0;
            { KP P = kparams(); unsigned char* ws = P->ws;
              const float* hin = (l == 0 ? (const float*)P->in[0] : (const float*)P->out) + (size_t)b * TB * DM;
              rmsnorm_bf16(hin, (const float*)P->in[3] + l * 1024, (bf16_t*)(ws + OFF_UN), TB); }
            GSYNC();
            if (b == 0) { KP P = kparams(); unsigned char* ws = P->ws;
                Order S; S.init(2, 8, 1, ws + OFF_MN, ws + OFF_WKV, 256L * 1024 * 2, 256L * 1024 * 2, 0, 0, 0);
                EpiKV E{(bf16_t*)(ws + OFF_KM), (bf16_t*)(ws + OFF_VT)}; gemm_phase(lds, Gemm{1024, 1024, 1024}, S, E); }
            REP(DUP_GEMM) { KP P = kparams(); unsigned char* ws = P->ws;
                Order S; S.init(64, 26, 1, ws + OFF_UN, ws + OFF_WIN, 256L * 1024 * 2, 256L * 1024 * 2, 0, 0, 0);
                EpiInproj E{ws}; gemm_phase(lds, Gemm{1024, 1024, 1024}, S, E); }
            GSYNC();
            REP(DUP_PREP) rwkv_prep(kparams(), l, shm);
            GSYNC();
            REP(DUP_P1) rwkv_pass1(kparams());
            GSYNC();
            if (blockIdx.x < 8) { rwkv_cscan(kparams(), shm); lru_p1(kparams(), l, (int)gridDim.x - 8 + obid(), 1 << 30, 256, shm); }
            else { lru_p1(kparams(), l, obid() - 8, (int)gridDim.x - 8, (int)gridDim.x - 8, shm); REP(DUP_GR) gr_ds(kparams(), l, b, shm, 8); }
            GSYNC();
            if (threadIdx.x < 256) rwkv_pass2(kparams());
            else gr_scan(kparams(), otid() - 256);
            GSYNC();
            { KP Pq = kparams(); gr_out(Pq, l, b, shm, (bf16_t*)(Pq->ws + OFF_ZG), 2048); }
            { KP Pq = kparams(); lru_p3(Pq, (bf16_t*)(Pq->ws + OFF_ZG), 2048); }
            rw_post(kparams(), l);
            GSYNC();
            REP(DUP_GEMM) { KP P = kparams(); unsigned char* ws = P->ws;
                Order S; S.init(64, 16, 1, ws + OFF_UN, ws + OFF_WIN + (size_t)6656 * 1024 * 2, 256L * 1024 * 2, 256L * 1024 * 2, 0, 0, 0);
                EpiBf16<1> E{(bf16_t*)(ws + OFF_G), 4096, 1.0f}; gemm_phase(lds, Gemm{1024, 1024, 1024}, S, E); }
            GSYNC();
            REP(DUP_GEMM) { KP P = kparams(); unsigned char* ws = P->ws;
                Order S; S.init(64, 4, 4, ws + OFF_ZG, ws + OFF_WB, 256L * 2048 * 2, 256L * 512 * 2, 0, 512L * 2, 1024L * 512 * 2);
                EpiMerge E{(const bf16_t*)(ws + OFF_G), (bf16_t*)(ws + OFF_MRG)}; gemm_phase(lds, Gemm{2048, 512, 512}, S, E); }
            GSYNC();
            { KP P = kparams(); unsigned char* ws = P->ws;
                const float* hin = (l == 0 ? (const float*)P->in[0] : (const float*)P->out) + (size_t)b * TB * DM; float* hout = P->out + (size_t)b * TB * DM;
                Order S; S.init(64, 4, 1, ws + OFF_MRG, ws + OFF_WOUT, 256L * 1024 * 2, 256L * 1024 * 2, 0, 0, 0);
                EpiResid E{hin, hout}; gemm_phase(lds, Gemm{1024, 1024, 1024}, S, E); }
            GSYNC();
            { KP P = kparams(); unsigned char* ws = P->ws; const float* hout = P->out + (size_t)b * TB * DM;
              rmsnorm_bf16(hout, (const float*)P->in[28] + l * 1024, (bf16_t*)(ws + OFF_UN), TB); }
            GSYNC();
            REP(DUP_GEMM) { KP P = kparams(); unsigned char* ws = P->ws;
                Order S; S.init(64, 4, 1, ws + OFF_UN, ws + OFF_WQ, 256L * 1024 * 2, 256L * 1024 * 2, 0, 0, 0);
                EpiBf16<0> E{(bf16_t*)(ws + OFF_Q), 1024, 0.0625f}; gemm_phase(lds, Gemm{1024, 1024, 1024}, S, E); }
            GSYNC();
            REP(DUP_GEMM) { KP P = kparams(); unsigned char* ws = P->ws;
                Order S; S.init(64, 4, 1, ws + OFF_Q, ws + OFF_KM + (size_t)b * 256 * 1024 * 2, 256L * 1024 * 2, 256L * 2, 256L * 2, 0, 0);
                EpiSoftmax E{(bf16_t*)(ws + OFF_P), (LAS float*)(lds + STAGE_BYTES)}; gemm_phase(lds, Gemm{1024, 1024, 256}, S, E); }
            GSYNC();
            REP(DUP_GEMM) { KP P = kparams(); unsigned char* ws = P->ws;
                Order S; S.init(64, 4, 1, ws + OFF_P, ws + OFF_VT + (size_t)b * 1024 * 256 * 2, 256L * 1024 * 2, 256L * 256 * 2, 256L * 2, 0, 0);
                EpiBf16<0> E{(bf16_t*)(ws + OFF_O), 1024, 1.0f}; gemm_phase(lds, Gemm{1024, 256, 256}, S, E); }
            GSYNC();
            { KP P = kparams(); unsigned char* ws = P->ws; float* hout = P->out + (size_t)b * TB * DM;
                Order S; S.init(64, 4, 1, ws + OFF_O, ws + OFF_WO, 256L * 1024 * 2, 256L * 1024 * 2, 0, 0, 0);
                EpiResid E{hout, hout}; gemm_phase(lds, Gemm{1024, 1024, 1024}, S, E); }
            GSYNC();
        }
    }
    { KP P = kparams(); rmsnorm_f32_inplace(P->out, (const float*)P->in[33], 2 * TB); }
    if (TP1 >= 0) {
        GSYNC();
        if (blockIdx.x == 0) { KP P = kparams(); __syncthreads();
            const float t1 = (float)tacc[TP1 >= 0 ? TP1 : 0] * 0.01f, t2 = (float)tacc[TP2 >= 0 ? TP2 : 0] * 0.01f;
            if (threadIdx.x == 0) P->out[0] = 100.0f * t1;
            if (TP2 >= 0) for (int i = threadIdx.x; i < 65536; i += 512) P->out[65536 + i] = t2; }
    }
}

extern "C" void kernel_launch(void* const* d_in, const int* in_sizes, int n_in, void* d_out, int out_size, void* d_ws, size_t ws_size, hipStream_t stream) {
    constexpr size_t kDynLds = pg8::STAGE_BYTES + 16384 + 64 + 256;
    static int grid_blocks = 0;
    if (!grid_blocks) {
        int dev = 0, cus = 0, per_cu = 0;
        hipGetDevice(&dev);
        hipDeviceGetAttribute(&cus, hipDeviceAttributeMultiprocessorCount, dev);
        hipFuncSetAttribute((const void*)fwd_megakernel, hipFuncAttributeMaxDynamicSharedMemorySize, (int)kDynLds);
        hipOccupancyMaxActiveBlocksPerMultiprocessor(&per_cu, (const void*)fwd_megakernel, 512, kDynLds);
        if (per_cu < 1) { fprintf(stderr, "occupancy query returned %d\n", per_cu); per_cu = 1; }
        grid_blocks = cus * per_cu;
        if (ws_size < OFF_END) fprintf(stderr, "workspace too small: %zu < %zu\n", ws_size, (size_t)OFF_END);
    }
    Params p{};
    for (int i = 0; i < 34; ++i) p.in[i] = d_in[i];
    p.out = (float*)d_out; p.ws = (unsigned char*)d_ws;
    void* args[] = {&p};
    hipError_t e = hipLaunchCooperativeKernel((const void*)fwd_megakernel, dim3(grid_blocks), dim3(512), args, kDynLds, stream);
    if (e != hipSuccess) fprintf(stderr, "cooperative launch failed: %s (grid %d)\n", hipGetErrorString(e), grid_blocks);
}
```
